# Optimizing an MI355X kernel written in HIP

```python
import math
import jax, jax.numpy as jnp
from jax import lax
import numpy as np

D_MODEL = 2048
BATCH = 2
SEQ = 8192
DEPTH = 2

ATTN_WIDTH = D_MODEL // 2
HGRN_WIDTH = D_MODEL - ATTN_WIDTH
ATTN_HEADS = 8
ATTN_HEAD_DIM = ATTN_WIDTH // (2 * ATTN_HEADS)
ATTN_V_DIM = 2 * ATTN_HEAD_DIM
HGRN_EXPAND = 128
HGRN_HEADS = HGRN_WIDTH // HGRN_EXPAND
HGRN_KEY_DIM = HGRN_EXPAND
HGRN_VAL_DIM = HGRN_WIDTH // HGRN_HEADS
D_FF = int(math.ceil(8 * D_MODEL / 3 / 256)) * 256
IN_WIDTH = 3 * ATTN_WIDTH + 4 * HGRN_WIDTH
SPLITS = (ATTN_WIDTH, 2 * ATTN_WIDTH, 3 * ATTN_WIDTH,
          3 * ATTN_WIDTH + HGRN_WIDTH, 3 * ATTN_WIDTH + 2 * HGRN_WIDTH,
          3 * ATTN_WIDTH + 3 * HGRN_WIDTH)
Q_BLOCK = 128
CHUNK = 64
NORM_EPS = 1e-6
SUBLN_EPS = 1e-5

kernel_name = 'hymba_diffattn_hgrn2_macaron'


def rmsnorm(x, w, eps=NORM_EPS):
    x32 = x.astype(jnp.float32)
    y = x32 * lax.rsqrt(jnp.mean(x32 * x32, axis=-1, keepdims=True) + eps)
    return (y * w.astype(jnp.float32)).astype(x.dtype)


def swiglu(h, w_gate, w_up, w_down):
    return (jax.nn.silu(h @ w_gate) * (h @ w_up)) @ w_down


def diff_attention(q, k, v, lam):
    B, S, H, _, d = q.shape
    nb = S // Q_BLOCK
    q_blocks = jnp.moveaxis((q * (d ** -0.5)).reshape(B, nb, Q_BLOCK, H, 2, d), 1, 0)
    key_pos = jnp.arange(S)

    def one_block(args):
        blk, qb = args
        q_pos = blk * Q_BLOCK + jnp.arange(Q_BLOCK)
        s = jnp.einsum('bqhcd,bkhcd->bhcqk', qb, k, preferred_element_type=jnp.float32)
        causal = key_pos[None, :] <= q_pos[:, None]
        p = jax.nn.softmax(jnp.where(causal, s, -jnp.inf), axis=-1)
        p_diff = p[:, :, 0] - lam * p[:, :, 1]
        return jnp.einsum('bhqk,bkhv->bqhv', p_diff.astype(v.dtype), v)

    o = lax.map(one_block, (jnp.arange(nb), q_blocks))
    return jnp.moveaxis(o, 0, 1).reshape(B, S, H, v.shape[-1])


def hgrn2_chunked(q, z_f, i, lb):
    f32 = jnp.float32
    q = q.astype(f32)
    z = z_f.astype(f32)
    v = i.astype(f32)
    lb = lb.astype(f32)
    log_f = jnp.logaddexp(jnp.log(lb), jnp.log1p(-lb) + jax.nn.log_sigmoid(z))
    k = (1.0 - lb) * jax.nn.sigmoid(-z)
    B, S, H, dk = q.shape
    dv = v.shape[-1]
    n = S // CHUNK

    def to_chunks(t):
        return t.reshape(B, n, CHUNK, H, t.shape[-1]).transpose(1, 0, 3, 2, 4)

    mask = jnp.tril(jnp.ones((CHUNK, CHUNK), dtype=bool))

    def step(state, inp):
        qc, gc, kc, vc = inp
        b = jnp.cumsum(gc, axis=2)
        o_inter = jnp.einsum('bhtk,bhkv->bhtv', qc * jnp.exp(b), state)
        rel = b[:, :, :, None, :] - b[:, :, None, :, :]
        decay = jnp.exp(jnp.where(mask[:, :, None], rel, -jnp.inf))
        scores = jnp.einsum('bhtk,bhtsk,bhsk->bhts', qc, decay, kc)
        o_intra = jnp.einsum('bhts,bhsv->bhtv', scores, vc)
        b_last = b[:, :, -1:, :]
        state = (jnp.exp(b_last[:, :, 0, :])[..., None] * state
                 + jnp.einsum('bhsk,bhsv->bhkv', kc * jnp.exp(b_last - b), vc))
        return state, o_inter + o_intra

    state0 = jnp.zeros((B, H, dk, dv), f32)
    _, o = lax.scan(step, state0, (to_chunks(q), to_chunks(log_f), to_chunks(k), to_chunks(v)))
    return o.transpose(1, 0, 3, 2, 4).reshape(B, S, H, dv)


def hybrid_mixer(h, w_in, lq1, lk1, lq2, lk2, subln_w, lb, gnorm_w, w_out, layer_idx):
    B, S, _ = h.shape
    proj = h @ w_in
    q_a, k_a, v_a, q_h, f_h, i_h, g_h = jnp.split(proj, SPLITS, axis=-1)

    lambda_init = 0.8 - 0.6 * math.exp(-0.3 * layer_idx)
    lam = (jnp.exp(jnp.sum(lq1.astype(jnp.float32) * lk1.astype(jnp.float32)))
           - jnp.exp(jnp.sum(lq2.astype(jnp.float32) * lk2.astype(jnp.float32)))
           + lambda_init)
    attn = diff_attention(q_a.reshape(B, S, ATTN_HEADS, 2, ATTN_HEAD_DIM),
                          k_a.reshape(B, S, ATTN_HEADS, 2, ATTN_HEAD_DIM),
                          v_a.reshape(B, S, ATTN_HEADS, ATTN_V_DIM), lam)
    attn = (rmsnorm(attn, subln_w, SUBLN_EPS) * (1.0 - lambda_init)).reshape(B, S, ATTN_WIDTH)

    rec = hgrn2_chunked(q_h.reshape(B, S, HGRN_HEADS, HGRN_KEY_DIM),
                        f_h.reshape(B, S, HGRN_HEADS, HGRN_KEY_DIM),
                        i_h.reshape(B, S, HGRN_HEADS, HGRN_VAL_DIM),
                        lb.reshape(HGRN_HEADS, HGRN_KEY_DIM))
    rec = rmsnorm(rec.reshape(B, S, HGRN_WIDTH).astype(h.dtype), gnorm_w) * jax.nn.silu(g_h)

    return jnp.concatenate([attn.astype(h.dtype), rec], axis=-1) @ w_out


def setup_inputs(seed: int = 0) -> dict:
    key = jax.random.key(seed)
    ks = jax.random.split(key, 20)
    f32 = jnp.float32

    def nrm(k, shape, scale):
        return jax.random.normal(k, shape, f32) * scale

    def gain(k, shape):
        return 1.0 + 0.02 * jax.random.normal(k, shape, f32)

    L, D, F = DEPTH, D_MODEL, D_FF
    return {
        'x': nrm(ks[0], (BATCH, SEQ, D), 1.0),
        'ffn1_norm': gain(ks[1], (L, D)),
        'ffn1_w_gate': nrm(ks[2], (L, D, F), D ** -0.5),
        'ffn1_w_up': nrm(ks[3], (L, D, F), D ** -0.5),
        'ffn1_w_down': nrm(ks[4], (L, F, D), F ** -0.5),
        'mix_norm': gain(ks[5], (L, D)),
        'w_in': nrm(ks[6], (L, D, IN_WIDTH), D ** -0.5),
        'lambda_q1': nrm(ks[7], (L, ATTN_HEAD_DIM), 0.1),
        'lambda_k1': nrm(ks[8], (L, ATTN_HEAD_DIM), 0.1),
        'lambda_q2': nrm(ks[9], (L, ATTN_HEAD_DIM), 0.1),
        'lambda_k2': nrm(ks[10], (L, ATTN_HEAD_DIM), 0.1),
        'attn_subln': gain(ks[11], (L, ATTN_V_DIM)),
        'hgrn_lower_bounds': nrm(ks[12], (L, HGRN_HEADS * HGRN_KEY_DIM), 0.5),
        'hgrn_out_norm': gain(ks[13], (L, HGRN_WIDTH)),
        'w_out': nrm(ks[14], (L, D, D), D ** -0.5),
        'ffn2_norm': gain(ks[15], (L, D)),
        'ffn2_w_gate': nrm(ks[16], (L, D, F), D ** -0.5),
        'ffn2_w_up': nrm(ks[17], (L, D, F), D ** -0.5),
        'ffn2_w_down': nrm(ks[18], (L, F, D), F ** -0.5),
        'final_norm': gain(ks[19], (D,)),
    }


def reference(x, ffn1_norm, ffn1_w_gate, ffn1_w_up, ffn1_w_down, mix_norm, w_in,
              lambda_q1, lambda_k1, lambda_q2, lambda_k2, attn_subln, hgrn_lower_bounds,
              hgrn_out_norm, w_out, ffn2_norm, ffn2_w_gate, ffn2_w_up, ffn2_w_down,
              final_norm):
    lb_all = jnp.cumsum(jax.nn.softmax(hgrn_lower_bounds.astype(jnp.float32), axis=0), axis=0)
    lb_all = jnp.clip(lb_all - lb_all[0:1], 0.0, 1.0)
    for l in range(DEPTH):
        x = x + 0.5 * swiglu(rmsnorm(x, ffn1_norm[l]), ffn1_w_gate[l], ffn1_w_up[l], ffn1_w_down[l])
        x = x + hybrid_mixer(rmsnorm(x, mix_norm[l]), w_in[l], lambda_q1[l], lambda_k1[l],
                             lambda_q2[l], lambda_k2[l], attn_subln[l], lb_all[l],
                             hgrn_out_norm[l], w_out[l], l)
        x = x + 0.5 * swiglu(rmsnorm(x, ffn2_norm[l]), ffn2_w_gate[l], ffn2_w_up[l], ffn2_w_down[l])
    return rmsnorm(x, final_norm)
```

```cpp
#include <hip/hip_runtime.h>
#include <hip/hip_bf16.h>
#include <hip/hip_cooperative_groups.h>
#include <cstdio>
#include <cstdint>
#include <cmath>
namespace cg = cooperative_groups;
namespace pg8 {
#define PG8_LAS __attribute__((address_space(3)))
typedef unsigned short bf16_t;
typedef short bf16x8 __attribute__((ext_vector_type(8)));
typedef float f32x4 __attribute__((ext_vector_type(4)));
typedef unsigned u32x4 __attribute__((ext_vector_type(4)));
constexpr int BM = 256, BK = 64, HALF = 128, HTB = HALF * BK * 2  , STAGE_BYTES = 8 * HTB, NXCD = 8, WGM = 8;

__host__ __device__ __forceinline__ int lds_byte(int r, int c) { const int st = (r >> 4) * 2 + (c >> 5), rr = r & 15, cc = c & 31, ob = rr * 64 + cc * 2; return st * 1024 + (ob ^ (((ob >> 9) & 1) << 5)); }
__host__ __device__ __forceinline__ void stage_rc(int b, int& R, int& C) { const int st = b / 1024, sb = b % 1024, swz = sb ^ (((sb >> 9) & 1) << 5); R = (st >> 1) * 16 + swz / 64; C = (st & 1) * 32 + (swz % 64) / 2; }
__host__ __device__ __forceinline__ int perm32(int rho) { const int n = rho >> 4, i = rho & 15; return 8 * (i >> 2) + 4 * n + (i & 3); }

struct Unit { int pm, pn; };
__host__ __device__ __forceinline__ size_t toff(int m, int k, int nt) { return ((size_t)((m >> 8) * nt + (k >> 6)) * 256 + (m & 255)) * 64 + (k & 63); }
struct Gemm { const bf16_t* A; const bf16_t* Bt; int M, N, K; };

struct StaticOrder {
    int nM, nN, nwg, G, c;
    __host__ __device__ void init(int M, int N, int G_, int c_) { nM = M / BM; nN = N / BM; nwg = nM * nN; G = G_; c = c_; }
    __host__ __device__ bool next(int i, Unit& u) const {
        const long L = (long)i * G + c; if (L >= nwg) return false;
        int wgid = (int)L; { const int q = nwg / NXCD, r = nwg % NXCD, xcd = wgid % NXCD, off = wgid / NXCD; wgid = (xcd < r ? xcd * (q + 1) : r * (q + 1) + (xcd - r) * q) + off; }
        const int nig = WGM * nN, gid = wgid / nig, fm = gid * WGM, gsz = (nM - fm) < WGM ? (nM - fm) : WGM;
        u.pm = fm + ((wgid % nig) % gsz); u.pn = (wgid % nig) / gsz; return true;
    }
    __device__ __forceinline__ void a_ready(const Unit&) const {}
    __device__ __forceinline__ void done(const Unit&) const {}
};

__device__ __forceinline__ unsigned cvt_pk_bf16(float lo, float hi) { unsigned r; asm volatile("v_cvt_pk_bf16_f32 %0, %1, %2" : "=v"(r) : "v"(lo), "v"(hi)); return r; }
typedef float f32x2 __attribute__((ext_vector_type(2)));
__device__ __forceinline__ f32x2 gelu_pk(f32x2 v) {
    const f32x2 av = __builtin_elementwise_abs(v), d = av * 0.2316418882f + 1.0f;
    f32x2 t; t.x = __builtin_amdgcn_rcpf(d.x); t.y = __builtin_amdgcn_rcpf(d.y);
    f32x2 q = t * 0.5307027145f + (-0.7265760135f); q = q * t + 0.7107068705f; q = q * t + (-0.142248368f); q = q * t + 0.127414796f; q = q * t;
    const f32x2 s = (v * v) * (-0.72134752044f);
    f32x2 e; e.x = __builtin_amdgcn_exp2f(s.x); e.y = __builtin_amdgcn_exp2f(s.y);
    const f32x2 m = v * (q * e), r = v - m;
    f32x2 o; o.x = v.x < 0.f ? m.x : r.x; o.y = v.y < 0.f ? m.y : r.y; return o;
}

template <int ACT  > struct EpiBf16 {
    static constexpr bool PERM = true, AFTER_DRAIN = false; static_assert(ACT == 0 || ACT == 1, "EpiBf16: ACT is 0 (none) or 1 (gelu_pk)");
    bf16_t* O; int ldc; const float* bias; int split_cols; size_t split_stride; float scale0;
    __device__ __forceinline__ void operator()(const f32x4 (&acc)[2][2][4][2], const Unit& u, int wr, int wc, int fr, int fq) const {
        const int row0 = u.pm * BM + wr * 64 + fr; int colt = u.pn * BM; bf16_t* base = O;
        float sc = 1.f; if (split_cols) { const int t = colt / split_cols; base += (size_t)t * split_stride; colt -= t * split_cols; if (t == 0) sc = scale0; }
        const int col0 = colt + wc * 32 + 8 * fq, bcol0 = u.pn * BM + wc * 32 + 8 * fq;
        f32x4 bv[2][2];
#pragma unroll
        for (int bj = 0; bj < 2; ++bj)
#pragma unroll
            for (int n = 0; n < 2; ++n) bv[bj][n] = bias ? *(const f32x4*)(bias + bcol0 + bj * HALF + 4 * n) : (f32x4){0.f, 0.f, 0.f, 0.f};
#pragma unroll
        for (int ai = 0; ai < 2; ++ai)
#pragma unroll
            for (int m = 0; m < 4; ++m) { bf16_t* rowp = base + (size_t)(row0 + ai * HALF + m * 16) * ldc + col0;
#pragma unroll
                for (int bj = 0; bj < 2; ++bj) { f32x4 v0 = acc[ai][bj][m][0] + bv[bj][0], v1 = acc[ai][bj][m][1] + bv[bj][1];
                    if (ACT == 1) { f32x2 a = gelu_pk((f32x2){v0[0], v0[1]}), b = gelu_pk((f32x2){v0[2], v0[3]}), c = gelu_pk((f32x2){v1[0], v1[1]}), d = gelu_pk((f32x2){v1[2], v1[3]});
                        v0 = (f32x4){a.x, a.y, b.x, b.y}; v1 = (f32x4){c.x, c.y, d.x, d.y}; }
                    v0 = v0 * sc; v1 = v1 * sc; u32x4 w; w.x = cvt_pk_bf16(v0[0], v0[1]); w.y = cvt_pk_bf16(v0[2], v0[3]); w.z = cvt_pk_bf16(v1[0], v1[1]); w.w = cvt_pk_bf16(v1[2], v1[3]);
                    *(u32x4*)(rowp + bj * HALF) = w; } }
    }
};
__device__ __forceinline__ float shx(float v, int lane, int m) { return __builtin_bit_cast(float, __builtin_amdgcn_ds_bpermute((lane ^ m) << 2, __builtin_bit_cast(int, v))); }
__device__ __forceinline__ void row_rstd(float (&rs)[2][4], const float* ssq, int row0, int fq, float inv_n, float eps, const PG8_LAS float* tab, int tab_pm, int pm) {
    const int lane = (row0 & 15) + 16 * fq;
    if (pm == tab_pm) {
#pragma unroll
        for (int ai = 0; ai < 2; ++ai)
#pragma unroll
            for (int m = 0; m < 4; ++m) rs[ai][m] = tab[(row0 & 255) + ai * HALF + m * 16];
        return;
    }
#pragma unroll
    for (int ai = 0; ai < 2; ++ai)
#pragma unroll
        for (int m = 0; m < 4; ++m) { const f32x4* p = (const f32x4*)(ssq + (size_t)(row0 + ai * HALF + m * 16) * 32 + fq * 8); const f32x4 a = p[0], b = p[1];
            float s = ((a[0] + a[1]) + (a[2] + a[3])) + ((b[0] + b[1]) + (b[2] + b[3])); s += shx(s, lane, 16); s += shx(s, lane, 32);
            rs[ai][m] = __builtin_amdgcn_rsqf(s * inv_n + eps); }
}
struct EpiSwiGLU {
    static constexpr bool PERM = true, AFTER_DRAIN = false;
    bf16_t* O; int ldc; const float* ssq; float inv_n, eps; const PG8_LAS float* tab; int tab_pm;
    __device__ __forceinline__ void operator()(const f32x4 (&acc)[2][2][4][2], const Unit& u, int wr, int wc, int fr, int fq) const {
        const int row0 = u.pm * BM + wr * 64 + fr; const int col0 = u.pn * HALF + wc * 32 + 8 * fq;
        float rs[2][4]; row_rstd(rs, ssq, row0, fq, inv_n, eps, tab, tab_pm, u.pm);
#pragma unroll
        for (int ai = 0; ai < 2; ++ai)
#pragma unroll
            for (int m = 0; m < 4; ++m) { bf16_t* rowp = O + toff(row0 + ai * HALF + m * 16, col0, ldc >> 6);
                const float r = rs[ai][m]; const f32x2 c1 = {-1.4426950408889634f * r, -1.4426950408889634f * r}, r2 = {r * r, r * r};
                unsigned wv[4];
#pragma unroll
                for (int n = 0; n < 2; ++n)
#pragma unroll
                    for (int e = 0; e < 4; e += 2) { const f32x2 g = {acc[ai][0][m][n][e], acc[ai][0][m][n][e + 1]}, up = {acc[ai][1][m][n][e], acc[ai][1][m][n][e + 1]};
                        const f32x2 t = g * c1; f32x2 d; d.x = __builtin_amdgcn_exp2f(t.x); d.y = __builtin_amdgcn_exp2f(t.y); d = d + 1.0f;
                        f32x2 rc; rc.x = __builtin_amdgcn_rcpf(d.x); rc.y = __builtin_amdgcn_rcpf(d.y);
                        const f32x2 hv = ((g * up) * r2) * rc; wv[n * 2 + (e >> 1)] = cvt_pk_bf16(hv.x, hv.y); }
                u32x4 w; w.x = wv[0]; w.y = wv[1]; w.z = wv[2]; w.w = wv[3];
                *(u32x4*)rowp = w; }
    }
};
struct EpiProj {
    static constexpr bool PERM = true, AFTER_DRAIN = false;
    bf16_t* O; int ldc; const float* ssq; float inv_n, eps; int qcols; float qscale; const PG8_LAS float* tab; int tab_pm;
    __device__ __forceinline__ void operator()(const f32x4 (&acc)[2][2][4][2], const Unit& u, int wr, int wc, int fr, int fq) const {
        const int row0 = u.pm * BM + wr * 64 + fr; const int col0 = u.pn * BM + wc * 32 + 8 * fq;
        float rs[2][4]; row_rstd(rs, ssq, row0, fq, inv_n, eps, tab, tab_pm, u.pm);
        const float cs = (u.pn * BM < qcols) ? qscale : 1.0f;
#pragma unroll
        for (int ai = 0; ai < 2; ++ai)
#pragma unroll
            for (int m = 0; m < 4; ++m) { bf16_t* rowp = O + (size_t)(row0 + ai * HALF + m * 16) * ldc + col0; const float r = rs[ai][m] * cs;
#pragma unroll
                for (int bj = 0; bj < 2; ++bj) { const f32x4 v0 = acc[ai][bj][m][0] * r, v1 = acc[ai][bj][m][1] * r;
                    u32x4 w; w.x = cvt_pk_bf16(v0[0], v0[1]); w.y = cvt_pk_bf16(v0[2], v0[3]); w.z = cvt_pk_bf16(v1[0], v1[1]); w.w = cvt_pk_bf16(v1[2], v1[3]);
                    *(u32x4*)(rowp + bj * HALF) = w; } }
    }
};
struct EpiResidual {
    static constexpr bool PERM = true, AFTER_DRAIN = false;
    bf16_t* xb; float* ssq; int ldc; float alpha;
    __device__ __forceinline__ void operator()(const f32x4 (&acc)[2][2][4][2], const Unit& u, int wr, int wc, int fr, int fq) const {
        const int row0 = u.pm * BM + wr * 64 + fr; const int col0 = u.pn * BM + wc * 32 + 8 * fq;
#pragma unroll
        for (int ai = 0; ai < 2; ++ai) {
            u32x4 bs[4][2];
#pragma unroll
            for (int m = 0; m < 4; ++m) {
#pragma unroll
                for (int bj = 0; bj < 2; ++bj) bs[m][bj] = *(const u32x4*)(xb + toff(row0 + ai * HALF + m * 16, col0 + bj * HALF, ldc >> 6)); }
            asm volatile("" ::: "memory");
#pragma unroll
            for (int m = 0; m < 4; ++m) { const int row = row0 + ai * HALF + m * 16; float ss = 0.f;
#pragma unroll
                for (int bj = 0; bj < 2; ++bj) { const u32x4 b = bs[m][bj];
                    const f32x4 b0 = {__builtin_bit_cast(float, b.x << 16), __builtin_bit_cast(float, b.x & 0xffff0000u), __builtin_bit_cast(float, b.y << 16), __builtin_bit_cast(float, b.y & 0xffff0000u)};
                    const f32x4 b1 = {__builtin_bit_cast(float, b.z << 16), __builtin_bit_cast(float, b.z & 0xffff0000u), __builtin_bit_cast(float, b.w << 16), __builtin_bit_cast(float, b.w & 0xffff0000u)};
                    const f32x4 o0 = b0 + acc[ai][bj][m][0] * alpha, o1 = b1 + acc[ai][bj][m][1] * alpha;
                    ss += (o0[0] * o0[0] + o0[1] * o0[1]) + (o0[2] * o0[2] + o0[3] * o0[3]) + (o1[0] * o1[0] + o1[1] * o1[1]) + (o1[2] * o1[2] + o1[3] * o1[3]);
                    u32x4 w; w.x = cvt_pk_bf16(o0[0], o0[1]); w.y = cvt_pk_bf16(o0[2], o0[3]); w.z = cvt_pk_bf16(o1[0], o1[1]); w.w = cvt_pk_bf16(o1[2], o1[3]);
                    *(u32x4*)(xb + toff(row, col0 + bj * HALF, ldc >> 6)) = w; }
                ss += shx(ss, fr + 16 * fq, 16); ss += shx(ss, fr + 16 * fq, 32);
                if (fq == 0) ssq[(size_t)row * 32 + u.pn * 4 + wc] = ss; }
            asm volatile("" ::: "memory");
        }
    }
};

template <class Epi, class Sched, bool ALIGN_EPI = false, bool SP2 = false>
__device__ __forceinline__ void gemm_phase(PG8_LAS unsigned char* lds, const Gemm g, const Sched& S, const Epi& E) {
    int tid_o = threadIdx.x; asm volatile("" : "+v"(tid_o));
    const int tid = tid_o, wid = __builtin_amdgcn_readfirstlane(tid >> 6), lane = tid & 63, wr = wid >> 2, wc = wid & 3, fr = lane & 15, fq = lane >> 4;
    const int K = g.K, nt = K / BK;
    unsigned voffA[2], voffB[2];
#pragma unroll
    for (int i = 0; i < 2; ++i) { int R, C; stage_rc(tid * 16 + i * 8192, R, C); const int Rb = Epi::PERM ? ((R & ~31) + perm32(R & 31)) : R;
        voffA[i] = (unsigned)(R * BK + C) * 2u; voffB[i] = (unsigned)(Rb * BK + C) * 2u; }
    const size_t kstep = (size_t)(BK * 2), kstepB = (size_t)BM * BK * 2;
    const size_t hstep = (size_t)HALF * K * 2, hstepB = (size_t)HALF * BK * 2;
    const size_t tstep = 2 * hstep;
    const unsigned ldsw = (unsigned)wid * 1024u;
    const int aoff = lds_byte(wr * 64 + fr, fq * 8), boff = lds_byte(wc * 32 + fr, fq * 8);
#define PG8_SA(b, h) (((b) * 2 + (h)) * HTB)
#define PG8_SB(b, h) ((4 + (b) * 2 + (h)) * HTB)
#define PG8_STAGE(bufoff, gbase, voff) do { _Pragma("unroll") for (int _i = 0; _i < 2; ++_i) \
        __builtin_amdgcn_global_load_lds((const unsigned*)((const char*)(gbase) + (voff)[_i]), (PG8_LAS unsigned*)(lds + (bufoff) + ldsw + _i * 8192), 16, 0, 0); } while (0)
#define PG8_LDA(dst, b, h) do { _Pragma("unroll") for (int m = 0; m < 4; ++m) _Pragma("unroll") for (int k = 0; k < 2; ++k) dst[m][k] = *(const PG8_LAS bf16x8*)(lds + PG8_SA(b, h) + aoff + m * 2048 + k * 1024); } while (0)
#define PG8_LDB(dst, b, h) do { _Pragma("unroll") for (int n = 0; n < 2; ++n) _Pragma("unroll") for (int k = 0; k < 2; ++k) dst[n][k] = *(const PG8_LAS bf16x8*)(lds + PG8_SB(b, h) + boff + n * 2048 + k * 1024); } while (0)
#define PG8_MMA(ai, bj, At, Bt) do { __builtin_amdgcn_s_setprio(1); _Pragma("unroll") for (int m = 0; m < 4; ++m) _Pragma("unroll") for (int n = 0; n < 2; ++n) _Pragma("unroll") for (int k = 0; k < 2; ++k) \
        acc[ai][bj][m][n] = __builtin_amdgcn_mfma_f32_16x16x32_bf16(Bt[n][k], At[m][k], acc[ai][bj][m][n], 0, 0, 0); __builtin_amdgcn_s_setprio(0); } while (0)
#define PG8_WAIT_V(n) asm volatile("s_waitcnt vmcnt(" #n ")" ::: "memory")
#define PG8_WAIT_L(n) asm volatile("s_waitcnt lgkmcnt(" #n ")" ::: "memory")
#define PG8_BAR __builtin_amdgcn_s_barrier()
#define PG8_SCHED __builtin_amdgcn_sched_barrier(0)
    Unit cur, nxt; int ui = 0;
    if (!S.next(0, cur)) return;
    f32x4 acc[2][2][4][2];
#pragma unroll
    for (int a = 0; a < 2; ++a)
#pragma unroll
        for (int b = 0; b < 2; ++b)
#pragma unroll
            for (int m = 0; m < 4; ++m)
#pragma unroll
                for (int n = 0; n < 2; ++n) acc[a][b][m][n] = (f32x4){0.f, 0.f, 0.f, 0.f};
    bf16x8 At[4][2], B0[2][2], B1[2][2];
    const char* cA = (const char*)g.A + (size_t)cur.pm * tstep; const char* cB = (const char*)g.Bt + (size_t)cur.pn * tstep;
    S.a_ready(cur);
    if constexpr (SP2) {
        PG8_STAGE(PG8_SB(0, 0), cB, voffB); PG8_STAGE(PG8_SB(0, 1), cB + hstepB, voffB); PG8_STAGE(PG8_SA(0, 0), cA, voffA); PG8_STAGE(PG8_SA(0, 1), cA + hstepB, voffA);
        if (wr == 1) PG8_BAR;
        PG8_WAIT_V(2); PG8_BAR;
        PG8_STAGE(PG8_SB(1, 0), cB + kstepB, voffB); PG8_STAGE(PG8_SA(1, 0), cA + kstepB, voffA); PG8_STAGE(PG8_SB(1, 1), cB + hstepB + kstepB, voffB);
        PG8_WAIT_V(6); PG8_BAR;
    } else {
        PG8_STAGE(PG8_SB(0, 0), cB, voffB); PG8_STAGE(PG8_SA(0, 0), cA, voffA); PG8_STAGE(PG8_SB(0, 1), cB + hstepB, voffB); PG8_STAGE(PG8_SA(0, 1), cA + hstepB, voffA);
        if (wr == 1) PG8_BAR;
        PG8_WAIT_V(4); PG8_BAR;
        PG8_STAGE(PG8_SB(1, 0), cB + kstepB, voffB); PG8_STAGE(PG8_SA(1, 0), cA + kstepB, voffA); PG8_STAGE(PG8_SB(1, 1), cB + hstepB + kstepB, voffB);
        PG8_WAIT_V(6); PG8_BAR;
    }
    for (;;) {
        const bool has_next = S.next(ui + 1, nxt);
        const char* nA = has_next ? (const char*)g.A + (size_t)nxt.pm * tstep : cA; const char* nB = has_next ? (const char*)g.Bt + (size_t)nxt.pn * tstep : cB;
        for (int t = 0; t < nt; t += 2) {
            const bool last = (t == nt - 2);
            const char* a1 = cA + (size_t)(t + 1) * kstepB;
            const char* a2 = last ? nA : cA + (size_t)(t + 2) * kstepB; const char* b2 = last ? nB : cB + (size_t)(t + 2) * kstepB;
            const char* a3 = a2 + kstepB; const char* b3 = b2 + kstepB;
            if (last && has_next) S.a_ready(nxt);
            if constexpr (SP2) {
            PG8_LDB(B0, 0, 0); PG8_LDB(B1, 0, 1); PG8_SCHED; PG8_LDA(At, 0, 0); PG8_STAGE(PG8_SA(1, 1), a1 + hstepB, voffA);
            PG8_WAIT_V(8); PG8_WAIT_L(0); PG8_BAR; PG8_MMA(0, 0, At, B0); PG8_MMA(0, 1, At, B1); PG8_BAR; PG8_SCHED;
            PG8_LDA(At, 0, 1); PG8_STAGE(PG8_SB(0, 0), b2, voffB); PG8_STAGE(PG8_SB(0, 1), b2 + hstepB, voffB); PG8_STAGE(PG8_SA(0, 0), a2, voffA);
            PG8_WAIT_V(8); PG8_WAIT_L(0); PG8_BAR; PG8_MMA(1, 0, At, B0); PG8_MMA(1, 1, At, B1); PG8_BAR; PG8_SCHED;
            PG8_LDB(B0, 1, 0); PG8_LDB(B1, 1, 1); PG8_SCHED; PG8_LDA(At, 1, 0); PG8_STAGE(PG8_SA(0, 1), a2 + hstepB, voffA);
            PG8_WAIT_V(8); PG8_WAIT_L(0); PG8_BAR; PG8_MMA(0, 0, At, B0); PG8_MMA(0, 1, At, B1); PG8_BAR; PG8_SCHED;
            PG8_LDA(At, 1, 1); PG8_STAGE(PG8_SB(1, 0), b3, voffB); PG8_STAGE(PG8_SB(1, 1), b3 + hstepB, voffB); PG8_STAGE(PG8_SA(1, 0), a3, voffA);
            PG8_WAIT_V(8); PG8_WAIT_L(0); PG8_BAR; PG8_MMA(1, 0, At, B0); PG8_MMA(1, 1, At, B1); PG8_BAR; PG8_SCHED;
            } else {
            PG8_LDB(B0, 0, 0); PG8_SCHED; PG8_LDA(At, 0, 0); PG8_STAGE(PG8_SA(1, 1), a1 + hstepB, voffA);
            PG8_WAIT_L(8); PG8_BAR; PG8_WAIT_L(0); PG8_MMA(0, 0, At, B0); PG8_BAR; PG8_SCHED;
            PG8_LDB(B1, 0, 1); PG8_STAGE(PG8_SB(0, 0), b2, voffB);
            PG8_BAR; PG8_WAIT_L(0); PG8_MMA(0, 1, At, B1); PG8_BAR;
            PG8_LDA(At, 0, 1); PG8_STAGE(PG8_SA(0, 0), a2, voffA);
            PG8_BAR; PG8_WAIT_L(0); PG8_MMA(1, 0, At, B0); PG8_BAR; PG8_SCHED;
            PG8_STAGE(PG8_SB(0, 1), b2 + hstepB, voffB);
            PG8_WAIT_V(6); PG8_BAR; PG8_MMA(1, 1, At, B1); PG8_BAR;
            PG8_LDB(B0, 1, 0); PG8_SCHED; PG8_LDA(At, 1, 0); PG8_STAGE(PG8_SA(0, 1), a2 + hstepB, voffA);
            PG8_WAIT_L(8); PG8_BAR; PG8_WAIT_L(0); PG8_MMA(0, 0, At, B0); PG8_BAR; PG8_SCHED;
            PG8_LDB(B1, 1, 1); PG8_STAGE(PG8_SB(1, 0), b3, voffB);
            PG8_BAR; PG8_WAIT_L(0); PG8_MMA(0, 1, At, B1); PG8_BAR;
            PG8_LDA(At, 1, 1); PG8_STAGE(PG8_SA(1, 0), a3, voffA);
            PG8_BAR; PG8_WAIT_L(0); PG8_MMA(1, 0, At, B0); PG8_BAR; PG8_SCHED;
            PG8_STAGE(PG8_SB(1, 1), b3 + hstepB, voffB);
            PG8_WAIT_V(6); PG8_BAR; PG8_MMA(1, 1, At, B1); PG8_BAR;
            }
        }
        if constexpr (ALIGN_EPI) { if (wr == 0) PG8_BAR; }
        if constexpr (!Epi::AFTER_DRAIN) { E(acc, cur, wr, wc, fr, fq); S.done(cur); }
        if (!has_next) break;
#pragma unroll
        for (int a = 0; a < 2; ++a)
#pragma unroll
            for (int b = 0; b < 2; ++b)
#pragma unroll
                for (int m = 0; m < 4; ++m)
#pragma unroll
                    for (int n = 0; n < 2; ++n) acc[a][b][m][n] = (f32x4){0.f, 0.f, 0.f, 0.f};
        cur = nxt; cA = nA; cB = nB; ++ui;
        if constexpr (ALIGN_EPI) { if (wr == 1) PG8_BAR; }
    }
    PG8_WAIT_V(0);
    if constexpr (!ALIGN_EPI) { if (wr == 0) PG8_BAR; }
    PG8_BAR;
    if constexpr (Epi::AFTER_DRAIN) { E.fused(acc, cur, wr, wc, fr, fq, lds, wid, lane); S.done(cur); }
#undef PG8_SA
#undef PG8_SB
#undef PG8_STAGE
#undef PG8_LDA
#undef PG8_LDB
#undef PG8_MMA
#undef PG8_WAIT_V
#undef PG8_WAIT_L
#undef PG8_BAR
#undef PG8_SCHED
}
}
namespace attn_body {
using bf16=__hip_bfloat16;
using bf16x8=__attribute__((ext_vector_type(8)))short;
using s16x4=__attribute__((ext_vector_type(4)))short;
using f32x16=__attribute__((ext_vector_type(16)))float;
using u32x4=__attribute__((ext_vector_type(4)))unsigned;
constexpr int BATCH=2,SEQ=8192,D=64,PIN=7168,POUT=2048;
constexpr int NW=8,QBLK=32,QB=QBLK*NW,KVBLK=64,NQB=SEQ/QB;
constexpr int ATTN_UNIT_ROWS=QB;
__device__ __forceinline__ int crow(int r,int hi){return (r&3)+8*(r>>2)+4*hi;}
#define SBAR() __builtin_amdgcn_sched_barrier(0)
__device__ __forceinline__ void cmask(f32x16&p0,f32x16&p1,int jb,int qrel,int hi){
  const float NEG=-INFINITY; int kb=64*jb+4*hi;
  #pragma unroll
  for(int r=0;r<16;++r){int kv=kb+(r&3)+8*(r>>2); if(kv>qrel)p0[r]=NEG; if(kv+32>qrel)p1[r]=NEG;}
}

constexpr int NSLOT=3, SLOTB=8192;
constexpr int VSLOTB=2*SLOTB;
constexpr int LDS_K=0, LDS_V=NSLOT*SLOTB, LDS_WS=LDS_V+NSLOT*VSLOTB, LDS_OST=LDS_WS+NW*64*4, LDS_BYTES=LDS_OST+NW*4096;
constexpr float C2=0.125f*1.4426950408889634f;
__device__ __forceinline__ void glds16(const void*gsrc,unsigned lds_dst){unsigned keep;
  asm volatile("s_mov_b32 %0, m0\n\ts_mov_b32 m0, %2\n\ts_nop 0\n\tglobal_load_lds_dwordx4 %1, off\n\ts_mov_b32 m0, %0":"=&s"(keep):"v"(gsrc),"s"(lds_dst):"memory");}
__device__ __forceinline__ float max3f(float a,float b,float c){float r;asm("v_max3_f32 %0, %1, %2, %3":"=v"(r):"v"(a),"v"(b),"v"(c));return r;}
__device__ __forceinline__ float max2f(float a,float b){float r;asm("v_max_f32_e32 %0, %1, %2":"=v"(r):"v"(a),"v"(b));return r;}
__device__ __forceinline__ float fadd_s(float a,float b){float r;asm("v_add_f32_e32 %0, %1, %2":"=v"(r):"v"(a),"v"(b));return r;}
__device__ __forceinline__ float fsub_s(float a,float b){float r;asm("v_sub_f32_e32 %0, %1, %2":"=v"(r):"v"(a),"v"(b));return r;}
typedef float f32x2_t __attribute__((ext_vector_type(2))); typedef __bf16 bf16x2_t __attribute__((ext_vector_type(2)));
__device__ __forceinline__ unsigned cvtpk_s(float lo,float hi){f32x2_t v={lo,hi};bf16x2_t b=__builtin_convertvector(v,bf16x2_t);return __builtin_bit_cast(unsigned,b);}
#define WAIT_BAR(N) asm volatile("s_waitcnt vmcnt(" #N ") lgkmcnt(0)\n\ts_barrier":::"memory")

__device__ __forceinline__ void qkt(f32x16&p0,f32x16&p1,const char*Kslot,const bf16x8*qr,const f32x16&negm,int r32,int hi){
  const char*kb=Kslot+hi*1024+r32*16;
  #pragma unroll
  for(int d0=0;d0<4;++d0){
    const bf16x8 b0=*reinterpret_cast<const bf16x8*>(kb+d0*2048);
    const bf16x8 b1=*reinterpret_cast<const bf16x8*>(kb+d0*2048+512);
    if(d0==0){p0=__builtin_amdgcn_mfma_f32_32x32x16_bf16(b0,qr[0],negm,0,0,0);p1=__builtin_amdgcn_mfma_f32_32x32x16_bf16(b1,qr[0],negm,0,0,0);}
    else{p0=__builtin_amdgcn_mfma_f32_32x32x16_bf16(b0,qr[d0],p0,0,0,0);p1=__builtin_amdgcn_mfma_f32_32x32x16_bf16(b1,qr[d0],p1,0,0,0);}}
}
typedef __attribute__((address_space(3))) const char* lds_cptr;
typedef short v4i16_t __attribute__((ext_vector_type(4)));
__device__ __forceinline__ void kload8(bf16x8*kf,lds_cptr kp){
  kf[0]=*(const __attribute__((address_space(3))) bf16x8*)(kp);      kf[1]=*(const __attribute__((address_space(3))) bf16x8*)(kp+512);
  kf[2]=*(const __attribute__((address_space(3))) bf16x8*)(kp+2048); kf[3]=*(const __attribute__((address_space(3))) bf16x8*)(kp+2560);
  kf[4]=*(const __attribute__((address_space(3))) bf16x8*)(kp+4096); kf[5]=*(const __attribute__((address_space(3))) bf16x8*)(kp+4608);
  kf[6]=*(const __attribute__((address_space(3))) bf16x8*)(kp+6144); kf[7]=*(const __attribute__((address_space(3))) bf16x8*)(kp+6656);
}
__device__ __forceinline__ void kload2(bf16x8*kf,lds_cptr kp,int j){ kf[2*j]=*(const __attribute__((address_space(3))) bf16x8*)(kp+j*2048); kf[2*j+1]=*(const __attribute__((address_space(3))) bf16x8*)(kp+j*2048+512); }
__device__ __forceinline__ s16x4 vtr(lds_cptr p){ return __builtin_bit_cast(s16x4,__builtin_amdgcn_ds_read_tr16_b64_v4i16((__attribute__((address_space(3))) v4i16_t*)p)); }
__device__ __forceinline__ float rowmax(const f32x16&p0,const f32x16&p1){
  float a=max3f(p0[0],p0[1],p1[0]),b=max3f(p0[2],p0[3],p1[1]);a=max3f(a,p1[2],p1[3]);
  #pragma unroll
  for(int r=4;r<16;r+=4){a=max3f(a,p0[r],p0[r+1]);b=max3f(b,p0[r+2],p0[r+3]);a=max3f(a,p1[r],p1[r+1]);b=max3f(b,p1[r+2],p1[r+3]);}
  const float m=max2f(a,b);
  auto rr=__builtin_amdgcn_permlane32_swap(__float_as_uint(m),__float_as_uint(m),false,false);
  return max2f(__uint_as_float(rr[0]),__uint_as_float(rr[1]));
}
__device__ __forceinline__ void pv(f32x16*o,int vb,bf16x8 pa0,bf16x8 pa1,bf16x8 pa2,bf16x8 pa3){
  #pragma unroll
  for(int d0=0;d0<2;++d0){s16x4 lo[4],hi[4];
    #pragma unroll
    for(int ks=0;ks<4;++ks){
      asm volatile("ds_read_b64_tr_b16 %0,%1 offset:%c2":"=&v"(lo[ks]):"v"(vb),"i"(d0*4096+ks*1024):"memory");
      asm volatile("ds_read_b64_tr_b16 %0,%1 offset:%c2":"=&v"(hi[ks]):"v"(vb),"i"(d0*4096+ks*1024+512):"memory");}
    asm volatile("s_waitcnt lgkmcnt(0)":::"memory");SBAR();
    #define PK(k) (bf16x8){lo[k][0],lo[k][1],lo[k][2],lo[k][3],hi[k][0],hi[k][1],hi[k][2],hi[k][3]}
    o[d0]=__builtin_amdgcn_mfma_f32_32x32x16_bf16(pa0,PK(0),o[d0],0,0,0);
    o[d0]=__builtin_amdgcn_mfma_f32_32x32x16_bf16(pa1,PK(1),o[d0],0,0,0);
    o[d0]=__builtin_amdgcn_mfma_f32_32x32x16_bf16(pa2,PK(2),o[d0],0,0,0);
    o[d0]=__builtin_amdgcn_mfma_f32_32x32x16_bf16(pa3,PK(3),o[d0],0,0,0);
    #undef PK
  }
}

#ifndef ATTN_STORE16
#define ATTN_STORE16(p,v) (*(u32x4*)(p)=(v))
#endif
template<int THRL> __device__ __forceinline__ void attn_unit(int b,int qcol,int kcol,int vcol,int ocol,int qb,const bf16*__restrict__ P,bf16*__restrict__ O,char*shm){
  int tid_o=threadIdx.x; asm volatile("":"+v"(tid_o)); const int tid=tid_o,lane=tid&63,r32=lane&31,hi=lane>>5; const int wid=__builtin_amdgcn_readfirstlane(tid>>6);
  const long rowbase=(long)b*SEQ; const int q0=qb*QB;
  const bf16*Qw=P+(rowbase+q0+wid*QBLK)*PIN+qcol;
  const bf16*Kh=P+rowbase*PIN+kcol,*Vh=P+rowbase*PIN+vcol;
  const unsigned lds0=(unsigned)(uintptr_t)shm;
  float*wsf=(float*)(shm+LDS_WS)+wid*64;
  const bf16*ksrc=Kh+(long)lane*PIN+wid*8;
  const bf16*vsrc=Vh+(long)(16*(wid&3)+(lane>>2))*PIN+(wid>>2)*32+(lane&3)*8;
  const unsigned kdst=lds0+LDS_K+wid*1024, vdst=lds0+LDS_V+wid*1024;
  #define DMA_K(t,slot) glds16(ksrc+(long)(t)*KVBLK*PIN,(unsigned)__builtin_amdgcn_readfirstlane(kdst+(slot)))
  #define DMA_V(t,slot) do{ glds16(vsrc+(long)(t)*KVBLK*PIN,(unsigned)__builtin_amdgcn_readfirstlane(vdst+2*(slot))); glds16(vsrc+(long)(t)*KVBLK*PIN+64,(unsigned)__builtin_amdgcn_readfirstlane(vdst+2*(slot)+SLOTB)); }while(0)
  const int vb0=(int)(lds0+LDS_V)+((lane>>4)&1)*32+(lane&3)*8+(4*hi+((lane&15)>>2))*64;
  const char*Kbase=shm+LDS_K; bf16x8 kf[8];
  const lds_cptr shm3=(lds_cptr)shm; const lds_cptr kp0=shm3+LDS_K+hi*1024+r32*16; const lds_cptr vp0=shm3+LDS_V+((lane>>4)&1)*32+(lane&3)*8+(4*hi+((lane&15)>>2))*64;
  const int NT=(q0+QB)/KVBLK;
  DMA_K(0,0);DMA_V(0,0);DMA_K(1,SLOTB);
  bf16x8 qr[4];
  #pragma unroll
  for(int d0=0;d0<4;++d0)qr[d0]=*reinterpret_cast<const bf16x8*>(&Qw[(long)r32*PIN+d0*16+hi*8]);
  float mhat=0.f,l_reg=0.f;f32x16 o[4];o[0]=f32x16{};o[1]=f32x16{};o[2]=f32x16{};o[3]=f32x16{};f32x16 negm=f32x16{};asm volatile("":"+v"(negm));
  const int qrel=wid*QBLK+r32;
  #define CMASK(P0,P1,t) do{int jb_=(t)-(NT-4); if(jb_>=0)cmask(P0,P1,jb_,qrel,hi);}while(0)
  bool resc=false;
  #define START(P0,P1) do{ const float rm=rowmax(P0,P1); resc=false; \
    { const float dl=rm; mhat=fadd_s(mhat,dl); \
      _Pragma("unroll") for(int r=0;r<16;++r){P0[r]=fsub_s(P0[r],dl);P1[r]=fsub_s(P1[r],dl);} \
      _Pragma("unroll") for(int r=0;r<16;++r)negm[r]=-mhat; asm volatile("":"+v"(negm)); } \
    _Pragma("unroll") for(int r=0;r<16;++r)P0[r]=__builtin_amdgcn_exp2f(P0[r]); }while(0)
  #define RESC() do{ if(resc){ asm volatile("s_waitcnt lgkmcnt(0)":::"memory"); \
      _Pragma("unroll") for(int d_=0;d_<4;++d_) _Pragma("unroll") for(int r=0;r<16;++r)o[d_][r]*=wsf[crow(r,hi)]; } }while(0)
  f32x16 pA0,pA1,pB0,pB1;
  int sl_prev=0,sl_cur=0,sl_next=SLOTB;
  #define ROT() do{sl_prev=sl_cur;sl_cur=sl_next;sl_next=(sl_next==(NSLOT-1)*SLOTB)?0:sl_next+SLOTB;}while(0)
  DMA_K(2,2*SLOTB);
  WAIT_BAR(4);
  qkt(pA0,pA1,Kbase,qr,negm,r32,hi);asm volatile("s_nop 15\n\ts_nop 7":"+v"(pA0),"+v"(pA1));CMASK(pA0,pA1,0);
  START(pA0,pA1);
  _Pragma("unroll") for(int r=0;r<16;++r)pA1[r]=__builtin_amdgcn_exp2f(pA1[r]);
  WAIT_BAR(0);
  DMA_K(3,0);DMA_V(1,SLOTB);
  ROT();
  kload8(kf,kp0+sl_cur);
  WAIT_BAR(3);
  s16x4 vlo[8],vhi[8]; u32x4 pw0,pw1,pw2,pw3;
  #define PKW(P,B) cvtpk_s(P[B],P[B+1])
  #define PAF(k) __builtin_bit_cast(bf16x8,pw##k)
  #define VFR(i) (bf16x8){vlo[i][0],vlo[i][1],vlo[i][2],vlo[i][3],vhi[i][0],vhi[i][1],vhi[i][2],vhi[i][3]}
  #define PIN(x) asm volatile("":"+v"(x))
  #define MX3(a,b,c) __builtin_fmaxf(__builtin_fmaxf((a),(b)),(c))
  #define GAPA(MF,A0,A1,A2,A3,W0,W1,PW) do{ MF; sacc+=A0; sacc+=A1; sacc+=A2; sacc+=A3; PIN(sacc); W0; W1; PIN(PW); SBAR(); }while(0)
  #define EX(v) __builtin_amdgcn_exp2f(v)
  #define GAPB(MF,X,B) do{ MF; X[B]=EX(X[B]); X[B+1]=EX(X[B+1]); X[B+2]=EX(X[B+2]); X[B+3]=EX(X[B+3]); PIN(X); SBAR(); }while(0)
  #define VRD(i) do{ vlo[i]=vtr(vp_+(((i)>>2)*4096+((i)&3)*1024)); vhi[i]=vtr(vp_+(((i)>>2)*4096+((i)&3)*1024+512)); }while(0)
  #define VRD2(i) do{ vlo[i]=vtr(vp_+(SLOTB+((i)>>2)*4096+((i)&3)*1024)); vhi[i]=vtr(vp_+(SLOTB+((i)>>2)*4096+((i)&3)*1024+512)); SBAR(); }while(0)
  #define GAPB2(MF,X,B) do{ MF; X[B]=EX(X[B]); X[B+1]=EX(X[B+1]); PIN(X); SBAR(); }while(0)
  #define KRD(G,j) do{ if(G){ kload2(kf,kp0+sl_next,j); SBAR(); } }while(0)
  #define STEP(C0,C1,P0,P1,t,GK,GV,GL) do{ SBAR(); \
    const lds_cptr vp_=vp0+2*sl_prev; \
    VRD(0); SBAR(); float sacc=(P0[0]+P0[1]); \
    GAPA(C0=__builtin_amdgcn_mfma_f32_32x32x16_bf16(kf[0],qr[0],negm,0,0,0), P0[2],P0[3],P0[4],P0[5],     pw0[0]=PKW(P0,0), pw0[1]=PKW(P0,2), pw0); \
    VRD(4); SBAR(); GAPA(C1=__builtin_amdgcn_mfma_f32_32x32x16_bf16(kf[1],qr[0],negm,0,0,0), P0[6],P0[7],P0[8],P0[9],     pw0[2]=PKW(P0,4), pw0[3]=PKW(P0,6), pw0); \
    VRD(1); SBAR(); GAPA(C0=__builtin_amdgcn_mfma_f32_32x32x16_bf16(kf[2],qr[1],C0,0,0,0),   P0[10],P0[11],P0[12],P0[13], pw1[0]=PKW(P0,8), pw1[1]=PKW(P0,10), pw1); \
    VRD(5); SBAR(); GAPA(C1=__builtin_amdgcn_mfma_f32_32x32x16_bf16(kf[3],qr[1],C1,0,0,0),   P0[14],P0[15],P1[0],P1[1],   pw1[2]=PKW(P0,12),pw1[3]=PKW(P0,14), pw1); \
    VRD(2); SBAR(); GAPA(C0=__builtin_amdgcn_mfma_f32_32x32x16_bf16(kf[4],qr[2],C0,0,0,0),   P1[2],P1[3],P1[4],P1[5],     pw2[0]=PKW(P1,0), pw2[1]=PKW(P1,2), pw2); \
    VRD(6); SBAR(); GAPA(C1=__builtin_amdgcn_mfma_f32_32x32x16_bf16(kf[5],qr[2],C1,0,0,0),   P1[6],P1[7],P1[8],P1[9],     pw2[2]=PKW(P1,4), pw2[3]=PKW(P1,6), pw2); \
    VRD(3); SBAR(); GAPA(C0=__builtin_amdgcn_mfma_f32_32x32x16_bf16(kf[6],qr[3],C0,0,0,0),   P1[10],P1[11],P1[12],P1[13], pw3[0]=PKW(P1,8), pw3[1]=PKW(P1,10), pw3); \
    VRD(7); SBAR(); GAPA(C1=__builtin_amdgcn_mfma_f32_32x32x16_bf16(kf[7],qr[3],C1,0,0,0),   P1[14],P1[15],0.f,0.f,       pw3[2]=PKW(P1,12),pw3[3]=PKW(P1,14), pw3); \
    l_reg+=sacc; \
    if(GK){DMA_K((t)+3,sl_cur);} if(GV){DMA_V((t)+1,sl_next);} \
    CMASK(C0,C1,t); \
    { float a=MX3(C0[0],C0[1],C1[0]),b=MX3(C0[2],C0[3],C1[1]); a=MX3(a,C1[2],C1[3]); \
      _Pragma("unroll") for(int r=4;r<16;r+=4){a=MX3(a,C0[r],C0[r+1]);b=MX3(b,C0[r+2],C0[r+3]);a=MX3(a,C1[r],C1[r+1]);b=MX3(b,C1[r+2],C1[r+3]);} \
      float rm=__builtin_fmaxf(a,b); { auto rr=__builtin_amdgcn_permlane32_swap(__float_as_uint(rm),__float_as_uint(rm),false,false); rm=__builtin_fmaxf(__uint_as_float(rr[0]),__uint_as_float(rr[1])); } \
      resc=false; \
      if(__builtin_expect(__any(rm>(float)THRL),0)){ const float dl=__builtin_fmaxf(rm,0.f); mhat+=dl; \
        _Pragma("unroll") for(int r=0;r<16;++r){C0[r]-=dl;C1[r]-=dl;} \
        _Pragma("unroll") for(int r=0;r<16;++r)negm[r]=-mhat; asm volatile("":"+v"(negm)); \
        const float f=__builtin_amdgcn_exp2f(-dl); l_reg*=f; if(hi==0)wsf[r32]=f; resc=true; } } \
    SBAR(); \
    GAPB2(o[0]=__builtin_amdgcn_mfma_f32_32x32x16_bf16(PAF(0),VFR(0),o[0],0,0,0), C0,0); VRD2(0); \
    GAPB2(o[1]=__builtin_amdgcn_mfma_f32_32x32x16_bf16(PAF(0),VFR(4),o[1],0,0,0), C0,2); VRD2(4); \
    KRD(GL,0); GAPB2(o[0]=__builtin_amdgcn_mfma_f32_32x32x16_bf16(PAF(1),VFR(1),o[0],0,0,0), C0,4); VRD2(1); \
    KRD(GL,1); GAPB2(o[1]=__builtin_amdgcn_mfma_f32_32x32x16_bf16(PAF(1),VFR(5),o[1],0,0,0), C0,6); VRD2(5); \
    KRD(GL,2); GAPB2(o[0]=__builtin_amdgcn_mfma_f32_32x32x16_bf16(PAF(2),VFR(2),o[0],0,0,0), C0,8); VRD2(2); \
    KRD(GL,3); GAPB2(o[1]=__builtin_amdgcn_mfma_f32_32x32x16_bf16(PAF(2),VFR(6),o[1],0,0,0), C0,10); VRD2(6); \
    GAPB2(o[0]=__builtin_amdgcn_mfma_f32_32x32x16_bf16(PAF(3),VFR(3),o[0],0,0,0), C0,12); VRD2(3); \
    GAPB2(o[1]=__builtin_amdgcn_mfma_f32_32x32x16_bf16(PAF(3),VFR(7),o[1],0,0,0), C0,14); VRD2(7); \
    GAPB2(o[2]=__builtin_amdgcn_mfma_f32_32x32x16_bf16(PAF(0),VFR(0),o[2],0,0,0), C1,0); \
    GAPB2(o[3]=__builtin_amdgcn_mfma_f32_32x32x16_bf16(PAF(0),VFR(4),o[3],0,0,0), C1,2); \
    GAPB2(o[2]=__builtin_amdgcn_mfma_f32_32x32x16_bf16(PAF(1),VFR(1),o[2],0,0,0), C1,4); \
    GAPB2(o[3]=__builtin_amdgcn_mfma_f32_32x32x16_bf16(PAF(1),VFR(5),o[3],0,0,0), C1,6); \
    GAPB2(o[2]=__builtin_amdgcn_mfma_f32_32x32x16_bf16(PAF(2),VFR(2),o[2],0,0,0), C1,8); \
    GAPB2(o[3]=__builtin_amdgcn_mfma_f32_32x32x16_bf16(PAF(2),VFR(6),o[3],0,0,0), C1,10); \
    GAPB2(o[2]=__builtin_amdgcn_mfma_f32_32x32x16_bf16(PAF(3),VFR(3),o[2],0,0,0), C1,12); \
    GAPB2(o[3]=__builtin_amdgcn_mfma_f32_32x32x16_bf16(PAF(3),VFR(7),o[3],0,0,0), C1,14); \
    }while(0)
  int t=1;
  #undef CMASK
  #define CMASK(P0,P1,t) do{}while(0)
  for(;t+5<NT;t+=2){
    STEP(pB0,pB1,pA0,pA1,t,true,true,true);     WAIT_BAR(3); RESC(); ROT();
    STEP(pA0,pA1,pB0,pB1,t+1,true,true,true);   WAIT_BAR(3); RESC(); ROT();
  }
  #undef CMASK
  #define CMASK(P0,P1,t) do{int jb_=(t)-(NT-4); if(jb_>=0)cmask(P0,P1,jb_,qrel,hi);}while(0)
  #define ENDW(tt) do{ if((tt)+3<NT){WAIT_BAR(3);} else if((tt)+2<NT){WAIT_BAR(2);} else {WAIT_BAR(0);} }while(0)
  for(;t+1<NT;t+=2){
    STEP(pB0,pB1,pA0,pA1,t,(t+3<NT),(t+1<NT),(t+1<NT));       ENDW(t);   RESC(); ROT();
    STEP(pA0,pA1,pB0,pB1,t+1,(t+4<NT),(t+2<NT),(t+2<NT));     ENDW(t+1); RESC(); ROT();
  }
  STEP(pB0,pB1,pA0,pA1,NT-1,false,false,false); RESC();
  { float sacc=pB0[0]+pB0[1]; _Pragma("unroll") for(int r=2;r<16;++r)sacc+=pB0[r]; _Pragma("unroll") for(int r=0;r<16;++r)sacc+=pB1[r]; l_reg+=sacc;
    pw0=(u32x4){PKW(pB0,0),PKW(pB0,2),PKW(pB0,4),PKW(pB0,6)};pw1=(u32x4){PKW(pB0,8),PKW(pB0,10),PKW(pB0,12),PKW(pB0,14)};pw2=(u32x4){PKW(pB1,0),PKW(pB1,2),PKW(pB1,4),PKW(pB1,6)};pw3=(u32x4){PKW(pB1,8),PKW(pB1,10),PKW(pB1,12),PKW(pB1,14)};
    SBAR(); pv(o,vb0+2*sl_cur,PAF(0),PAF(1),PAF(2),PAF(3)); pv(o+2,vb0+2*sl_cur+SLOTB,PAF(0),PAF(1),PAF(2),PAF(3)); }
  #undef PKW
  #undef PAF
  #undef VFR
  #undef PIN
  #undef MX3
  #undef GAPA
  #undef GAPB
  #undef EX
  #undef VRD
  #undef VRD2
  #undef GAPB2
  #undef KRD
  #undef STEP
  #undef ENDW
  {auto rr=__builtin_amdgcn_permlane32_swap(__float_as_uint(l_reg),__float_as_uint(l_reg),false,false);l_reg=__uint_as_float(rr[0])+__uint_as_float(rr[1]);}
  if(hi==0)wsf[32+r32]=l_reg;asm volatile("s_waitcnt lgkmcnt(0)":::"memory");
  float rli[16];
  #pragma unroll
  for(int r=0;r<16;++r)rli[r]=__builtin_amdgcn_rcpf(wsf[32+crow(r,hi)]);
  bf16*Ow=O+(rowbase+q0+wid*QBLK)*POUT+ocol;
  { bf16*stg=(bf16*)(shm+LDS_OST)+wid*2048;
    #pragma unroll
    for(int vh=0;vh<2;++vh){
    #pragma unroll
    for(int r=0;r<16;++r){const int orow=crow(r,hi);
      #pragma unroll
      for(int d0=0;d0<2;++d0)stg[orow*64+d0*32+r32]=__float2bfloat16(o[2*vh+d0][r]*rli[r]);}
    asm volatile("s_waitcnt lgkmcnt(0)":::"memory");
    #pragma unroll
    for(int i=0;i<4;++i){const int row=i*8+(lane>>3),ch=lane&7; const u32x4 v=*(const u32x4*)(stg+row*64+ch*8); ATTN_STORE16(Ow+(long)row*POUT+vh*64+ch*8,v);}
    asm volatile("s_waitcnt lgkmcnt(0)":::"memory"); } }
  asm volatile("s_waitcnt lgkmcnt(0)\n\ts_barrier":::"memory");
  #undef DMA_K
  #undef DMA_V
  #undef CMASK
  #undef START
  #undef RESC
  #undef ROT
}
constexpr int ATTN_LDS_BYTES=LDS_BYTES;
#undef SBAR
#undef WAIT_BAR
}
#define GAS __attribute__((address_space(1)))
#define LAS __attribute__((address_space(3)))
typedef unsigned short bf16;
typedef unsigned v4u __attribute__((ext_vector_type(4)));
typedef unsigned v2u __attribute__((ext_vector_type(2)));
typedef float f32x4 __attribute__((ext_vector_type(4)));
typedef short bf16x8 __attribute__((ext_vector_type(8)));
#define LDS_WAIT() asm volatile("s_waitcnt lgkmcnt(0)" ::: "memory")

#ifndef HGRN_NAIVE
#define HGRN_NAIVE 0
#endif
constexpr int NWAVES = 8, NTHREADS = 512;
constexpr int BATCH = 2, SEQ = 8192, DM = 2048, M = BATCH * SEQ, DFF = 5632, INW = 7168, AW = 1024, HW = 1024, NH = 8;
constexpr int C_QA = 0, C_KA = 1024, C_VA = 2048, C_QH = 3072, C_FH = 4096, C_IH = 5120, C_GH = 6144;
constexpr float NORM_EPS = 1e-6f, SUBLN_EPS = 1e-5f;
constexpr int LDS_BYTES = 147456, RING_BYTES = 131072;

constexpr size_t SZ_WGU = (size_t)2 * DFF * DM * 2, SZ_WD = (size_t)DM * DFF * 2, SZ_WIN = (size_t)INW * DM * 2, SZ_WOUT = (size_t)DM * DM * 2;
constexpr size_t WS_WGU1 = 0, WS_WD1 = WS_WGU1 + SZ_WGU, WS_WIN = WS_WD1 + SZ_WD, WS_WOUT = WS_WIN + SZ_WIN, WS_WGU2 = WS_WOUT + SZ_WOUT, WS_WD2 = WS_WGU2 + SZ_WGU;
constexpr size_t WS_XN = WS_WD2 + SZ_WD;
constexpr size_t WS_MIX = WS_XN + (size_t)M * DM * 2;
constexpr size_t WS_BIG = WS_MIX + (size_t)M * DM * 2;
constexpr size_t WS_ATTO = WS_BIG + (size_t)M * INW * 2;
constexpr size_t WS_ST = WS_ATTO + (size_t)M * DM * 2;
constexpr size_t WS_DEC = WS_ST + (size_t)2048 * 128 * 128 * 2;
constexpr size_t WS_BAR = WS_DEC + (size_t)2048 * 128 * 4;
constexpr size_t WS_SSQ = WS_BAR + 16384;
constexpr size_t WS_END = WS_SSQ + (size_t)7 * M * 32 * 4;

__device__ __forceinline__ unsigned f2bf(float f) { unsigned u = __builtin_bit_cast(unsigned, f); return (u + 0x7fffu + ((u >> 16) & 1u)) >> 16; }
__device__ __forceinline__ unsigned pk2(float lo, float hi) { return f2bf(lo) | (f2bf(hi) << 16); }
__device__ __forceinline__ float bf2f(unsigned short b) { return __builtin_bit_cast(float, (unsigned)b << 16); }
using pg8::shx;
__device__ __forceinline__ float wave_sum(float v, int lane) {
#pragma unroll
    for (int o = 1; o < 64; o <<= 1) v += shx(v, lane, o);
    return v;
}

#define RLX_AGENT __ATOMIC_RELAXED, __HIP_MEMORY_SCOPE_AGENT
#define XB_TMO      128
#define XB_XCNT(j)  (256  + 64 * (j))
#define XB_XSUB(j)  (1280 + 64 * (j))
#define XB_XGEN(j)  (2304 + 64 * (j))
#define XB_TOP      3328
#define XB_TOPGEN   3392
#define XCD_BAR_WORDS 3456
#define XB_SPIN_CAP (1u << 18)

__device__ __forceinline__ unsigned xb_ld(unsigned* p)              { return __hip_atomic_load(p, __ATOMIC_RELAXED, __HIP_MEMORY_SCOPE_AGENT); }
__device__ __forceinline__ unsigned xb_add(unsigned* p, unsigned v) { return __hip_atomic_fetch_add(p, v, __ATOMIC_RELAXED, __HIP_MEMORY_SCOPE_AGENT); }
__device__ __forceinline__ unsigned xb_xcc_id() { return (unsigned)__builtin_amdgcn_s_getreg((3 << 11) | 20) & 0xFu; }
#define XB_SPIN(cond, bar) do { unsigned _sp = 0; while (cond) { __builtin_amdgcn_s_sleep(1); \
    if ((++_sp & 255u) == 0u) { if (xb_ld(&(bar)[XB_TMO])) break; if (_sp > XB_SPIN_CAP) { atomicAdd(&(bar)[XB_TMO], 1u); break; } } } } while (0)

struct XcdBarrier {
    unsigned* bar; unsigned x;
    volatile LAS unsigned* st;
};

__device__ __forceinline__ XcdBarrier xcd_barrier_post(unsigned* bar, volatile LAS unsigned* st) {
    XcdBarrier b; b.bar = bar; b.x = xb_xcc_id(); b.st = st;
    if (threadIdx.x == 0) (void)xb_add(&bar[XB_XCNT(b.x)], 1u);
    return b;
}
__device__ __forceinline__ void xcd_barrier_complete(unsigned* bar, unsigned x, unsigned& nloc, unsigned& nx) {
    const unsigned G = gridDim.x * gridDim.y * gridDim.z;
    unsigned sum, cnt, mine, sp = 0u;
    for (;;) {
        sum = 0u; cnt = 0u; mine = 0u;
#pragma unroll
        for (unsigned j = 0; j < 16; ++j) { const unsigned c = xb_ld(&bar[XB_XCNT(j)]); sum += c; cnt += (c > 0u) ? 1u : 0u; mine = (j == x) ? c : mine; }
        if (sum == G) break;
        __builtin_amdgcn_s_sleep(1);
        if ((++sp & 255u) == 0u) { if (xb_ld(&bar[XB_TMO])) break; if (sp > XB_SPIN_CAP) { atomicAdd(&bar[XB_TMO], 1u); break; } }
    }
    nloc = mine > 0u ? mine : 1u; nx = cnt > 0u ? cnt : 1u;
}

__device__ __forceinline__ void xcd_barrier(const XcdBarrier& b) {
    asm volatile("s_waitcnt vmcnt(0)" ::: "memory");
    __syncthreads();
    if (threadIdx.x == 0) {
        unsigned* bar = b.bar;
        __builtin_amdgcn_s_waitcnt(0);
        unsigned nloc = b.st[0], nx = b.st[1];
        if (nloc == 0u) { xcd_barrier_complete(bar, b.x, nloc, nx); b.st[0] = nloc; b.st[1] = nx; }
        const unsigned old = xb_add(&bar[XB_XSUB(b.x)], 1u);
        const unsigned gen = old / nloc;
        if (old + 1u == (gen + 1u) * nloc) {
            __builtin_amdgcn_fence(__ATOMIC_RELEASE, "agent");
            asm volatile("s_waitcnt vmcnt(0)" ::: "memory");
            const unsigned og = xb_add(&bar[XB_TOP], 1u);
            const unsigned tg = og / nx;
            if (og + 1u == (tg + 1u) * nx) xb_add(&bar[XB_TOPGEN], 1u);
            else XB_SPIN(xb_ld(&bar[XB_TOPGEN]) == tg, bar);
            __builtin_amdgcn_fence(__ATOMIC_ACQUIRE, "agent");
            xb_add(&bar[XB_XGEN(b.x)], 1u);
            asm volatile("s_waitcnt vmcnt(0)" ::: "memory");
        } else {
            XB_SPIN(xb_ld(&bar[XB_XGEN(b.x)]) == gen, bar);
            __builtin_amdgcn_fence(__ATOMIC_ACQUIRE, "agent");
            asm volatile("s_waitcnt vmcnt(0)" ::: "memory");
        }
    }
    __syncthreads();
}

struct Args { const float* in[20]; float* out; unsigned char* ws; int ph_lo, ph_hi; };

__device__ __forceinline__ void transpose_item(const float* W, int K, int N, bf16* WT, int mode, const float* nw, LAS float* scr, int item, int lane) {
    const int nblk = N / 32, kb = item / nblk, nb = item % nblk, k0 = 64 * kb, n0 = 32 * nb;
    const int drow0 = (mode == 0) ? n0 : ((n0 >> 7) * 256 + (n0 & 127) + (mode == 2 ? 128 : 0));
#pragma unroll 8
    for (int i = 0; i < 32; ++i) { const int kk = 2 * i + (lane >> 5); scr[kk * 33 + (lane & 31)] = W[(size_t)(k0 + kk) * N + n0 + (lane & 31)]; }
    LDS_WAIT(); asm volatile("" ::: "memory");
    const int c = lane & 7;
    f32x4 na = {1.f, 1.f, 1.f, 1.f}, nb2 = na;
    if (nw) { na = *(const GAS f32x4*)(nw + k0 + 8 * c); nb2 = *(const GAS f32x4*)(nw + k0 + 8 * c + 4); }
#pragma unroll
    for (int j = 0; j < 4; ++j) { const int n = (lane >> 3) + 8 * j; const LAS float* s = scr + (8 * c) * 33 + n;
        v4u o; o.x = pk2(s[0 * 33] * na.x, s[1 * 33] * na.y); o.y = pk2(s[2 * 33] * na.z, s[3 * 33] * na.w); o.z = pk2(s[4 * 33] * nb2.x, s[5 * 33] * nb2.y); o.w = pk2(s[6 * 33] * nb2.z, s[7 * 33] * nb2.w);
        const int r = drow0 + n; *(GAS v4u*)(WT + ((size_t)((r >> 8) * (K >> 6) + kb) * 256 + (r & 255)) * 64 + 8 * c) = o; }
    LDS_WAIT(); asm volatile("" ::: "memory");
}
__device__ __forceinline__ void rms_row_to_bf16(const float* xrow, const float* w, bf16* orow, int lane) {
    const GAS f32x4* xr = (const GAS f32x4*)xrow + lane; const GAS f32x4* wr = (const GAS f32x4*)w + lane;
    f32x4 v[8]; float s = 0.f;
#pragma unroll
    for (int j = 0; j < 8; ++j) { v[j] = xr[64 * j]; s += (v[j].x * v[j].x + v[j].y * v[j].y) + (v[j].z * v[j].z + v[j].w * v[j].w); }
    const float rstd = 1.0f / sqrtf(wave_sum(s, lane) * (1.f / DM) + NORM_EPS);
    GAS v2u* o8 = (GAS v2u*)orow + lane;
#pragma unroll
    for (int j = 0; j < 8; ++j) { const f32x4 ww = wr[64 * j]; v2u o; o.x = pk2(v[j].x * rstd * ww.x, v[j].y * rstd * ww.y); o.y = pk2(v[j].z * rstd * ww.z, v[j].w * rstd * ww.w); o8[64 * j] = o; }
}
__device__ __forceinline__ void row_to_bf16_ssq(const float* xrow, bf16* xn, int m, float* ssq, int lane) {
    const GAS f32x4* xr = (const GAS f32x4*)xrow + lane; float s = 0.f;
#pragma unroll
    for (int j = 0; j < 8; ++j) { const f32x4 v = xr[64 * j]; s += (v.x * v.x + v.y * v.y) + (v.z * v.z + v.w * v.w); v2u o; o.x = pk2(v.x, v.y); o.y = pk2(v.z, v.w); *(GAS v2u*)(xn + pg8::toff(m, 4 * lane + 256 * j, DM / 64)) = o; }
    s = wave_sum(s, lane); if (lane < 32) ssq[lane] = (lane == 0) ? s : 0.f;
}
__device__ __forceinline__ void rms_row_bf16_to_f32(const bf16* xn, int m, float* orow, const float* w, int lane) {
    f32x4 v[4][2]; float s = 0.f;
#pragma unroll
    for (int j = 0; j < 4; ++j) { const v4u b = *(const GAS v4u*)(xn + pg8::toff(m, 8 * lane + 512 * j, DM / 64));
        v[j][0] = (f32x4){__builtin_bit_cast(float, b.x << 16), __builtin_bit_cast(float, b.x & 0xffff0000u), __builtin_bit_cast(float, b.y << 16), __builtin_bit_cast(float, b.y & 0xffff0000u)};
        v[j][1] = (f32x4){__builtin_bit_cast(float, b.z << 16), __builtin_bit_cast(float, b.z & 0xffff0000u), __builtin_bit_cast(float, b.w << 16), __builtin_bit_cast(float, b.w & 0xffff0000u)};
#pragma unroll
        for (int h = 0; h < 2; ++h) s += (v[j][h].x * v[j][h].x + v[j][h].y * v[j][h].y) + (v[j][h].z * v[j][h].z + v[j][h].w * v[j][h].w); }
    const float rstd = 1.0f / sqrtf(wave_sum(s, lane) * (1.f / DM) + NORM_EPS);
#pragma unroll
    for (int j = 0; j < 4; ++j)
#pragma unroll
        for (int h = 0; h < 2; ++h) { const int col = 512 * j + 8 * lane + 4 * h; const f32x4 ww = *(const GAS f32x4*)(w + col); *(GAS f32x4*)(orow + col) = v[j][h] * rstd * ww; }
}
__device__ __forceinline__ void rms_row_to_f32(float* xrow, const float* w, int lane) {
    GAS f32x4* xr = (GAS f32x4*)xrow + lane; const GAS f32x4* wr = (const GAS f32x4*)w + lane;
    f32x4 v[8]; float s = 0.f;
#pragma unroll
    for (int j = 0; j < 8; ++j) { v[j] = xr[64 * j]; s += (v[j].x * v[j].x + v[j].y * v[j].y) + (v[j].z * v[j].z + v[j].w * v[j].w); }
    const float rstd = 1.0f / sqrtf(wave_sum(s, lane) * (1.f / DM) + NORM_EPS);
#pragma unroll
    for (int j = 0; j < 8; ++j) { const f32x4 ww = wr[64 * j]; xr[64 * j] = v[j] * rstd * ww; }
}
__device__ __forceinline__ float lambda_init_of(int layer) { return layer == 0 ? 0.2f : 0.35550907f; }

__device__ __forceinline__ void postmix_row(int row, float lam, float oml, const bf16* atto, const bf16* rec, const bf16* proj, const float* subln, const float* gnw, bf16* mix, int lane) {
    const bf16* ao = atto + (size_t)row * 2048;
    const int vb = (lane & 15) * 8;
    float sw[8];
#pragma unroll
    for (int e = 0; e < 8; ++e) sw[e] = subln[vb + e] * oml;
#pragma unroll
    for (int j = 0; j < 4; ++j) {
        const v4u raw = *(const GAS v4u*)(ao + j * 512 + lane * 8);
        float v[8], d[8]; float ss = 0.f;
#pragma unroll
        for (int e = 0; e < 4; ++e) { const unsigned w = raw[e]; v[2 * e] = __builtin_bit_cast(float, w << 16); v[2 * e + 1] = __builtin_bit_cast(float, w & 0xffff0000u); }
#pragma unroll
        for (int e = 0; e < 8; ++e) { const float p = shx(v[e], lane | 16, 0); d[e] = v[e] - lam * p; ss += d[e] * d[e]; }
        ss += shx(ss, lane, 1); ss += shx(ss, lane, 2); ss += shx(ss, lane, 4); ss += shx(ss, lane, 8);
        const float rstd = 1.0f / sqrtf(ss * (1.f / 128.f) + SUBLN_EPS);
        v4u o; o.x = pk2(d[0] * rstd * sw[0], d[1] * rstd * sw[1]); o.y = pk2(d[2] * rstd * sw[2], d[3] * rstd * sw[3]); o.z = pk2(d[4] * rstd * sw[4], d[5] * rstd * sw[5]); o.w = pk2(d[6] * rstd * sw[6], d[7] * rstd * sw[7]);
        const int h = 2 * j + (lane >> 5);
        if ((lane & 16) == 0) *(GAS v4u*)(mix + pg8::toff(row, h * 128 + vb, DM / 64)) = o;
    }
    const GAS v2u* rr = (const GAS v2u*)(rec + (size_t)row * HW) + lane;
    f32x4 r[4]; float s = 0.f;
#pragma unroll
    for (int j = 0; j < 4; ++j) { const v2u rw = rr[64 * j]; r[j] = (f32x4){__builtin_bit_cast(float, rw.x << 16), __builtin_bit_cast(float, rw.x & 0xffff0000u), __builtin_bit_cast(float, rw.y << 16), __builtin_bit_cast(float, rw.y & 0xffff0000u)};
        s += (r[j].x * r[j].x + r[j].y * r[j].y) + (r[j].z * r[j].z + r[j].w * r[j].w); }
    const float rstd = 1.0f / sqrtf(wave_sum(s, lane) * (1.f / HW) + NORM_EPS);
#pragma unroll
    for (int j = 0; j < 4; ++j) { const int col = 4 * lane + 256 * j;
        const v2u graw = *(const GAS v2u*)(proj + (size_t)row * INW + C_GH + col); const f32x4 gw = *(const GAS f32x4*)(gnw + col);
        float g[4] = { __builtin_bit_cast(float, graw.x << 16), __builtin_bit_cast(float, graw.x & 0xffff0000u), __builtin_bit_cast(float, graw.y << 16), __builtin_bit_cast(float, graw.y & 0xffff0000u) };
        float o[4];
#pragma unroll
        for (int e = 0; e < 4; ++e) { const float sg = g[e] / (1.0f + __expf(-g[e])); o[e] = r[j][e] * rstd * gw[e] * sg; }
        v2u ov; ov.x = pk2(o[0], o[1]); ov.y = pk2(o[2], o[3]);
        *(GAS v2u*)(mix + pg8::toff(row, 1024 + col, DM / 64)) = ov; }
}

__device__ __forceinline__ float hgrn_lb(const float* lbsrc, int layer, int ch) { return layer == 0 ? 0.f : 1.0f / (1.0f + __expf(lbsrc[ch] - lbsrc[HW + ch])); }

__device__ __forceinline__ void hgrn_naive_item(int item, const bf16* proj, float* rec, const float* lbsrc, int layer, LAS unsigned char* lds, int tid) {
    typedef float f32x2 __attribute__((ext_vector_type(2)));
    LAS f32x2* tile = (LAS f32x2*)lds;
    const int b = item >> 3, h = item & 7, lane = tid & 63, wave = tid >> 6;
    const int k = tid & 127, tq = tid >> 7;
    const float lb = hgrn_lb(lbsrc, layer, h * 128 + k);
    float S[128];
#pragma unroll
    for (int i = 0; i < 128; ++i) S[i] = 0.f;
    for (int tb = 0; tb < SEQ / 64; ++tb) {
        const size_t row0 = (size_t)b * SEQ + (size_t)tb * 64;
#pragma unroll 4
        for (int j = 0; j < 16; ++j) { const int t = tq + 4 * j; const bf16* pr = proj + (row0 + t) * INW + h * 128 + k;
            const float z = bf2f(pr[C_FH]), q = bf2f(pr[C_QH]); const float f = lb + (1.0f - lb) / (1.0f + __expf(-z));
            tile[t * 128 + k] = (f32x2){f, q}; }
        __syncthreads();
        if (wave < 2) { const int v = wave * 64 + lane;
            for (int t = 0; t < 64; ++t) { const float iv = bf2f(proj[(row0 + t) * INW + C_IH + h * 128 + v]); float o = 0.f;
#pragma unroll
                for (int kk = 0; kk < 128; ++kk) { const f32x2 fq = tile[t * 128 + kk]; S[kk] = fq.x * (S[kk] - iv) + iv; o += fq.y * S[kk]; }
                rec[(row0 + t) * HW + h * 128 + v] = o; } }
        __syncthreads();
    }
}

constexpr int HG_TOT = 0, HG_A1 = 2048, HG_A2 = HG_A1 + 64 * 272, HG_B1 = HG_A2 + 64 * 272, HG_VT = HG_B1 + 64 * 272, HG_P = HG_VT + 128 * 144, HG_END = HG_P + 64 * 144;
constexpr int HG_B3T = 2048;
static_assert(HG_B3T + 128 * 144 <= HG_VT && HG_END <= RING_BYTES, "HGRN LDS map");
struct HgRaw { unsigned zq[16], vv[8]; };
template <int PASS>
__device__ __forceinline__ void hg_load(HgRaw& R, int unit, const bf16* proj, int tid) {
    const int bh = unit >> 7, c = unit & 127, b = bh >> 3, h = bh & 7; const size_t row0 = (size_t)b * SEQ + (size_t)c * 64; const int k = tid & 127, tg = tid >> 7;
    const bf16* pz = proj + (row0 + 16 * tg) * INW + h * 128 + k;
#pragma unroll
    for (int j = 0; j < 16; ++j) { const unsigned z = pz[(size_t)j * INW + C_FH]; const unsigned q = (PASS == 3) ? pz[(size_t)j * INW + C_QH] : 0u; R.zq[j] = z | (q << 16); }
#pragma unroll
    for (int j = 0; j < 8; ++j) { const unsigned a = pz[(size_t)(2 * j) * INW + C_IH], b2 = pz[(size_t)(2 * j + 1) * INW + C_IH]; R.vv[j] = a | (b2 << 16); }
}
template <int PASS>
__device__ __forceinline__ void hgrn_chunk_unit(const HgRaw& R, int unit, const bf16* proj, bf16* Lbuf, float* dec, const bf16* ST, bf16* rec, const float* lbsrc, int layer, LAS unsigned char* lds, int tid) {
    const int bh = unit >> 7, c = unit & 127, b = bh >> 3, h = bh & 7;
    const size_t row0 = (size_t)b * SEQ + (size_t)c * 64;
    const int k = tid & 127, tg = tid >> 7, lane = tid & 63, w = __builtin_amdgcn_readfirstlane(tid >> 6), fr = lane & 15, fq = lane >> 4;
    LAS float* TOT = (LAS float*)(lds + HG_TOT);
    const float lb = hgrn_lb(lbsrc, layer, h * 128 + k);
    float bcum[16], kk[16], qv[16];
    {   float run = 0.f;
#pragma unroll
        for (int j = 0; j < 16; ++j) { const float z = __builtin_bit_cast(float, R.zq[j] << 16);
            if (PASS == 3) qv[j] = __builtin_bit_cast(float, R.zq[j] & 0xffff0000u);
            const float e = __expf(-z); const float sg = 1.0f / (1.0f + e);
            const float f = fmaxf(lb + (1.0f - lb) * sg, 1e-26f);
            kk[j] = (1.0f - lb) * (e * sg);
            run += __logf(f); bcum[j] = run; }
        TOT[tg * 128 + k] = run;
    }
    {   v4u o0, o1;
        o0.x = R.vv[0]; o0.y = R.vv[1]; o0.z = R.vv[2]; o0.w = R.vv[3]; o1.x = R.vv[4]; o1.y = R.vv[5]; o1.z = R.vv[6]; o1.w = R.vv[7];
        *(LAS v4u*)(lds + HG_VT + k * 144 + tg * 32) = o0; *(LAS v4u*)(lds + HG_VT + k * 144 + tg * 32 + 16) = o1;
    }
    __syncthreads();
    const float t0 = TOT[k], t1 = TOT[128 + k], t2 = TOT[256 + k], t3 = TOT[384 + k];
    const float off = (tg > 0 ? t0 : 0.f) + (tg > 1 ? t1 : 0.f) + (tg > 2 ? t2 : 0.f);
    const float blast = (t0 + t1) + (t2 + t3);
    if (PASS == 1) {
        unsigned pkd[8];
#pragma unroll
        for (int j = 0; j < 16; j += 2) pkd[j >> 1] = pk2(kk[j] * __expf(blast - (off + bcum[j])), kk[j + 1] * __expf(blast - (off + bcum[j + 1])));
        *(LAS v4u*)(lds + HG_B3T + k * 144 + tg * 32) = (v4u){pkd[0], pkd[1], pkd[2], pkd[3]};
        *(LAS v4u*)(lds + HG_B3T + k * 144 + tg * 32 + 16) = (v4u){pkd[4], pkd[5], pkd[6], pkd[7]};
        if (tg == 0) dec[(size_t)unit * 128 + k] = __expf(blast);
        __syncthreads();
        bf16x8 yv[2];
#pragma unroll
        for (int ks = 0; ks < 2; ++ks) yv[ks] = *(const LAS bf16x8*)(lds + HG_VT + (16 * w + fr) * 144 + ks * 64 + fq * 16);
        bf16* Lu = Lbuf + (size_t)unit * 16384 + (size_t)(16 * w + fr) * 128 + 4 * fq;
#pragma unroll
        for (int xb = 0; xb < 8; ++xb) { f32x4 acc = {0.f, 0.f, 0.f, 0.f};
#pragma unroll
            for (int ks = 0; ks < 2; ++ks) { const bf16x8 xv = *(const LAS bf16x8*)(lds + HG_B3T + (16 * xb + fr) * 144 + ks * 64 + fq * 16);
                acc = __builtin_amdgcn_mfma_f32_16x16x32_bf16(xv, yv[ks], acc, 0, 0, 0); }
            *(GAS v2u*)(Lu + 16 * xb) = (v2u){pk2(acc[0], acc[1]), pk2(acc[2], acc[3])}; }
    } else {
        const float r = t0 + t1;
#pragma unroll
        for (int j = 0; j < 16; ++j) { const float bj = off + bcum[j]; const int t = 16 * tg + j;
            const float a1 = qv[j] * __expf(fminf(bj - r, 80.f)), a2 = qv[j] * __expf(bj), b1 = kk[j] * __expf(fminf(r - bj, 80.f));
            *(LAS unsigned short*)(lds + HG_A1 + t * 272 + k * 2) = (unsigned short)f2bf(a1);
            *(LAS unsigned short*)(lds + HG_A2 + t * 272 + k * 2) = (unsigned short)f2bf(a2);
            *(LAS unsigned short*)(lds + HG_B1 + t * 272 + k * 2) = (unsigned short)f2bf(b1); }
        bf16x8 sx[4];
#pragma unroll
        for (int ks = 0; ks < 4; ++ks) sx[ks] = *(const GAS bf16x8*)(ST + (size_t)unit * 16384 + (size_t)(16 * w + fr) * 128 + 32 * ks + 8 * fq);
        __syncthreads();
#pragma unroll
        for (int rep = 0; rep < 2; ++rep) { const int id = w + 8 * rep, sb = id >> 2, tb = id & 3;
            f32x4 acc = {0.f, 0.f, 0.f, 0.f};
            if (sb <= tb) {
#pragma unroll
                for (int ks = 0; ks < 4; ++ks) { const bf16x8 xv = *(const LAS bf16x8*)(lds + HG_B1 + (16 * sb + fr) * 272 + ks * 64 + fq * 16);
                    const bf16x8 yv = *(const LAS bf16x8*)(lds + HG_A1 + (16 * tb + fr) * 272 + ks * 64 + fq * 16);
                    acc = __builtin_amdgcn_mfma_f32_16x16x32_bf16(xv, yv, acc, 0, 0, 0); }
            }
            const int t = 16 * tb + fr, s0 = 16 * sb + 4 * fq;
            float pvv[4];
#pragma unroll
            for (int i = 0; i < 4; ++i) pvv[i] = (sb <= tb && s0 + i <= t) ? acc[i] : 0.f;
            *(LAS v2u*)(lds + HG_P + t * 144 + s0 * 2) = (v2u){pk2(pvv[0], pvv[1]), pk2(pvv[2], pvv[3])}; }
        __syncthreads();
        bf16x8 vx[2];
#pragma unroll
        for (int ks = 0; ks < 2; ++ks) vx[ks] = *(const LAS bf16x8*)(lds + HG_VT + (16 * w + fr) * 144 + ks * 64 + fq * 16);
#pragma unroll
        for (int tb = 0; tb < 4; ++tb) { f32x4 acc = {0.f, 0.f, 0.f, 0.f};
#pragma unroll
            for (int ks = 0; ks < 2; ++ks) { const bf16x8 yv = *(const LAS bf16x8*)(lds + HG_P + (16 * tb + fr) * 144 + ks * 64 + fq * 16);
                acc = __builtin_amdgcn_mfma_f32_16x16x32_bf16(vx[ks], yv, acc, 0, 0, 0); }
#pragma unroll
            for (int ks = 0; ks < 4; ++ks) { const bf16x8 yv = *(const LAS bf16x8*)(lds + HG_A2 + (16 * tb + fr) * 272 + ks * 64 + fq * 16);
                acc = __builtin_amdgcn_mfma_f32_16x16x32_bf16(sx[ks], yv, acc, 0, 0, 0); }
            *(GAS v2u*)(rec + (row0 + 16 * tb + fr) * HW + h * 128 + 16 * w + 4 * fq) = (v2u){pk2(acc[0], acc[1]), pk2(acc[2], acc[3])}; }
    }
    __syncthreads();
}
__device__ __forceinline__ void hgrn_scan(int gtid, int nthreads, const bf16* Lbuf, const float* dec, bf16* ST) {
    typedef float f32x2 __attribute__((ext_vector_type(2)));
    for (int idx = gtid; idx < 16 * 8192; idx += nthreads) {
        const int bh = idx >> 13, e2 = (idx & 8191) * 2, kq = e2 & 127;
        const unsigned* Lp = (const unsigned*)(Lbuf + (size_t)bh * 128 * 16384 + e2); const float* dp = dec + (size_t)bh * 128 * 128 + kq; unsigned* sp = (unsigned*)(ST + (size_t)bh * 128 * 16384 + e2);
        f32x2 S = {0.f, 0.f};
#pragma unroll 8
        for (int c = 0; c < 128; ++c) { const unsigned lw = Lp[(size_t)c * 8192]; const f32x2 lv = {__builtin_bit_cast(float, lw << 16), __builtin_bit_cast(float, lw & 0xffff0000u)}; const f32x2 d = *(const GAS f32x2*)(dp + c * 128);
            sp[(size_t)c * 8192] = pk2(S.x, S.y); S = d * S + lv; }
    }
}

__device__ __forceinline__ void rstd_table(LAS float* tab, const float* ssq, int pm, float inv_n, float eps, int tid) {
    const int r = tid >> 1, hf = tid & 1; const f32x4* p = (const f32x4*)(ssq + (size_t)(pm * 256 + r) * 32 + hf * 16);
    const f32x4 a = p[0], b = p[1], c = p[2], d = p[3];
    const float q0 = ((a[0] + a[1]) + (a[2] + a[3])) + ((b[0] + b[1]) + (b[2] + b[3])), q1 = ((c[0] + c[1]) + (c[2] + c[3])) + ((d[0] + d[1]) + (d[2] + d[3]));
    float s = q0 + q1; s += shx(s, tid & 63, 1);
    if (hf == 0) tab[r] = __builtin_amdgcn_rsqf(s * inv_n + eps);
    __syncthreads();
}
#ifndef GEMM_ALIGN
#define GEMM_ALIGN true
#endif
#ifndef GEMM_SP2
#define GEMM_SP2 true
#endif
constexpr int PH_PER_LAYER = 13, N_PHASES = 2 * PH_PER_LAYER + 1;

__global__ void __launch_bounds__(NTHREADS, 2) hymba_fwd(Args args) {
    extern __shared__ __attribute__((aligned(16))) unsigned char lds_raw[];
    LAS unsigned char* lds = (LAS unsigned char*)lds_raw;
    cg::grid_group grid = cg::this_grid();
    const int G = gridDim.x, bx = blockIdx.x;
    const int vcu = (G % 8 == 0) ? (bx % 8) * (G / 8) + bx / 8 : bx;
    const int NGW = G * NWAVES;
    unsigned char* ws = args.ws;
    const float* x_in = args.in[0];
    float* xres = args.out;
    bf16* XN = (bf16*)(ws + WS_XN); bf16* MIX = (bf16*)(ws + WS_MIX); bf16* BIG = (bf16*)(ws + WS_BIG); bf16* ATTO = (bf16*)(ws + WS_ATTO);
    float* SSQ = (float*)(ws + WS_SSQ);
    bf16* REC = (bf16*)xres; bf16* LBUF = (bf16*)xres;     bf16* ST = (bf16*)(ws + WS_ST); float* DEC = (float*)(ws + WS_DEC);
    bf16* Wgu1 = (bf16*)(ws + WS_WGU1); bf16* Wd1 = (bf16*)(ws + WS_WD1); bf16* Win = (bf16*)(ws + WS_WIN); bf16* Wout = (bf16*)(ws + WS_WOUT); bf16* Wgu2 = (bf16*)(ws + WS_WGU2); bf16* Wd2 = (bf16*)(ws + WS_WD2);

    LAS float* RTAB = (LAS float*)(lds + RING_BYTES + 1024);
    unsigned* barw = (unsigned*)(ws + WS_BAR);
    volatile LAS unsigned* bst = (volatile LAS unsigned*)(lds + RING_BYTES);
    if (threadIdx.x < 2) bst[threadIdx.x] = 0u;
    if (bx == 0 && args.ph_lo == 0) for (int i = threadIdx.x; i < 4096; i += NTHREADS) __hip_atomic_store(barw + i, 0u, __ATOMIC_RELAXED, __HIP_MEMORY_SCOPE_AGENT);
    __syncthreads();
#ifdef PROBE_MASK
    int probe_rep = 0;
#endif
    XcdBarrier xbar; xbar.bar = barw; xbar.x = 0; xbar.st = bst;
    for (int ph = args.ph_lo; ph < args.ph_hi; ++ph) {
        const int layer = ph / PH_PER_LAYER, p = (ph == N_PHASES - 1) ? 99 : ph % PH_PER_LAYER;
        if (p == 3 || p == 10 || (p == 8 && !HGRN_NAIVE)) continue;
        int tid_o = threadIdx.x; asm volatile("" : "+v"(tid_o));
        const int tid = tid_o;
#define PHASE_IDS const int lane = tid & 63, wave = __builtin_amdgcn_readfirstlane(tid >> 6), gw = vcu * NWAVES + wave; (void)lane; (void)wave; (void)gw;
        switch (p) {
        case 0: {
            PHASE_IDS
            LAS float* scr = (LAS float*)(lds + wave * 16384);
            const float* g1 = args.in[2] + (size_t)layer * DM * DFF; const float* u1 = args.in[3] + (size_t)layer * DM * DFF; const float* d1 = args.in[4] + (size_t)layer * DFF * DM;
            const float* wi = args.in[6] + (size_t)layer * DM * INW; const float* wo = args.in[14] + (size_t)layer * DM * DM;
            const float* g2 = args.in[16] + (size_t)layer * DM * DFF; const float* u2 = args.in[17] + (size_t)layer * DM * DFF; const float* d2 = args.in[18] + (size_t)layer * DFF * DM;
            const float* nw1 = args.in[1] + (size_t)layer * DM; const float* nw2 = args.in[5] + (size_t)layer * DM; const float* nw3 = args.in[15] + (size_t)layer * DM;
            constexpr int I_F = (DM / 64) * (DFF / 32), I_IN = (DM / 64) * (INW / 32), I_OUT = (DM / 64) * (DM / 32);
            constexpr int NITEMS = 6 * I_F + I_IN + I_OUT;
            for (int it = gw; it < NITEMS; it += NGW) {
                int r = it;
                if (r < I_F) { transpose_item(g1, DM, DFF, Wgu1, 1, nw1, scr, r, lane); continue; } r -= I_F;
                if (r < I_F) { transpose_item(u1, DM, DFF, Wgu1, 2, nw1, scr, r, lane); continue; } r -= I_F;
                if (r < I_F) { transpose_item(d1, DFF, DM, Wd1, 0, nullptr, scr, r, lane); continue; } r -= I_F;
                if (r < I_IN) { transpose_item(wi, DM, INW, Win, 0, nw2, scr, r, lane); continue; } r -= I_IN;
                if (r < I_OUT) { transpose_item(wo, DM, DM, Wout, 0, nullptr, scr, r, lane); continue; } r -= I_OUT;
                if (r < I_F) { transpose_item(g2, DM, DFF, Wgu2, 1, nw3, scr, r, lane); continue; } r -= I_F;
                if (r < I_F) { transpose_item(u2, DM, DFF, Wgu2, 2, nw3, scr, r, lane); continue; } r -= I_F;
                transpose_item(d2, DFF, DM, Wd2, 0, nullptr, scr, r, lane);
            }
            if (ph == 0) for (int m = gw; m < M; m += NGW) row_to_bf16_ssq(x_in + (size_t)m * DM, XN, m, SSQ + (size_t)m * 32, lane);
        } break;
        case 1: case 11: {
            pg8::Gemm g{XN, p == 1 ? Wgu1 : Wgu2, M, 2 * DFF, DM}; pg8::StaticOrder S; S.init(M, 2 * DFF, G, bx);
            const float* sq = SSQ + (size_t)(layer * 3 + (p == 1 ? 0 : 2)) * M * 32; pg8::Unit u0; S.next(0, u0); rstd_table(RTAB, sq, u0.pm, 1.0f / DM, NORM_EPS, tid);
            pg8::EpiSwiGLU E{BIG, DFF, sq, 1.0f / DM, NORM_EPS, RTAB, u0.pm};
            pg8::gemm_phase<pg8::EpiSwiGLU, pg8::StaticOrder, GEMM_ALIGN, GEMM_SP2>(lds, g, S, E);
        } break;
        case 2: case 12: case 9: {
            const bf16* A = (p == 9) ? MIX : BIG; const bf16* Bt = (p == 2) ? Wd1 : (p == 12) ? Wd2 : Wout; const int K = (p == 9) ? DM : DFF;
            pg8::Gemm g{A, Bt, M, DM, K}; pg8::StaticOrder S; S.init(M, DM, G, bx);
            pg8::EpiResidual E{XN, SSQ + (size_t)(layer * 3 + (p == 2 ? 1 : p == 9 ? 2 : 3)) * M * 32, DM, (p == 9) ? 1.0f : 0.5f};
            pg8::gemm_phase<pg8::EpiResidual, pg8::StaticOrder, GEMM_ALIGN, GEMM_SP2>(lds, g, S, E);
        } break;
        case 4: {
            pg8::Gemm g{XN, Win, M, INW, DM}; pg8::StaticOrder S; S.init(M, INW, G, bx);
            const float* sq = SSQ + (size_t)(layer * 3 + 1) * M * 32; pg8::Unit u0; S.next(0, u0); rstd_table(RTAB, sq, u0.pm, 1.0f / DM, NORM_EPS, tid);
            pg8::EpiProj E{BIG, INW, sq, 1.0f / DM, NORM_EPS, AW, attn_body::C2, RTAB, u0.pm};
            pg8::gemm_phase<pg8::EpiProj, pg8::StaticOrder, GEMM_ALIGN, GEMM_SP2>(lds, g, S, E);
        } break;
        case 5: {
            for (int i = vcu; i < 256; i += G) {
                const int gsel = i >> 3, s = i & 7; const int b = gsel >> 4, hc = gsel & 15, h = hc >> 1;
                for (int qi = 0; qi < 4; ++qi) { const int qb = (qi == 0) ? s : (qi == 1) ? 15 - s : (qi == 2) ? 16 + s : 31 - s;
                    attn_body::attn_unit<8>(b, C_QA + hc * 64, C_KA + hc * 64, C_VA + h * 128, hc * 128, qb, (const attn_body::bf16*)BIG, (attn_body::bf16*)ATTO, (char*)lds_raw); }
            }
            {   int tid2 = tid; asm volatile("" : "+v"(tid2));
#define tid tid2
                HgRaw cur, nxt; hg_load<1>(cur, vcu < 2048 ? vcu : 2047, BIG, tid);
                for (int u = vcu; u < 2048; u += G) { hg_load<1>(nxt, u + G < 2048 ? u + G : u, BIG, tid);
                    hgrn_chunk_unit<1>(cur, u, BIG, LBUF, DEC, ST, REC, args.in[12], layer, lds, tid); cur = nxt; } }
#undef tid
        } break;
        case 6: {
#if HGRN_NAIVE
            for (int item = bx; item < 16; item += G) hgrn_naive_item(item, BIG, REC, args.in[12], layer, lds, tid);
#else
            hgrn_scan(bx * NTHREADS + tid, G * NTHREADS, LBUF, DEC, ST);
#endif
        } break;
        case 7: {
#if !HGRN_NAIVE
            {
                PHASE_IDS
                const float sa = wave_sum(args.in[7][layer * 64 + lane] * args.in[8][layer * 64 + lane], lane), sb = wave_sum(args.in[9][layer * 64 + lane] * args.in[10][layer * 64 + lane], lane);
                const float li = lambda_init_of(layer), lam = __expf(sa) - __expf(sb) + li;
                for (int bc = vcu; bc < 256; bc += G) { const int b = bc >> 7, c = bc & 127;
                    HgRaw cur, nxt; hg_load<3>(cur, (b * 8) * 128 + c, BIG, tid);
                    for (int h = 0; h < 8; ++h) { const int u = (b * 8 + h) * 128 + c; hg_load<3>(nxt, h < 7 ? u + 128 : u, BIG, tid);
                        hgrn_chunk_unit<3>(cur, u, BIG, LBUF, DEC, ST, REC, args.in[12], layer, lds, tid); cur = nxt; }
                    asm volatile("s_waitcnt vmcnt(0)" ::: "memory"); __syncthreads();
                    const int row0 = b * SEQ + c * 64 + wave * 8;
                    for (int i = 0; i < 8; ++i) postmix_row(row0 + i, lam, 1.0f - li, ATTO, REC, BIG, args.in[11] + layer * 128, args.in[13] + (size_t)layer * HW, MIX, lane);
                }
            }
#endif
        } break;
        default: {
            PHASE_IDS
            for (int m = gw; m < M; m += NGW) rms_row_bf16_to_f32(XN, m, xres + (size_t)m * DM, args.in[19], lane);
        } break;
        }
        if (ph + 1 < args.ph_hi) {
            if (ph == args.ph_lo) { grid.sync(); xbar = xcd_barrier_post(barw, bst); }
            else xcd_barrier(xbar);
        }
#ifdef PROBE_MASK
        if (p < 32 && ((PROBE_MASK >> p) & 1) && !probe_rep && ph != args.ph_lo) { probe_rep = 1; --ph; } else probe_rep = 0;
#endif
    }
}

#ifndef HGRN_NAIVE
#define HGRN_NAIVE 0
#endif
#ifndef N_LAUNCH_MODE
#define N_LAUNCH_MODE 1
#endif
extern "C" void kernel_launch(void* const* d_in, const int* in_sizes, int n_in, void* d_out, int out_size, void* d_ws, size_t ws_size, hipStream_t stream) {
    static int grid = 0;
    if (grid == 0) {
        if (n_in != 20 || out_size != M * DM || ws_size < WS_END) { fprintf(stderr, "kernel_launch: unexpected shapes (n_in %d out %d ws %zu need %zu)\n", n_in, out_size, ws_size, (size_t)WS_END); grid = -1; return; }
        int dev = 0, cus = 0, per_cu = 0;
        (void)hipGetDevice(&dev); (void)hipDeviceGetAttribute(&cus, hipDeviceAttributeMultiprocessorCount, dev);
        if (hipFuncSetAttribute((const void*)hymba_fwd, hipFuncAttributeMaxDynamicSharedMemorySize, LDS_BYTES) != hipSuccess) { fprintf(stderr, "kernel_launch: hipFuncSetAttribute failed\n"); grid = -1; return; }
        if (hipOccupancyMaxActiveBlocksPerMultiprocessor(&per_cu, (const void*)hymba_fwd, NTHREADS, LDS_BYTES) != hipSuccess || per_cu < 1) { fprintf(stderr, "kernel_launch: occupancy query says %d\n", per_cu); per_cu = 1; }
        (void)hipGetLastError();
        grid = cus;
    }
    if (grid < 0) return;
    Args a{};
    for (int i = 0; i < 20; ++i) a.in[i] = (const float*)d_in[i];
    a.out = (float*)d_out; a.ws = (unsigned char*)d_ws;
#if N_LAUNCH_MODE == 1
    a.ph_lo = 0; a.ph_hi = N_PHASES;
    { void* kargs[] = {&a}; hipError_t e = hipLaunchCooperativeKernel((const void*)hymba_fwd, dim3(grid), dim3(NTHREADS), kargs, LDS_BYTES, stream);
      if (e != hipSuccess) fprintf(stderr, "cooperative launch failed: %s (grid %d)\n", hipGetErrorString(e), grid); }
#else
    for (int ph = 0; ph < N_PHASES; ++ph) { if (ph % PH_PER_LAYER == 7) continue; a.ph_lo = ph; a.ph_hi = ph + 1;
        void* kargs[] = {&a}; hipError_t e = hipLaunchCooperativeKernel((const void*)hymba_fwd, dim3(grid), dim3(NTHREADS), kargs, LDS_BYTES, stream);
        if (e != hipSuccess) { fprintf(stderr, "cooperative launch %d failed: %s (grid %d)\n", ph, hipGetErrorString(e), grid); break; } }
#endif
}
```

```cpp
#include <hip/hip_runtime.h>
#include <hip/hip_bf16.h>
#include <hip/hip_cooperative_groups.h>
#include <cstdio>
#include <cstdint>
#include <cmath>
namespace cg = cooperative_groups;
__device__ __forceinline__ int tid_from_wave(int wave_s) { unsigned m = ~0u; asm volatile("" : "+s"(m)); return wave_s * 64 + (int)__builtin_amdgcn_mbcnt_hi(m, __builtin_amdgcn_mbcnt_lo(m, 0u)); }
namespace pg8 {
#define PG8_LAS __attribute__((address_space(3)))
typedef unsigned short bf16_t;
typedef short bf16x8 __attribute__((ext_vector_type(8)));
typedef float f32x4 __attribute__((ext_vector_type(4)));
typedef unsigned u32x4 __attribute__((ext_vector_type(4)));
constexpr int BM = 256, BK = 64, HALF = 128, HTB = HALF * BK * 2  , STAGE_BYTES = 8 * HTB, NXCD = 8, WGM = 8;

__host__ __device__ __forceinline__ int lds_byte(int r, int c) { const int st = (r >> 4) * 2 + (c >> 5), rr = r & 15, cc = c & 31, ob = rr * 64 + cc * 2; return st * 1024 + (ob ^ (((ob >> 9) & 1) << 5)); }
__host__ __device__ __forceinline__ void stage_rc(int b, int& R, int& C) { const int st = b / 1024, sb = b % 1024, swz = sb ^ (((sb >> 9) & 1) << 5); R = (st >> 1) * 16 + swz / 64; C = (st & 1) * 32 + (swz % 64) / 2; }
__host__ __device__ __forceinline__ int perm32(int rho) { const int n = rho >> 4, i = rho & 15; return 8 * (i >> 2) + 4 * n + (i & 3); }

struct Unit { int pm, pn; };
__host__ __device__ __forceinline__ size_t toff(int m, int k, int nt) { return ((size_t)((m >> 8) * nt + (k >> 6)) * 256 + (m & 255)) * 64 + (k & 63); }
struct Gemm { const bf16_t* A; const bf16_t* Bt; int M, N, K; };

struct StaticOrder {
    int nM, nN, nwg, G, c;
    __host__ __device__ void init(int M, int N, int G_, int c_) { nM = M / BM; nN = N / BM; nwg = nM * nN; G = G_; c = c_; }
    __host__ __device__ bool next(int i, Unit& u) const {
        const long L = (long)i * G + c; if (L >= nwg) return false;
        int wgid = (int)L; { const int q = nwg / NXCD, r = nwg % NXCD, xcd = wgid % NXCD, off = wgid / NXCD; wgid = (xcd < r ? xcd * (q + 1) : r * (q + 1) + (xcd - r) * q) + off; }
        const int nig = WGM * nN, gid = wgid / nig, fm = gid * WGM, gsz = (nM - fm) < WGM ? (nM - fm) : WGM;
        u.pm = fm + ((wgid % nig) % gsz); u.pn = (wgid % nig) / gsz; return true;
    }
    __device__ __forceinline__ void a_ready(const Unit&) const {}
    __device__ __forceinline__ void done(const Unit&) const {}
};

__device__ __forceinline__ unsigned cvt_pk_bf16(float lo, float hi) { unsigned r; asm volatile("v_cvt_pk_bf16_f32 %0, %1, %2" : "=v"(r) : "v"(lo), "v"(hi)); return r; }
typedef float f32x2 __attribute__((ext_vector_type(2)));
__device__ __forceinline__ f32x2 gelu_pk(f32x2 v) {
    const f32x2 av = __builtin_elementwise_abs(v), d = av * 0.2316418882f + 1.0f;
    f32x2 t; t.x = __builtin_amdgcn_rcpf(d.x); t.y = __builtin_amdgcn_rcpf(d.y);
    f32x2 q = t * 0.5307027145f + (-0.7265760135f); q = q * t + 0.7107068705f; q = q * t + (-0.142248368f); q = q * t + 0.127414796f; q = q * t;
    const f32x2 s = (v * v) * (-0.72134752044f);
    f32x2 e; e.x = __builtin_amdgcn_exp2f(s.x); e.y = __builtin_amdgcn_exp2f(s.y);
    const f32x2 m = v * (q * e), r = v - m;
    f32x2 o; o.x = v.x < 0.f ? m.x : r.x; o.y = v.y < 0.f ? m.y : r.y; return o;
}

template <int ACT  > struct EpiBf16 {
    static constexpr bool PERM = true, AFTER_DRAIN = false; static_assert(ACT == 0 || ACT == 1, "EpiBf16: ACT is 0 (none) or 1 (gelu_pk)");
    bf16_t* O; int ldc; const float* bias; int split_cols; size_t split_stride; float scale0;
    __device__ __forceinline__ void operator()(const f32x4 (&acc)[2][2][4][2], const Unit& u, int wr, int wc, int fr, int fq) const {
        const int row0 = u.pm * BM + wr * 64 + fr; int colt = u.pn * BM; bf16_t* base = O;
        float sc = 1.f; if (split_cols) { const int t = colt / split_cols; base += (size_t)t * split_stride; colt -= t * split_cols; if (t == 0) sc = scale0; }
        const int col0 = colt + wc * 32 + 8 * fq, bcol0 = u.pn * BM + wc * 32 + 8 * fq;
        f32x4 bv[2][2];
#pragma unroll
        for (int bj = 0; bj < 2; ++bj)
#pragma unroll
            for (int n = 0; n < 2; ++n) bv[bj][n] = bias ? *(const f32x4*)(bias + bcol0 + bj * HALF + 4 * n) : (f32x4){0.f, 0.f, 0.f, 0.f};
#pragma unroll
        for (int ai = 0; ai < 2; ++ai)
#pragma unroll
            for (int m = 0; m < 4; ++m) { bf16_t* rowp = base + (size_t)(row0 + ai * HALF + m * 16) * ldc + col0;
#pragma unroll
                for (int bj = 0; bj < 2; ++bj) { f32x4 v0 = acc[ai][bj][m][0] + bv[bj][0], v1 = acc[ai][bj][m][1] + bv[bj][1];
                    if (ACT == 1) { f32x2 a = gelu_pk((f32x2){v0[0], v0[1]}), b = gelu_pk((f32x2){v0[2], v0[3]}), c = gelu_pk((f32x2){v1[0], v1[1]}), d = gelu_pk((f32x2){v1[2], v1[3]});
                        v0 = (f32x4){a.x, a.y, b.x, b.y}; v1 = (f32x4){c.x, c.y, d.x, d.y}; }
                    v0 = v0 * sc; v1 = v1 * sc; u32x4 w; w.x = cvt_pk_bf16(v0[0], v0[1]); w.y = cvt_pk_bf16(v0[2], v0[3]); w.z = cvt_pk_bf16(v1[0], v1[1]); w.w = cvt_pk_bf16(v1[2], v1[3]);
                    *(u32x4*)(rowp + bj * HALF) = w; } }
    }
};
__device__ __forceinline__ float shx(float v, int lane, int m) { return __builtin_bit_cast(float, __builtin_amdgcn_ds_bpermute((lane ^ m) << 2, __builtin_bit_cast(int, v))); }
__device__ __forceinline__ void row_rstd(float (&rs)[2][4], const float* ssq, int row0, int fq, float inv_n, float eps, const PG8_LAS float* tab, int tab_pm, int pm) {
    const int lane = (row0 & 15) + 16 * fq;
    if (pm == tab_pm) {
#pragma unroll
        for (int ai = 0; ai < 2; ++ai)
#pragma unroll
            for (int m = 0; m < 4; ++m) rs[ai][m] = tab[(row0 & 255) + ai * HALF + m * 16];
        return;
    }
#pragma unroll
    for (int ai = 0; ai < 2; ++ai)
#pragma unroll
        for (int m = 0; m < 4; ++m) { const f32x4* p = (const f32x4*)(ssq + (size_t)(row0 + ai * HALF + m * 16) * 32 + fq * 8); const f32x4 a = p[0], b = p[1];
            float s = ((a[0] + a[1]) + (a[2] + a[3])) + ((b[0] + b[1]) + (b[2] + b[3])); s += shx(s, lane, 16); s += shx(s, lane, 32);
            rs[ai][m] = __builtin_amdgcn_rsqf(s * inv_n + eps); }
}
struct EpiSwiGLU {
    static constexpr bool PERM = true, AFTER_DRAIN = false;
    bf16_t* O; int ldc; const float* ssq; float inv_n, eps; const PG8_LAS float* tab; int tab_pm;
    __device__ __forceinline__ void operator()(const f32x4 (&acc)[2][2][4][2], const Unit& u, int wr, int wc, int fr, int fq) const {
        const int row0 = u.pm * BM + wr * 64 + fr; const int col0 = u.pn * HALF + wc * 32 + 8 * fq;
        float rs[2][4]; row_rstd(rs, ssq, row0, fq, inv_n, eps, tab, tab_pm, u.pm);
#pragma unroll
        for (int ai = 0; ai < 2; ++ai)
#pragma unroll
            for (int m = 0; m < 4; ++m) { bf16_t* rowp = O + toff(row0 + ai * HALF + m * 16, col0, ldc >> 6);
                const float r = rs[ai][m]; const f32x2 c1 = {-1.4426950408889634f * r, -1.4426950408889634f * r}, r2 = {r * r, r * r};
                unsigned wv[4];
#pragma unroll
                for (int n = 0; n < 2; ++n)
#pragma unroll
                    for (int e = 0; e < 4; e += 2) { const f32x2 g = {acc[ai][0][m][n][e], acc[ai][0][m][n][e + 1]}, up = {acc[ai][1][m][n][e], acc[ai][1][m][n][e + 1]};
                        const f32x2 t = g * c1; f32x2 d; d.x = __builtin_amdgcn_exp2f(t.x); d.y = __builtin_amdgcn_exp2f(t.y); d = d + 1.0f;
                        f32x2 rc; rc.x = __builtin_amdgcn_rcpf(d.x); rc.y = __builtin_amdgcn_rcpf(d.y);
                        const f32x2 hv = ((g * up) * r2) * rc; wv[n * 2 + (e >> 1)] = cvt_pk_bf16(hv.x, hv.y); }
                u32x4 w; w.x = wv[0]; w.y = wv[1]; w.z = wv[2]; w.w = wv[3];
                *(u32x4*)rowp = w; }
    }
};
struct EpiProj {
    static constexpr bool PERM = true, AFTER_DRAIN = false;
    bf16_t* O; int ldc; const float* ssq; float inv_n, eps; int qcols; float qscale; const PG8_LAS float* tab; int tab_pm;
    __device__ __forceinline__ void operator()(const f32x4 (&acc)[2][2][4][2], const Unit& u, int wr, int wc, int fr, int fq) const {
        const int row0 = u.pm * BM + wr * 64 + fr; const int col0 = u.pn * BM + wc * 32 + 8 * fq;
        float rs[2][4]; row_rstd(rs, ssq, row0, fq, inv_n, eps, tab, tab_pm, u.pm);
        const float cs = (u.pn * BM < qcols) ? qscale : 1.0f;
#pragma unroll
        for (int ai = 0; ai < 2; ++ai)
#pragma unroll
            for (int m = 0; m < 4; ++m) { bf16_t* rowp = O + (size_t)(row0 + ai * HALF + m * 16) * ldc + col0; const float r = rs[ai][m] * cs;
#pragma unroll
                for (int bj = 0; bj < 2; ++bj) { const f32x4 v0 = acc[ai][bj][m][0] * r, v1 = acc[ai][bj][m][1] * r;
                    u32x4 w; w.x = cvt_pk_bf16(v0[0], v0[1]); w.y = cvt_pk_bf16(v0[2], v0[3]); w.z = cvt_pk_bf16(v1[0], v1[1]); w.w = cvt_pk_bf16(v1[2], v1[3]);
                    *(u32x4*)(rowp + bj * HALF) = w; } }
    }
};
struct EpiResidual {
    static constexpr bool PERM = true, AFTER_DRAIN = false;
    bf16_t* xb; float* ssq; int ldc; float alpha;
    __device__ __forceinline__ void operator()(const f32x4 (&acc)[2][2][4][2], const Unit& u, int wr, int wc, int fr, int fq) const {
        const int row0 = u.pm * BM + wr * 64 + fr; const int col0 = u.pn * BM + wc * 32 + 8 * fq;
#pragma unroll
        for (int ai = 0; ai < 2; ++ai) {
            u32x4 bs[4][2];
#pragma unroll
            for (int m = 0; m < 4; ++m) {
#pragma unroll
                for (int bj = 0; bj < 2; ++bj) bs[m][bj] = *(const u32x4*)(xb + toff(row0 + ai * HALF + m * 16, col0 + bj * HALF, ldc >> 6)); }
            asm volatile("" ::: "memory");
#pragma unroll
            for (int m = 0; m < 4; ++m) { const int row = row0 + ai * HALF + m * 16; float ss = 0.f;
#pragma unroll
                for (int bj = 0; bj < 2; ++bj) { const u32x4 b = bs[m][bj];
                    const f32x4 b0 = {__builtin_bit_cast(float, b.x << 16), __builtin_bit_cast(float, b.x & 0xffff0000u), __builtin_bit_cast(float, b.y << 16), __builtin_bit_cast(float, b.y & 0xffff0000u)};
                    const f32x4 b1 = {__builtin_bit_cast(float, b.z << 16), __builtin_bit_cast(float, b.z & 0xffff0000u), __builtin_bit_cast(float, b.w << 16), __builtin_bit_cast(float, b.w & 0xffff0000u)};
                    const f32x4 o0 = b0 + acc[ai][bj][m][0] * alpha, o1 = b1 + acc[ai][bj][m][1] * alpha;
                    ss += (o0[0] * o0[0] + o0[1] * o0[1]) + (o0[2] * o0[2] + o0[3] * o0[3]) + (o1[0] * o1[0] + o1[1] * o1[1]) + (o1[2] * o1[2] + o1[3] * o1[3]);
                    u32x4 w; w.x = cvt_pk_bf16(o0[0], o0[1]); w.y = cvt_pk_bf16(o0[2], o0[3]); w.z = cvt_pk_bf16(o1[0], o1[1]); w.w = cvt_pk_bf16(o1[2], o1[3]);
                    *(u32x4*)(xb + toff(row, col0 + bj * HALF, ldc >> 6)) = w; }
                ss += shx(ss, fr + 16 * fq, 16); ss += shx(ss, fr + 16 * fq, 32);
                if (fq == 0) ssq[(size_t)row * 32 + u.pn * 4 + wc] = ss; }
            asm volatile("" ::: "memory");
        }
    }
};

template <class Epi, class Sched, bool ALIGN_EPI = false, bool SP2 = false>
__device__ __forceinline__ void gemm_phase(PG8_LAS unsigned char* lds, const Gemm g, const Sched& S, const Epi& E, int tid_in) {
    int tid_o = tid_in; asm volatile("" : "+v"(tid_o));
    const int tid = tid_o, wid = __builtin_amdgcn_readfirstlane(tid >> 6), lane = tid & 63, wr = wid >> 2, wc = wid & 3, fr = lane & 15, fq = lane >> 4;
    const int K = g.K, nt = K / BK;
    unsigned voffA[2], voffB[2];
#pragma unroll
    for (int i = 0; i < 2; ++i) { int R, C; stage_rc(tid * 16 + i * 8192, R, C); const int Rb = Epi::PERM ? ((R & ~31) + perm32(R & 31)) : R;
        voffA[i] = (unsigned)(R * BK + C) * 2u; voffB[i] = (unsigned)(Rb * BK + C) * 2u; }
    const size_t kstep = (size_t)(BK * 2), kstepB = (size_t)BM * BK * 2;
    const size_t hstep = (size_t)HALF * K * 2, hstepB = (size_t)HALF * BK * 2;
    const size_t tstep = 2 * hstep;
    const unsigned ldsw = (unsigned)wid * 1024u;
    const int aoff = lds_byte(wr * 64 + fr, fq * 8), boff = lds_byte(wc * 32 + fr, fq * 8);
#define PG8_SA(b, h) (((b) * 2 + (h)) * HTB)
#define PG8_SB(b, h) ((4 + (b) * 2 + (h)) * HTB)
#define PG8_STAGE(bufoff, gbase, voff) do { _Pragma("unroll") for (int _i = 0; _i < 2; ++_i) \
        __builtin_amdgcn_global_load_lds((const unsigned*)((const char*)(gbase) + (voff)[_i]), (PG8_LAS unsigned*)(lds + (bufoff) + ldsw + _i * 8192), 16, 0, 0); } while (0)
#define PG8_LDA(dst, b, h) do { _Pragma("unroll") for (int m = 0; m < 4; ++m) _Pragma("unroll") for (int k = 0; k < 2; ++k) dst[m][k] = *(const PG8_LAS bf16x8*)(lds + PG8_SA(b, h) + aoff + m * 2048 + k * 1024); } while (0)
#define PG8_LDB(dst, b, h) do { _Pragma("unroll") for (int n = 0; n < 2; ++n) _Pragma("unroll") for (int k = 0; k < 2; ++k) dst[n][k] = *(const PG8_LAS bf16x8*)(lds + PG8_SB(b, h) + boff + n * 2048 + k * 1024); } while (0)
#define PG8_MMA(ai, bj, At, Bt) do { __builtin_amdgcn_s_setprio(1); _Pragma("unroll") for (int m = 0; m < 4; ++m) _Pragma("unroll") for (int n = 0; n < 2; ++n) _Pragma("unroll") for (int k = 0; k < 2; ++k) \
        acc[ai][bj][m][n] = __builtin_amdgcn_mfma_f32_16x16x32_bf16(Bt[n][k], At[m][k], acc[ai][bj][m][n], 0, 0, 0); __builtin_amdgcn_s_setprio(0); } while (0)
#define PG8_WAIT_V(n) asm volatile("s_waitcnt vmcnt(" #n ")" ::: "memory")
#define PG8_WAIT_L(n) asm volatile("s_waitcnt lgkmcnt(" #n ")" ::: "memory")
#define PG8_BAR __builtin_amdgcn_s_barrier()
#define PG8_SCHED __builtin_amdgcn_sched_barrier(0)
    Unit cur, nxt; int ui = 0;
    if (!S.next(0, cur)) return;
    f32x4 acc[2][2][4][2];
#pragma unroll
    for (int a = 0; a < 2; ++a)
#pragma unroll
        for (int b = 0; b < 2; ++b)
#pragma unroll
            for (int m = 0; m < 4; ++m)
#pragma unroll
                for (int n = 0; n < 2; ++n) acc[a][b][m][n] = (f32x4){0.f, 0.f, 0.f, 0.f};
    bf16x8 At[4][2], B0[2][2], B1[2][2];
    const char* cA = (const char*)g.A + (size_t)cur.pm * tstep; const char* cB = (const char*)g.Bt + (size_t)cur.pn * tstep;
    S.a_ready(cur);
    if constexpr (SP2) {
        PG8_STAGE(PG8_SB(0, 0), cB, voffB); PG8_STAGE(PG8_SB(0, 1), cB + hstepB, voffB); PG8_STAGE(PG8_SA(0, 0), cA, voffA); PG8_STAGE(PG8_SA(0, 1), cA + hstepB, voffA);
        if (wr == 1) PG8_BAR;
        PG8_WAIT_V(2); PG8_BAR;
        PG8_STAGE(PG8_SB(1, 0), cB + kstepB, voffB); PG8_STAGE(PG8_SA(1, 0), cA + kstepB, voffA); PG8_STAGE(PG8_SB(1, 1), cB + hstepB + kstepB, voffB);
        PG8_WAIT_V(6); PG8_BAR;
    } else {
        PG8_STAGE(PG8_SB(0, 0), cB, voffB); PG8_STAGE(PG8_SA(0, 0), cA, voffA); PG8_STAGE(PG8_SB(0, 1), cB + hstepB, voffB); PG8_STAGE(PG8_SA(0, 1), cA + hstepB, voffA);
        if (wr == 1) PG8_BAR;
        PG8_WAIT_V(4); PG8_BAR;
        PG8_STAGE(PG8_SB(1, 0), cB + kstepB, voffB); PG8_STAGE(PG8_SA(1, 0), cA + kstepB, voffA); PG8_STAGE(PG8_SB(1, 1), cB + hstepB + kstepB, voffB);
        PG8_WAIT_V(6); PG8_BAR;
    }
    for (;;) {
        const bool has_next = S.next(ui + 1, nxt);
        const char* nA = has_next ? (const char*)g.A + (size_t)nxt.pm * tstep : cA; const char* nB = has_next ? (const char*)g.Bt + (size_t)nxt.pn * tstep : cB;
        for (int t = 0; t < nt; t += 2) {
            const bool last = (t == nt - 2);
            const char* a1 = cA + (size_t)(t + 1) * kstepB;
            const char* a2 = last ? nA : cA + (size_t)(t + 2) * kstepB; const char* b2 = last ? nB : cB + (size_t)(t + 2) * kstepB;
            const char* a3 = a2 + kstepB; const char* b3 = b2 + kstepB;
            if (last && has_next) S.a_ready(nxt);
            if constexpr (SP2) {
            PG8_LDB(B0, 0, 0); PG8_LDB(B1, 0, 1); PG8_SCHED; PG8_LDA(At, 0, 0); PG8_STAGE(PG8_SA(1, 1), a1 + hstepB, voffA);
            PG8_WAIT_V(8); PG8_WAIT_L(0); PG8_BAR; PG8_MMA(0, 0, At, B0); PG8_MMA(0, 1, At, B1); PG8_BAR; PG8_SCHED;
            PG8_LDA(At, 0, 1); PG8_STAGE(PG8_SB(0, 0), b2, voffB); PG8_STAGE(PG8_SB(0, 1), b2 + hstepB, voffB); PG8_STAGE(PG8_SA(0, 0), a2, voffA);
            PG8_WAIT_V(8); PG8_WAIT_L(0); PG8_BAR; PG8_MMA(1, 0, At, B0); PG8_MMA(1, 1, At, B1); PG8_BAR; PG8_SCHED;
            PG8_LDB(B0, 1, 0); PG8_LDB(B1, 1, 1); PG8_SCHED; PG8_LDA(At, 1, 0); PG8_STAGE(PG8_SA(0, 1), a2 + hstepB, voffA);
            PG8_WAIT_V(8); PG8_WAIT_L(0); PG8_BAR; PG8_MMA(0, 0, At, B0); PG8_MMA(0, 1, At, B1); PG8_BAR; PG8_SCHED;
            PG8_LDA(At, 1, 1); PG8_STAGE(PG8_SB(1, 0), b3, voffB); PG8_STAGE(PG8_SB(1, 1), b3 + hstepB, voffB); PG8_STAGE(PG8_SA(1, 0), a3, voffA);
            PG8_WAIT_V(8); PG8_WAIT_L(0); PG8_BAR; PG8_MMA(1, 0, At, B0); PG8_MMA(1, 1, At, B1); PG8_BAR; PG8_SCHED;
            } else {
            PG8_LDB(B0, 0, 0); PG8_SCHED; PG8_LDA(At, 0, 0); PG8_STAGE(PG8_SA(1, 1), a1 + hstepB, voffA);
            PG8_WAIT_L(8); PG8_BAR; PG8_WAIT_L(0); PG8_MMA(0, 0, At, B0); PG8_BAR; PG8_SCHED;
            PG8_LDB(B1, 0, 1); PG8_STAGE(PG8_SB(0, 0), b2, voffB);
            PG8_BAR; PG8_WAIT_L(0); PG8_MMA(0, 1, At, B1); PG8_BAR;
            PG8_LDA(At, 0, 1); PG8_STAGE(PG8_SA(0, 0), a2, voffA);
            PG8_BAR; PG8_WAIT_L(0); PG8_MMA(1, 0, At, B0); PG8_BAR; PG8_SCHED;
            PG8_STAGE(PG8_SB(0, 1), b2 + hstepB, voffB);
            PG8_WAIT_V(6); PG8_BAR; PG8_MMA(1, 1, At, B1); PG8_BAR;
            PG8_LDB(B0, 1, 0); PG8_SCHED; PG8_LDA(At, 1, 0); PG8_STAGE(PG8_SA(0, 1), a2 + hstepB, voffA);
            PG8_WAIT_L(8); PG8_BAR; PG8_WAIT_L(0); PG8_MMA(0, 0, At, B0); PG8_BAR; PG8_SCHED;
            PG8_LDB(B1, 1, 1); PG8_STAGE(PG8_SB(1, 0), b3, voffB);
            PG8_BAR; PG8_WAIT_L(0); PG8_MMA(0, 1, At, B1); PG8_BAR;
            PG8_LDA(At, 1, 1); PG8_STAGE(PG8_SA(1, 0), a3, voffA);
            PG8_BAR; PG8_WAIT_L(0); PG8_MMA(1, 0, At, B0); PG8_BAR; PG8_SCHED;
            PG8_STAGE(PG8_SB(1, 1), b3 + hstepB, voffB);
            PG8_WAIT_V(6); PG8_BAR; PG8_MMA(1, 1, At, B1); PG8_BAR;
            }
        }
        if constexpr (ALIGN_EPI) { if (wr == 0) PG8_BAR; }
        if constexpr (!Epi::AFTER_DRAIN) { E(acc, cur, wr, wc, fr, fq); S.done(cur); }
        if (!has_next) break;
#pragma unroll
        for (int a = 0; a < 2; ++a)
#pragma unroll
            for (int b = 0; b < 2; ++b)
#pragma unroll
                for (int m = 0; m < 4; ++m)
#pragma unroll
                    for (int n = 0; n < 2; ++n) acc[a][b][m][n] = (f32x4){0.f, 0.f, 0.f, 0.f};
        cur = nxt; cA = nA; cB = nB; ++ui;
        if constexpr (ALIGN_EPI) { if (wr == 1) PG8_BAR; }
    }
    PG8_WAIT_V(0);
    if constexpr (!ALIGN_EPI) { if (wr == 0) PG8_BAR; }
    PG8_BAR;
    if constexpr (Epi::AFTER_DRAIN) { E.fused(acc, cur, wr, wc, fr, fq, lds, wid, lane); S.done(cur); }
#undef PG8_SA
#undef PG8_SB
#undef PG8_STAGE
#undef PG8_LDA
#undef PG8_LDB
#undef PG8_MMA
#undef PG8_WAIT_V
#undef PG8_WAIT_L
#undef PG8_BAR
#undef PG8_SCHED
}
}
namespace attn_body {
using bf16=__hip_bfloat16;
using bf16x8=__attribute__((ext_vector_type(8)))short;
using s16x4=__attribute__((ext_vector_type(4)))short;
using f32x16=__attribute__((ext_vector_type(16)))float;
using u32x4=__attribute__((ext_vector_type(4)))unsigned;
constexpr int BATCH=2,SEQ=8192,D=64,PIN=7168,POUT=2048;
constexpr int NW=8,QBLK=32,QB=QBLK*NW,KVBLK=64,NQB=SEQ/QB;
constexpr int ATTN_UNIT_ROWS=QB;
__device__ __forceinline__ int crow(int r,int hi){return (r&3)+8*(r>>2)+4*hi;}
#define SBAR() __builtin_amdgcn_sched_barrier(0)
__device__ __forceinline__ void cmask(f32x16&p0,f32x16&p1,int jb,int qrel,int hi){
  const float NEG=-INFINITY; int kb=64*jb+4*hi;
  #pragma unroll
  for(int r=0;r<16;++r){int kv=kb+(r&3)+8*(r>>2); if(kv>qrel)p0[r]=NEG; if(kv+32>qrel)p1[r]=NEG;}
}

constexpr int NSLOT=3, SLOTB=8192;
constexpr int VSLOTB=2*SLOTB;
constexpr int LDS_K=0, LDS_V=NSLOT*SLOTB, LDS_WS=LDS_V+NSLOT*VSLOTB, LDS_OST=LDS_WS+NW*64*4, LDS_BYTES=LDS_OST+NW*4096;
constexpr float C2=0.125f*1.4426950408889634f;
__device__ __forceinline__ void glds16(const void*gsrc,unsigned lds_dst){unsigned keep;
  asm volatile("s_mov_b32 %0, m0\n\ts_mov_b32 m0, %2\n\ts_nop 0\n\tglobal_load_lds_dwordx4 %1, off\n\ts_mov_b32 m0, %0":"=&s"(keep):"v"(gsrc),"s"(lds_dst):"memory");}
__device__ __forceinline__ float max3f(float a,float b,float c){float r;asm("v_max3_f32 %0, %1, %2, %3":"=v"(r):"v"(a),"v"(b),"v"(c));return r;}
__device__ __forceinline__ float max2f(float a,float b){float r;asm("v_max_f32_e32 %0, %1, %2":"=v"(r):"v"(a),"v"(b));return r;}
__device__ __forceinline__ float fadd_s(float a,float b){float r;asm("v_add_f32_e32 %0, %1, %2":"=v"(r):"v"(a),"v"(b));return r;}
__device__ __forceinline__ float fsub_s(float a,float b){float r;asm("v_sub_f32_e32 %0, %1, %2":"=v"(r):"v"(a),"v"(b));return r;}
typedef float f32x2_t __attribute__((ext_vector_type(2))); typedef __bf16 bf16x2_t __attribute__((ext_vector_type(2)));
__device__ __forceinline__ unsigned cvtpk_s(float lo,float hi){f32x2_t v={lo,hi};bf16x2_t b=__builtin_convertvector(v,bf16x2_t);return __builtin_bit_cast(unsigned,b);}
#define WAIT_BAR(N) asm volatile("s_waitcnt vmcnt(" #N ") lgkmcnt(0)\n\ts_barrier":::"memory")

__device__ __forceinline__ void qkt(f32x16&p0,f32x16&p1,const char*Kslot,const bf16x8*qr,const f32x16&negm,int r32,int hi){
  const char*kb=Kslot+hi*1024+r32*16;
  #pragma unroll
  for(int d0=0;d0<4;++d0){
    const bf16x8 b0=*reinterpret_cast<const bf16x8*>(kb+d0*2048);
    const bf16x8 b1=*reinterpret_cast<const bf16x8*>(kb+d0*2048+512);
    if(d0==0){p0=__builtin_amdgcn_mfma_f32_32x32x16_bf16(b0,qr[0],negm,0,0,0);p1=__builtin_amdgcn_mfma_f32_32x32x16_bf16(b1,qr[0],negm,0,0,0);}
    else{p0=__builtin_amdgcn_mfma_f32_32x32x16_bf16(b0,qr[d0],p0,0,0,0);p1=__builtin_amdgcn_mfma_f32_32x32x16_bf16(b1,qr[d0],p1,0,0,0);}}
}
typedef __attribute__((address_space(3))) const char* lds_cptr;
typedef short v4i16_t __attribute__((ext_vector_type(4)));
__device__ __forceinline__ void kload8(bf16x8*kf,lds_cptr kp){
  kf[0]=*(const __attribute__((address_space(3))) bf16x8*)(kp);      kf[1]=*(const __attribute__((address_space(3))) bf16x8*)(kp+512);
  kf[2]=*(const __attribute__((address_space(3))) bf16x8*)(kp+2048); kf[3]=*(const __attribute__((address_space(3))) bf16x8*)(kp+2560);
  kf[4]=*(const __attribute__((address_space(3))) bf16x8*)(kp+4096); kf[5]=*(const __attribute__((address_space(3))) bf16x8*)(kp+4608);
  kf[6]=*(const __attribute__((address_space(3))) bf16x8*)(kp+6144); kf[7]=*(const __attribute__((address_space(3))) bf16x8*)(kp+6656);
}
__device__ __forceinline__ void kload2(bf16x8*kf,lds_cptr kp,int j){ kf[2*j]=*(const __attribute__((address_space(3))) bf16x8*)(kp+j*2048); kf[2*j+1]=*(const __attribute__((address_space(3))) bf16x8*)(kp+j*2048+512); }
__device__ __forceinline__ s16x4 vtr(lds_cptr p){ return __builtin_bit_cast(s16x4,__builtin_amdgcn_ds_read_tr16_b64_v4i16((__attribute__((address_space(3))) v4i16_t*)p)); }
__device__ __forceinline__ float rowmax(const f32x16&p0,const f32x16&p1){
  float a=max3f(p0[0],p0[1],p1[0]),b=max3f(p0[2],p0[3],p1[1]);a=max3f(a,p1[2],p1[3]);
  #pragma unroll
  for(int r=4;r<16;r+=4){a=max3f(a,p0[r],p0[r+1]);b=max3f(b,p0[r+2],p0[r+3]);a=max3f(a,p1[r],p1[r+1]);b=max3f(b,p1[r+2],p1[r+3]);}
  const float m=max2f(a,b);
  auto rr=__builtin_amdgcn_permlane32_swap(__float_as_uint(m),__float_as_uint(m),false,false);
  return max2f(__uint_as_float(rr[0]),__uint_as_float(rr[1]));
}
__device__ __forceinline__ void pv(f32x16*o,int vb,bf16x8 pa0,bf16x8 pa1,bf16x8 pa2,bf16x8 pa3){
  #pragma unroll
  for(int d0=0;d0<2;++d0){s16x4 lo[4],hi[4];
    #pragma unroll
    for(int ks=0;ks<4;++ks){
      asm volatile("ds_read_b64_tr_b16 %0,%1 offset:%c2":"=&v"(lo[ks]):"v"(vb),"i"(d0*4096+ks*1024):"memory");
      asm volatile("ds_read_b64_tr_b16 %0,%1 offset:%c2":"=&v"(hi[ks]):"v"(vb),"i"(d0*4096+ks*1024+512):"memory");}
    asm volatile("s_waitcnt lgkmcnt(0)":::"memory");SBAR();
    #define PK(k) (bf16x8){lo[k][0],lo[k][1],lo[k][2],lo[k][3],hi[k][0],hi[k][1],hi[k][2],hi[k][3]}
    o[d0]=__builtin_amdgcn_mfma_f32_32x32x16_bf16(pa0,PK(0),o[d0],0,0,0);
    o[d0]=__builtin_amdgcn_mfma_f32_32x32x16_bf16(pa1,PK(1),o[d0],0,0,0);
    o[d0]=__builtin_amdgcn_mfma_f32_32x32x16_bf16(pa2,PK(2),o[d0],0,0,0);
    o[d0]=__builtin_amdgcn_mfma_f32_32x32x16_bf16(pa3,PK(3),o[d0],0,0,0);
    #undef PK
  }
}

#ifndef ATTN_STORE16
#define ATTN_STORE16(p,v) (*(u32x4*)(p)=(v))
#endif
template<int THRL> __device__ __forceinline__ void attn_unit(int b,int qcol,int kcol,int vcol,int ocol,int qb,const bf16*__restrict__ P,bf16*__restrict__ O,char*shm,int tid_in){
  int tid_o=tid_in; asm volatile("":"+v"(tid_o)); const int tid=tid_o,lane=tid&63,r32=lane&31,hi=lane>>5; const int wid=__builtin_amdgcn_readfirstlane(tid>>6);
  const long rowbase=(long)b*SEQ; const int q0=qb*QB;
  const bf16*Qw=P+(rowbase+q0+wid*QBLK)*PIN+qcol;
  const bf16*Kh=P+rowbase*PIN+kcol,*Vh=P+rowbase*PIN+vcol;
  const unsigned lds0=(unsigned)(uintptr_t)shm;
  float*wsf=(float*)(shm+LDS_WS)+wid*64;
  const bf16*ksrc=Kh+(long)lane*PIN+wid*8;
  const bf16*vsrc=Vh+(long)(16*(wid&3)+(lane>>2))*PIN+(wid>>2)*32+(lane&3)*8;
  const unsigned kdst=lds0+LDS_K+wid*1024, vdst=lds0+LDS_V+wid*1024;
  #define DMA_K(t,slot) glds16(ksrc+(long)(t)*KVBLK*PIN,(unsigned)__builtin_amdgcn_readfirstlane(kdst+(slot)))
  #define DMA_V(t,slot) do{ glds16(vsrc+(long)(t)*KVBLK*PIN,(unsigned)__builtin_amdgcn_readfirstlane(vdst+2*(slot))); glds16(vsrc+(long)(t)*KVBLK*PIN+64,(unsigned)__builtin_amdgcn_readfirstlane(vdst+2*(slot)+SLOTB)); }while(0)
  const int vb0=(int)(lds0+LDS_V)+((lane>>4)&1)*32+(lane&3)*8+(4*hi+((lane&15)>>2))*64;
  const char*Kbase=shm+LDS_K; bf16x8 kf[8];
  const lds_cptr shm3=(lds_cptr)shm; const lds_cptr kp0=shm3+LDS_K+hi*1024+r32*16; const lds_cptr vp0=shm3+LDS_V+((lane>>4)&1)*32+(lane&3)*8+(4*hi+((lane&15)>>2))*64;
  const int NT=(q0+QB)/KVBLK;
  DMA_K(0,0);DMA_V(0,0);DMA_K(1,SLOTB);
  bf16x8 qr[4];
  #pragma unroll
  for(int d0=0;d0<4;++d0)qr[d0]=*reinterpret_cast<const bf16x8*>(&Qw[(long)r32*PIN+d0*16+hi*8]);
  float mhat=0.f,l_reg=0.f;f32x16 o[4];o[0]=f32x16{};o[1]=f32x16{};o[2]=f32x16{};o[3]=f32x16{};f32x16 negm=f32x16{};asm volatile("":"+v"(negm));
  const int qrel=wid*QBLK+r32;
  #define CMASK(P0,P1,t) do{int jb_=(t)-(NT-4); if(jb_>=0)cmask(P0,P1,jb_,qrel,hi);}while(0)
  bool resc=false;
  #define START(P0,P1) do{ const float rm=rowmax(P0,P1); resc=false; \
    { const float dl=rm; mhat=fadd_s(mhat,dl); \
      _Pragma("unroll") for(int r=0;r<16;++r){P0[r]=fsub_s(P0[r],dl);P1[r]=fsub_s(P1[r],dl);} \
      _Pragma("unroll") for(int r=0;r<16;++r)negm[r]=-mhat; asm volatile("":"+v"(negm)); } \
    _Pragma("unroll") for(int r=0;r<16;++r)P0[r]=__builtin_amdgcn_exp2f(P0[r]); }while(0)
  #define RESC() do{ if(resc){ asm volatile("s_waitcnt lgkmcnt(0)":::"memory"); \
      _Pragma("unroll") for(int d_=0;d_<4;++d_) _Pragma("unroll") for(int r=0;r<16;++r)o[d_][r]*=wsf[crow(r,hi)]; } }while(0)
  f32x16 pA0,pA1,pB0,pB1;
  int sl_prev=0,sl_cur=0,sl_next=SLOTB;
  #define ROT() do{sl_prev=sl_cur;sl_cur=sl_next;sl_next=(sl_next==(NSLOT-1)*SLOTB)?0:sl_next+SLOTB;}while(0)
  DMA_K(2,2*SLOTB);
  WAIT_BAR(4);
  qkt(pA0,pA1,Kbase,qr,negm,r32,hi);asm volatile("s_nop 15\n\ts_nop 7":"+v"(pA0),"+v"(pA1));CMASK(pA0,pA1,0);
  START(pA0,pA1);
  _Pragma("unroll") for(int r=0;r<16;++r)pA1[r]=__builtin_amdgcn_exp2f(pA1[r]);
  WAIT_BAR(0);
  DMA_K(3,0);DMA_V(1,SLOTB);
  ROT();
  kload8(kf,kp0+sl_cur);
  WAIT_BAR(3);
  s16x4 vlo[8],vhi[8]; u32x4 pw0,pw1,pw2,pw3;
  #define PKW(P,B) cvtpk_s(P[B],P[B+1])
  #define PAF(k) __builtin_bit_cast(bf16x8,pw##k)
  #define VFR(i) (bf16x8){vlo[i][0],vlo[i][1],vlo[i][2],vlo[i][3],vhi[i][0],vhi[i][1],vhi[i][2],vhi[i][3]}
  #define PIN(x) asm volatile("":"+v"(x))
  #define MX3(a,b,c) __builtin_fmaxf(__builtin_fmaxf((a),(b)),(c))
  #define GAPA(MF,A0,A1,A2,A3,W0,W1,PW) do{ MF; sacc+=A0; sacc+=A1; sacc+=A2; sacc+=A3; PIN(sacc); W0; W1; PIN(PW); SBAR(); }while(0)
  #define EX(v) __builtin_amdgcn_exp2f(v)
  #define GAPB(MF,X,B) do{ MF; X[B]=EX(X[B]); X[B+1]=EX(X[B+1]); X[B+2]=EX(X[B+2]); X[B+3]=EX(X[B+3]); PIN(X); SBAR(); }while(0)
  #define VRD(i) do{ vlo[i]=vtr(vp_+(((i)>>2)*4096+((i)&3)*1024)); vhi[i]=vtr(vp_+(((i)>>2)*4096+((i)&3)*1024+512)); }while(0)
  #define VRD2(i) do{ vlo[i]=vtr(vp_+(SLOTB+((i)>>2)*4096+((i)&3)*1024)); vhi[i]=vtr(vp_+(SLOTB+((i)>>2)*4096+((i)&3)*1024+512)); SBAR(); }while(0)
  #define GAPB2(MF,X,B) do{ MF; X[B]=EX(X[B]); X[B+1]=EX(X[B+1]); PIN(X); SBAR(); }while(0)
  #define KRD(G,j) do{ if(G){ kload2(kf,kp0+sl_next,j); SBAR(); } }while(0)
  #define STEP(C0,C1,P0,P1,t,GK,GV,GL) do{ SBAR(); \
    const lds_cptr vp_=vp0+2*sl_prev; \
    VRD(0); SBAR(); float sacc=(P0[0]+P0[1]); \
    GAPA(C0=__builtin_amdgcn_mfma_f32_32x32x16_bf16(kf[0],qr[0],negm,0,0,0), P0[2],P0[3],P0[4],P0[5],     pw0[0]=PKW(P0,0), pw0[1]=PKW(P0,2), pw0); \
    VRD(4); SBAR(); GAPA(C1=__builtin_amdgcn_mfma_f32_32x32x16_bf16(kf[1],qr[0],negm,0,0,0), P0[6],P0[7],P0[8],P0[9],     pw0[2]=PKW(P0,4), pw0[3]=PKW(P0,6), pw0); \
    VRD(1); SBAR(); GAPA(C0=__builtin_amdgcn_mfma_f32_32x32x16_bf16(kf[2],qr[1],C0,0,0,0),   P0[10],P0[11],P0[12],P0[13], pw1[0]=PKW(P0,8), pw1[1]=PKW(P0,10), pw1); \
    VRD(5); SBAR(); GAPA(C1=__builtin_amdgcn_mfma_f32_32x32x16_bf16(kf[3],qr[1],C1,0,0,0),   P0[14],P0[15],P1[0],P1[1],   pw1[2]=PKW(P0,12),pw1[3]=PKW(P0,14), pw1); \
    VRD(2); SBAR(); GAPA(C0=__builtin_amdgcn_mfma_f32_32x32x16_bf16(kf[4],qr[2],C0,0,0,0),   P1[2],P1[3],P1[4],P1[5],     pw2[0]=PKW(P1,0), pw2[1]=PKW(P1,2), pw2); \
    VRD(6); SBAR(); GAPA(C1=__builtin_amdgcn_mfma_f32_32x32x16_bf16(kf[5],qr[2],C1,0,0,0),   P1[6],P1[7],P1[8],P1[9],     pw2[2]=PKW(P1,4), pw2[3]=PKW(P1,6), pw2); \
    VRD(3); SBAR(); GAPA(C0=__builtin_amdgcn_mfma_f32_32x32x16_bf16(kf[6],qr[3],C0,0,0,0),   P1[10],P1[11],P1[12],P1[13], pw3[0]=PKW(P1,8), pw3[1]=PKW(P1,10), pw3); \
    VRD(7); SBAR(); GAPA(C1=__builtin_amdgcn_mfma_f32_32x32x16_bf16(kf[7],qr[3],C1,0,0,0),   P1[14],P1[15],0.f,0.f,       pw3[2]=PKW(P1,12),pw3[3]=PKW(P1,14), pw3); \
    l_reg+=sacc; \
    if(GK){DMA_K((t)+3,sl_cur);} if(GV){DMA_V((t)+1,sl_next);} \
    CMASK(C0,C1,t); \
    { float a=MX3(C0[0],C0[1],C1[0]),b=MX3(C0[2],C0[3],C1[1]); a=MX3(a,C1[2],C1[3]); \
      _Pragma("unroll") for(int r=4;r<16;r+=4){a=MX3(a,C0[r],C0[r+1]);b=MX3(b,C0[r+2],C0[r+3]);a=MX3(a,C1[r],C1[r+1]);b=MX3(b,C1[r+2],C1[r+3]);} \
      float rm=__builtin_fmaxf(a,b); { auto rr=__builtin_amdgcn_permlane32_swap(__float_as_uint(rm),__float_as_uint(rm),false,false); rm=__builtin_fmaxf(__uint_as_float(rr[0]),__uint_as_float(rr[1])); } \
      resc=false; \
      if(__builtin_expect(__any(rm>(float)THRL),0)){ const float dl=__builtin_fmaxf(rm,0.f); mhat+=dl; \
        _Pragma("unroll") for(int r=0;r<16;++r){C0[r]-=dl;C1[r]-=dl;} \
        _Pragma("unroll") for(int r=0;r<16;++r)negm[r]=-mhat; asm volatile("":"+v"(negm)); \
        const float f=__builtin_amdgcn_exp2f(-dl); l_reg*=f; if(hi==0)wsf[r32]=f; resc=true; } } \
    SBAR(); \
    GAPB2(o[0]=__builtin_amdgcn_mfma_f32_32x32x16_bf16(PAF(0),VFR(0),o[0],0,0,0), C0,0); VRD2(0); \
    GAPB2(o[1]=__builtin_amdgcn_mfma_f32_32x32x16_bf16(PAF(0),VFR(4),o[1],0,0,0), C0,2); VRD2(4); \
    KRD(GL,0); GAPB2(o[0]=__builtin_amdgcn_mfma_f32_32x32x16_bf16(PAF(1),VFR(1),o[0],0,0,0), C0,4); VRD2(1); \
    KRD(GL,1); GAPB2(o[1]=__builtin_amdgcn_mfma_f32_32x32x16_bf16(PAF(1),VFR(5),o[1],0,0,0), C0,6); VRD2(5); \
    KRD(GL,2); GAPB2(o[0]=__builtin_amdgcn_mfma_f32_32x32x16_bf16(PAF(2),VFR(2),o[0],0,0,0), C0,8); VRD2(2); \
    KRD(GL,3); GAPB2(o[1]=__builtin_amdgcn_mfma_f32_32x32x16_bf16(PAF(2),VFR(6),o[1],0,0,0), C0,10); VRD2(6); \
    GAPB2(o[0]=__builtin_amdgcn_mfma_f32_32x32x16_bf16(PAF(3),VFR(3),o[0],0,0,0), C0,12); VRD2(3); \
    GAPB2(o[1]=__builtin_amdgcn_mfma_f32_32x32x16_bf16(PAF(3),VFR(7),o[1],0,0,0), C0,14); VRD2(7); \
    GAPB2(o[2]=__builtin_amdgcn_mfma_f32_32x32x16_bf16(PAF(0),VFR(0),o[2],0,0,0), C1,0); \
    GAPB2(o[3]=__builtin_amdgcn_mfma_f32_32x32x16_bf16(PAF(0),VFR(4),o[3],0,0,0), C1,2); \
    GAPB2(o[2]=__builtin_amdgcn_mfma_f32_32x32x16_bf16(PAF(1),VFR(1),o[2],0,0,0), C1,4); \
    GAPB2(o[3]=__builtin_amdgcn_mfma_f32_32x32x16_bf16(PAF(1),VFR(5),o[3],0,0,0), C1,6); \
    GAPB2(o[2]=__builtin_amdgcn_mfma_f32_32x32x16_bf16(PAF(2),VFR(2),o[2],0,0,0), C1,8); \
    GAPB2(o[3]=__builtin_amdgcn_mfma_f32_32x32x16_bf16(PAF(2),VFR(6),o[3],0,0,0), C1,10); \
    GAPB2(o[2]=__builtin_amdgcn_mfma_f32_32x32x16_bf16(PAF(3),VFR(3),o[2],0,0,0), C1,12); \
    GAPB2(o[3]=__builtin_amdgcn_mfma_f32_32x32x16_bf16(PAF(3),VFR(7),o[3],0,0,0), C1,14); \
    }while(0)
  int t=1;
  #undef CMASK
  #define CMASK(P0,P1,t) do{}while(0)
  for(;t+5<NT;t+=2){
    STEP(pB0,pB1,pA0,pA1,t,true,true,true);     WAIT_BAR(3); RESC(); ROT();
    STEP(pA0,pA1,pB0,pB1,t+1,true,true,true);   WAIT_BAR(3); RESC(); ROT();
  }
  #undef CMASK
  #define CMASK(P0,P1,t) do{int jb_=(t)-(NT-4); if(jb_>=0)cmask(P0,P1,jb_,qrel,hi);}while(0)
  #define ENDW(tt) do{ if((tt)+3<NT){WAIT_BAR(3);} else if((tt)+2<NT){WAIT_BAR(2);} else {WAIT_BAR(0);} }while(0)
  for(;t+1<NT;t+=2){
    STEP(pB0,pB1,pA0,pA1,t,(t+3<NT),(t+1<NT),(t+1<NT));       ENDW(t);   RESC(); ROT();
    STEP(pA0,pA1,pB0,pB1,t+1,(t+4<NT),(t+2<NT),(t+2<NT));     ENDW(t+1); RESC(); ROT();
  }
  STEP(pB0,pB1,pA0,pA1,NT-1,false,false,false); RESC();
  { float sacc=pB0[0]+pB0[1]; _Pragma("unroll") for(int r=2;r<16;++r)sacc+=pB0[r]; _Pragma("unroll") for(int r=0;r<16;++r)sacc+=pB1[r]; l_reg+=sacc;
    pw0=(u32x4){PKW(pB0,0),PKW(pB0,2),PKW(pB0,4),PKW(pB0,6)};pw1=(u32x4){PKW(pB0,8),PKW(pB0,10),PKW(pB0,12),PKW(pB0,14)};pw2=(u32x4){PKW(pB1,0),PKW(pB1,2),PKW(pB1,4),PKW(pB1,6)};pw3=(u32x4){PKW(pB1,8),PKW(pB1,10),PKW(pB1,12),PKW(pB1,14)};
    SBAR(); pv(o,vb0+2*sl_cur,PAF(0),PAF(1),PAF(2),PAF(3)); pv(o+2,vb0+2*sl_cur+SLOTB,PAF(0),PAF(1),PAF(2),PAF(3)); }
  #undef PKW
  #undef PAF
  #undef VFR
  #undef PIN
  #undef MX3
  #undef GAPA
  #undef GAPB
  #undef EX
  #undef VRD
  #undef VRD2
  #undef GAPB2
  #undef KRD
  #undef STEP
  #undef ENDW
  {auto rr=__builtin_amdgcn_permlane32_swap(__float_as_uint(l_reg),__float_as_uint(l_reg),false,false);l_reg=__uint_as_float(rr[0])+__uint_as_float(rr[1]);}
  if(hi==0)wsf[32+r32]=l_reg;asm volatile("s_waitcnt lgkmcnt(0)":::"memory");
  float rli[16];
  #pragma unroll
  for(int r=0;r<16;++r)rli[r]=__builtin_amdgcn_rcpf(wsf[32+crow(r,hi)]);
  bf16*Ow=O+(rowbase+q0+wid*QBLK)*POUT+ocol;
  { bf16*stg=(bf16*)(shm+LDS_OST)+wid*2048;
    #pragma unroll
    for(int vh=0;vh<2;++vh){
    #pragma unroll
    for(int r=0;r<16;++r){const int orow=crow(r,hi);
      #pragma unroll
      for(int d0=0;d0<2;++d0)stg[orow*64+d0*32+r32]=__float2bfloat16(o[2*vh+d0][r]*rli[r]);}
    asm volatile("s_waitcnt lgkmcnt(0)":::"memory");
    #pragma unroll
    for(int i=0;i<4;++i){const int row=i*8+(lane>>3),ch=lane&7; const u32x4 v=*(const u32x4*)(stg+row*64+ch*8); ATTN_STORE16(Ow+(long)row*POUT+vh*64+ch*8,v);}
    asm volatile("s_waitcnt lgkmcnt(0)":::"memory"); } }
  asm volatile("s_waitcnt lgkmcnt(0)\n\ts_barrier":::"memory");
  #undef DMA_K
  #undef DMA_V
  #undef CMASK
  #undef START
  #undef RESC
  #undef ROT
}
constexpr int ATTN_LDS_BYTES=LDS_BYTES;
#undef SBAR
#undef WAIT_BAR
}
#define GAS __attribute__((address_space(1)))
#define LAS __attribute__((address_space(3)))
typedef unsigned short bf16;
typedef unsigned v4u __attribute__((ext_vector_type(4)));
typedef unsigned v2u __attribute__((ext_vector_type(2)));
typedef float f32x4 __attribute__((ext_vector_type(4)));
typedef short bf16x8 __attribute__((ext_vector_type(8)));
#define LDS_WAIT() asm volatile("s_waitcnt lgkmcnt(0)" ::: "memory")

#ifndef HGRN_NAIVE
#define HGRN_NAIVE 0
#endif
constexpr int NWAVES = 8, NTHREADS = 512;
constexpr int BATCH = 2, SEQ = 8192, DM = 2048, M = BATCH * SEQ, DFF = 5632, INW = 7168, AW = 1024, HW = 1024, NH = 8;
constexpr int C_QA = 0, C_KA = 1024, C_VA = 2048, C_QH = 3072, C_FH = 4096, C_IH = 5120, C_GH = 6144;
constexpr float NORM_EPS = 1e-6f, SUBLN_EPS = 1e-5f;
constexpr int LDS_BYTES = 147456, RING_BYTES = 131072;

constexpr size_t SZ_WGU = (size_t)2 * DFF * DM * 2, SZ_WD = (size_t)DM * DFF * 2, SZ_WIN = (size_t)INW * DM * 2, SZ_WOUT = (size_t)DM * DM * 2;
constexpr size_t WS_WGU1 = 0, WS_WD1 = WS_WGU1 + SZ_WGU, WS_WIN = WS_WD1 + SZ_WD, WS_WOUT = WS_WIN + SZ_WIN, WS_WGU2 = WS_WOUT + SZ_WOUT, WS_WD2 = WS_WGU2 + SZ_WGU;
constexpr size_t WS_XN = WS_WD2 + SZ_WD;
constexpr size_t WS_MIX = WS_XN + (size_t)M * DM * 2;
constexpr size_t WS_BIG = WS_MIX + (size_t)M * DM * 2;
constexpr size_t WS_ATTO = WS_BIG + (size_t)M * INW * 2;
constexpr size_t WS_ST = WS_ATTO + (size_t)M * DM * 2;
constexpr size_t WS_DEC = WS_ST + (size_t)2048 * 128 * 128 * 2;
constexpr size_t WS_BAR = WS_DEC + (size_t)2048 * 128 * 4;
constexpr size_t WS_SSQ = WS_BAR + 16384;
constexpr size_t WS_END = WS_SSQ + (size_t)7 * M * 32 * 4;

__device__ __forceinline__ unsigned f2bf(float f) { unsigned u = __builtin_bit_cast(unsigned, f); return (u + 0x7fffu + ((u >> 16) & 1u)) >> 16; }
__device__ __forceinline__ unsigned pk2(float lo, float hi) { return f2bf(lo) | (f2bf(hi) << 16); }
__device__ __forceinline__ float bf2f(unsigned short b) { return __builtin_bit_cast(float, (unsigned)b << 16); }
using pg8::shx;
__device__ __forceinline__ float wave_sum(float v, int lane) {
#pragma unroll
    for (int o = 1; o < 64; o <<= 1) v += shx(v, lane, o);
    return v;
}

#define RLX_AGENT __ATOMIC_RELAXED, __HIP_MEMORY_SCOPE_AGENT
#define XB_TMO      128
#define XB_XCNT(j)  (256  + 64 * (j))
#define XB_XSUB(j)  (1280 + 64 * (j))
#define XB_XGEN(j)  (2304 + 64 * (j))
#define XB_TOP      3328
#define XB_TOPGEN   3392
#define XCD_BAR_WORDS 3456
#define XB_SPIN_CAP (1u << 18)

__device__ __forceinline__ unsigned xb_ld(unsigned* p)              { return __hip_atomic_load(p, __ATOMIC_RELAXED, __HIP_MEMORY_SCOPE_AGENT); }
__device__ __forceinline__ unsigned xb_add(unsigned* p, unsigned v) { return __hip_atomic_fetch_add(p, v, __ATOMIC_RELAXED, __HIP_MEMORY_SCOPE_AGENT); }
__device__ __forceinline__ unsigned xb_xcc_id() { return (unsigned)__builtin_amdgcn_s_getreg((3 << 11) | 20) & 0xFu; }
#define XB_SPIN(cond, bar) do { unsigned _sp = 0; while (cond) { __builtin_amdgcn_s_sleep(1); \
    if ((++_sp & 255u) == 0u) { if (xb_ld(&(bar)[XB_TMO])) break; if (_sp > XB_SPIN_CAP) { atomicAdd(&(bar)[XB_TMO], 1u); break; } } } } while (0)

struct XcdBarrier {
    unsigned* bar; unsigned x;
    volatile LAS unsigned* st;
};

__device__ __forceinline__ XcdBarrier xcd_barrier_post(unsigned* bar, volatile LAS unsigned* st, int tid) {
    XcdBarrier b; b.bar = bar; b.x = xb_xcc_id(); b.st = st;
    if (tid == 0) (void)xb_add(&bar[XB_XCNT(b.x)], 1u);
    return b;
}
__device__ __forceinline__ void xcd_barrier_complete(unsigned* bar, unsigned x, unsigned& nloc, unsigned& nx) {
    const unsigned G = gridDim.x * gridDim.y * gridDim.z;
    unsigned sum, cnt, mine, sp = 0u;
    for (;;) {
        sum = 0u; cnt = 0u; mine = 0u;
#pragma unroll
        for (unsigned j = 0; j < 16; ++j) { const unsigned c = xb_ld(&bar[XB_XCNT(j)]); sum += c; cnt += (c > 0u) ? 1u : 0u; mine = (j == x) ? c : mine; }
        if (sum == G) break;
        __builtin_amdgcn_s_sleep(1);
        if ((++sp & 255u) == 0u) { if (xb_ld(&bar[XB_TMO])) break; if (sp > XB_SPIN_CAP) { atomicAdd(&bar[XB_TMO], 1u); break; } }
    }
    nloc = mine > 0u ? mine : 1u; nx = cnt > 0u ? cnt : 1u;
}

__device__ __forceinline__ void xcd_barrier(const XcdBarrier& b, int tid) {
    asm volatile("s_waitcnt vmcnt(0)" ::: "memory");
    __syncthreads();
    if (tid == 0) {
        unsigned* bar = b.bar;
        __builtin_amdgcn_s_waitcnt(0);
        unsigned nloc = b.st[0], nx = b.st[1];
        if (nloc == 0u) { xcd_barrier_complete(bar, b.x, nloc, nx); b.st[0] = nloc; b.st[1] = nx; }
        const unsigned old = xb_add(&bar[XB_XSUB(b.x)], 1u);
        const unsigned gen = old / nloc;
        if (old + 1u == (gen + 1u) * nloc) {
            __builtin_amdgcn_fence(__ATOMIC_RELEASE, "agent");
            asm volatile("s_waitcnt vmcnt(0)" ::: "memory");
            const unsigned og = xb_add(&bar[XB_TOP], 1u);
            const unsigned tg = og / nx;
            if (og + 1u == (tg + 1u) * nx) xb_add(&bar[XB_TOPGEN], 1u);
            else XB_SPIN(xb_ld(&bar[XB_TOPGEN]) == tg, bar);
            __builtin_amdgcn_fence(__ATOMIC_ACQUIRE, "agent");
            xb_add(&bar[XB_XGEN(b.x)], 1u);
            asm volatile("s_waitcnt vmcnt(0)" ::: "memory");
        } else {
            XB_SPIN(xb_ld(&bar[XB_XGEN(b.x)]) == gen, bar);
            __builtin_amdgcn_fence(__ATOMIC_ACQUIRE, "agent");
            asm volatile("s_waitcnt vmcnt(0)" ::: "memory");
        }
    }
    __syncthreads();
}

struct Args { const float* in[20]; float* out; unsigned char* ws; int ph_lo, ph_hi; };

__device__ __forceinline__ void transpose_item(const float* W, int K, int N, bf16* WT, int mode, const float* nw, LAS float* scr, int item, int lane) {
    const int nblk = N / 32, kb = item / nblk, nb = item % nblk, k0 = 64 * kb, n0 = 32 * nb;
    const int drow0 = (mode == 0) ? n0 : ((n0 >> 7) * 256 + (n0 & 127) + (mode == 2 ? 128 : 0));
#pragma unroll 8
    for (int i = 0; i < 32; ++i) { const int kk = 2 * i + (lane >> 5); scr[kk * 33 + (lane & 31)] = W[(size_t)(k0 + kk) * N + n0 + (lane & 31)]; }
    LDS_WAIT(); asm volatile("" ::: "memory");
    const int c = lane & 7;
    f32x4 na = {1.f, 1.f, 1.f, 1.f}, nb2 = na;
    if (nw) { na = *(const GAS f32x4*)(nw + k0 + 8 * c); nb2 = *(const GAS f32x4*)(nw + k0 + 8 * c + 4); }
#pragma unroll
    for (int j = 0; j < 4; ++j) { const int n = (lane >> 3) + 8 * j; const LAS float* s = scr + (8 * c) * 33 + n;
        v4u o; o.x = pk2(s[0 * 33] * na.x, s[1 * 33] * na.y); o.y = pk2(s[2 * 33] * na.z, s[3 * 33] * na.w); o.z = pk2(s[4 * 33] * nb2.x, s[5 * 33] * nb2.y); o.w = pk2(s[6 * 33] * nb2.z, s[7 * 33] * nb2.w);
        const int r = drow0 + n; *(GAS v4u*)(WT + ((size_t)((r >> 8) * (K >> 6) + kb) * 256 + (r & 255)) * 64 + 8 * c) = o; }
    LDS_WAIT(); asm volatile("" ::: "memory");
}
__device__ __forceinline__ void rms_row_to_bf16(const float* xrow, const float* w, bf16* orow, int lane) {
    const GAS f32x4* xr = (const GAS f32x4*)xrow + lane; const GAS f32x4* wr = (const GAS f32x4*)w + lane;
    f32x4 v[8]; float s = 0.f;
#pragma unroll
    for (int j = 0; j < 8; ++j) { v[j] = xr[64 * j]; s += (v[j].x * v[j].x + v[j].y * v[j].y) + (v[j].z * v[j].z + v[j].w * v[j].w); }
    const float rstd = 1.0f / sqrtf(wave_sum(s, lane) * (1.f / DM) + NORM_EPS);
    GAS v2u* o8 = (GAS v2u*)orow + lane;
#pragma unroll
    for (int j = 0; j < 8; ++j) { const f32x4 ww = wr[64 * j]; v2u o; o.x = pk2(v[j].x * rstd * ww.x, v[j].y * rstd * ww.y); o.y = pk2(v[j].z * rstd * ww.z, v[j].w * rstd * ww.w); o8[64 * j] = o; }
}
__device__ __forceinline__ void row_to_bf16_ssq(const float* xrow, bf16* xn, int m, float* ssq, int lane) {
    const GAS f32x4* xr = (const GAS f32x4*)xrow + lane; float s = 0.f;
#pragma unroll
    for (int j = 0; j < 8; ++j) { const f32x4 v = xr[64 * j]; s += (v.x * v.x + v.y * v.y) + (v.z * v.z + v.w * v.w); v2u o; o.x = pk2(v.x, v.y); o.y = pk2(v.z, v.w); *(GAS v2u*)(xn + pg8::toff(m, 4 * lane + 256 * j, DM / 64)) = o; }
    s = wave_sum(s, lane); if (lane < 32) ssq[lane] = (lane == 0) ? s : 0.f;
}
__device__ __forceinline__ void rms_row_bf16_to_f32(const bf16* xn, int m, float* orow, const float* w, int lane) {
    f32x4 v[4][2]; float s = 0.f;
#pragma unroll
    for (int j = 0; j < 4; ++j) { const v4u b = *(const GAS v4u*)(xn + pg8::toff(m, 8 * lane + 512 * j, DM / 64));
        v[j][0] = (f32x4){__builtin_bit_cast(float, b.x << 16), __builtin_bit_cast(float, b.x & 0xffff0000u), __builtin_bit_cast(float, b.y << 16), __builtin_bit_cast(float, b.y & 0xffff0000u)};
        v[j][1] = (f32x4){__builtin_bit_cast(float, b.z << 16), __builtin_bit_cast(float, b.z & 0xffff0000u), __builtin_bit_cast(float, b.w << 16), __builtin_bit_cast(float, b.w & 0xffff0000u)};
#pragma unroll
        for (int h = 0; h < 2; ++h) s += (v[j][h].x * v[j][h].x + v[j][h].y * v[j][h].y) + (v[j][h].z * v[j][h].z + v[j][h].w * v[j][h].w); }
    const float rstd = 1.0f / sqrtf(wave_sum(s, lane) * (1.f / DM) + NORM_EPS);
#pragma unroll
    for (int j = 0; j < 4; ++j)
#pragma unroll
        for (int h = 0; h < 2; ++h) { const int col = 512 * j + 8 * lane + 4 * h; const f32x4 ww = *(const GAS f32x4*)(w + col); *(GAS f32x4*)(orow + col) = v[j][h] * rstd * ww; }
}
__device__ __forceinline__ void rms_row_to_f32(float* xrow, const float* w, int lane) {
    GAS f32x4* xr = (GAS f32x4*)xrow + lane; const GAS f32x4* wr = (const GAS f32x4*)w + lane;
    f32x4 v[8]; float s = 0.f;
#pragma unroll
    for (int j = 0; j < 8; ++j) { v[j] = xr[64 * j]; s += (v[j].x * v[j].x + v[j].y * v[j].y) + (v[j].z * v[j].z + v[j].w * v[j].w); }
    const float rstd = 1.0f / sqrtf(wave_sum(s, lane) * (1.f / DM) + NORM_EPS);
#pragma unroll
    for (int j = 0; j < 8; ++j) { const f32x4 ww = wr[64 * j]; xr[64 * j] = v[j] * rstd * ww; }
}
__device__ __forceinline__ float lambda_init_of(int layer) { return layer == 0 ? 0.2f : 0.35550907f; }

__device__ __forceinline__ void postmix_row(int row, float lam, float oml, const bf16* atto, const bf16* rec, const bf16* proj, const float* subln, const float* gnw, bf16* mix, int lane) {
    const bf16* ao = atto + (size_t)row * 2048;
    const int vb = (lane & 15) * 8;
    float sw[8];
#pragma unroll
    for (int e = 0; e < 8; ++e) sw[e] = subln[vb + e] * oml;
#pragma unroll
    for (int j = 0; j < 4; ++j) {
        const v4u raw = *(const GAS v4u*)(ao + j * 512 + lane * 8);
        float v[8], d[8]; float ss = 0.f;
#pragma unroll
        for (int e = 0; e < 4; ++e) { const unsigned w = raw[e]; v[2 * e] = __builtin_bit_cast(float, w << 16); v[2 * e + 1] = __builtin_bit_cast(float, w & 0xffff0000u); }
#pragma unroll
        for (int e = 0; e < 8; ++e) { const float p = shx(v[e], lane | 16, 0); d[e] = v[e] - lam * p; ss += d[e] * d[e]; }
        ss += shx(ss, lane, 1); ss += shx(ss, lane, 2); ss += shx(ss, lane, 4); ss += shx(ss, lane, 8);
        const float rstd = 1.0f / sqrtf(ss * (1.f / 128.f) + SUBLN_EPS);
        v4u o; o.x = pk2(d[0] * rstd * sw[0], d[1] * rstd * sw[1]); o.y = pk2(d[2] * rstd * sw[2], d[3] * rstd * sw[3]); o.z = pk2(d[4] * rstd * sw[4], d[5] * rstd * sw[5]); o.w = pk2(d[6] * rstd * sw[6], d[7] * rstd * sw[7]);
        const int h = 2 * j + (lane >> 5);
        if ((lane & 16) == 0) *(GAS v4u*)(mix + pg8::toff(row, h * 128 + vb, DM / 64)) = o;
    }
    const GAS v2u* rr = (const GAS v2u*)(rec + (size_t)row * HW) + lane;
    f32x4 r[4]; float s = 0.f;
#pragma unroll
    for (int j = 0; j < 4; ++j) { const v2u rw = rr[64 * j]; r[j] = (f32x4){__builtin_bit_cast(float, rw.x << 16), __builtin_bit_cast(float, rw.x & 0xffff0000u), __builtin_bit_cast(float, rw.y << 16), __builtin_bit_cast(float, rw.y & 0xffff0000u)};
        s += (r[j].x * r[j].x + r[j].y * r[j].y) + (r[j].z * r[j].z + r[j].w * r[j].w); }
    const float rstd = 1.0f / sqrtf(wave_sum(s, lane) * (1.f / HW) + NORM_EPS);
#pragma unroll
    for (int j = 0; j < 4; ++j) { const int col = 4 * lane + 256 * j;
        const v2u graw = *(const GAS v2u*)(proj + (size_t)row * INW + C_GH + col); const f32x4 gw = *(const GAS f32x4*)(gnw + col);
        float g[4] = { __builtin_bit_cast(float, graw.x << 16), __builtin_bit_cast(float, graw.x & 0xffff0000u), __builtin_bit_cast(float, graw.y << 16), __builtin_bit_cast(float, graw.y & 0xffff0000u) };
        float o[4];
#pragma unroll
        for (int e = 0; e < 4; ++e) { const float sg = g[e] / (1.0f + __expf(-g[e])); o[e] = r[j][e] * rstd * gw[e] * sg; }
        v2u ov; ov.x = pk2(o[0], o[1]); ov.y = pk2(o[2], o[3]);
        *(GAS v2u*)(mix + pg8::toff(row, 1024 + col, DM / 64)) = ov; }
}

__device__ __forceinline__ float hgrn_lb(const float* lbsrc, int layer, int ch) { return layer == 0 ? 0.f : 1.0f / (1.0f + __expf(lbsrc[ch] - lbsrc[HW + ch])); }

__device__ __forceinline__ void hgrn_naive_item(int item, const bf16* proj, float* rec, const float* lbsrc, int layer, LAS unsigned char* lds, int tid) {
    typedef float f32x2 __attribute__((ext_vector_type(2)));
    LAS f32x2* tile = (LAS f32x2*)lds;
    const int b = item >> 3, h = item & 7, lane = tid & 63, wave = tid >> 6;
    const int k = tid & 127, tq = tid >> 7;
    const float lb = hgrn_lb(lbsrc, layer, h * 128 + k);
    float S[128];
#pragma unroll
    for (int i = 0; i < 128; ++i) S[i] = 0.f;
    for (int tb = 0; tb < SEQ / 64; ++tb) {
        const size_t row0 = (size_t)b * SEQ + (size_t)tb * 64;
#pragma unroll 4
        for (int j = 0; j < 16; ++j) { const int t = tq + 4 * j; const bf16* pr = proj + (row0 + t) * INW + h * 128 + k;
            const float z = bf2f(pr[C_FH]), q = bf2f(pr[C_QH]); const float f = lb + (1.0f - lb) / (1.0f + __expf(-z));
            tile[t * 128 + k] = (f32x2){f, q}; }
        __syncthreads();
        if (wave < 2) { const int v = wave * 64 + lane;
            for (int t = 0; t < 64; ++t) { const float iv = bf2f(proj[(row0 + t) * INW + C_IH + h * 128 + v]); float o = 0.f;
#pragma unroll
                for (int kk = 0; kk < 128; ++kk) { const f32x2 fq = tile[t * 128 + kk]; S[kk] = fq.x * (S[kk] - iv) + iv; o += fq.y * S[kk]; }
                rec[(row0 + t) * HW + h * 128 + v] = o; } }
        __syncthreads();
    }
}

constexpr int HG_TOT = 0, HG_A1 = 2048, HG_A2 = HG_A1 + 64 * 272, HG_B1 = HG_A2 + 64 * 272, HG_VT = HG_B1 + 64 * 272, HG_P = HG_VT + 128 * 144, HG_END = HG_P + 64 * 144;
constexpr int HG_B3T = 2048;
static_assert(HG_B3T + 128 * 144 <= HG_VT && HG_END <= RING_BYTES, "HGRN LDS map");
struct HgRaw { unsigned zq[16], vv[8]; };
template <int PASS>
__device__ __forceinline__ void hg_load(HgRaw& R, int unit, const bf16* proj, int tid) {
    const int bh = unit >> 7, c = unit & 127, b = bh >> 3, h = bh & 7; const size_t row0 = (size_t)b * SEQ + (size_t)c * 64; const int k = tid & 127, tg = tid >> 7;
    const bf16* pz = proj + (row0 + 16 * tg) * INW + h * 128 + k;
#pragma unroll
    for (int j = 0; j < 16; ++j) { const unsigned z = pz[(size_t)j * INW + C_FH]; const unsigned q = (PASS == 3) ? pz[(size_t)j * INW + C_QH] : 0u; R.zq[j] = z | (q << 16); }
#pragma unroll
    for (int j = 0; j < 8; ++j) { const unsigned a = pz[(size_t)(2 * j) * INW + C_IH], b2 = pz[(size_t)(2 * j + 1) * INW + C_IH]; R.vv[j] = a | (b2 << 16); }
}
template <int PASS>
__device__ __forceinline__ void hgrn_chunk_unit(const HgRaw& R, int unit, const bf16* proj, f32x4 (&RS)[8], float& cumlog, float* Fseg, float* dseg, float* dec, bf16* ST, const bf16* Gseg, bf16* rec, const float* lbsrc, int layer, LAS unsigned char* lds, int tid) {
    const int bh = unit >> 7, c = unit & 127, b = bh >> 3, h = bh & 7;
    const size_t row0 = (size_t)b * SEQ + (size_t)c * 64;
    const int k = tid & 127, tg = tid >> 7, lane = tid & 63, w = __builtin_amdgcn_readfirstlane(tid >> 6), fr = lane & 15, fq = lane >> 4;
    LAS float* TOT = (LAS float*)(lds + HG_TOT);
    const float lb = hgrn_lb(lbsrc, layer, h * 128 + k);
    float bcum[16], kk[16], qv[16];
    {   float run = 0.f;
#pragma unroll
        for (int j = 0; j < 16; ++j) { const float z = __builtin_bit_cast(float, R.zq[j] << 16);
            if (PASS == 3) qv[j] = __builtin_bit_cast(float, R.zq[j] & 0xffff0000u);
            const float e = __expf(-z); const float sg = 1.0f / (1.0f + e);
            const float f = fmaxf(lb + (1.0f - lb) * sg, 1e-26f);
            kk[j] = (1.0f - lb) * (e * sg);
            run += __logf(f); bcum[j] = run; }
        TOT[tg * 128 + k] = run;
    }
    {   v4u o0, o1;
        o0.x = R.vv[0]; o0.y = R.vv[1]; o0.z = R.vv[2]; o0.w = R.vv[3]; o1.x = R.vv[4]; o1.y = R.vv[5]; o1.z = R.vv[6]; o1.w = R.vv[7];
        *(LAS v4u*)(lds + HG_VT + k * 144 + tg * 32) = o0; *(LAS v4u*)(lds + HG_VT + k * 144 + tg * 32 + 16) = o1;
    }
    __syncthreads();
    const float t0 = TOT[k], t1 = TOT[128 + k], t2 = TOT[256 + k], t3 = TOT[384 + k];
    const float off = (tg > 0 ? t0 : 0.f) + (tg > 1 ? t1 : 0.f) + (tg > 2 ? t2 : 0.f);
    const float blast = (t0 + t1) + (t2 + t3);
    if (PASS == 1) {
        unsigned pkd[8];
#pragma unroll
        for (int j = 0; j < 16; j += 2) pkd[j >> 1] = pk2(kk[j] * __expf(blast - (off + bcum[j])), kk[j + 1] * __expf(blast - (off + bcum[j + 1])));
        *(LAS v4u*)(lds + HG_B3T + k * 144 + tg * 32) = (v4u){pkd[0], pkd[1], pkd[2], pkd[3]};
        *(LAS v4u*)(lds + HG_B3T + k * 144 + tg * 32 + 16) = (v4u){pkd[4], pkd[5], pkd[6], pkd[7]};
        LAS float* DL = (LAS float*)(lds + HG_P);
        if (tg == 0) { dec[(size_t)unit * 128 + k] = __expf(cumlog); DL[k] = __expf(blast); }
        cumlog += blast;
        if (tg == 0 && (unit & 7) == 7) dseg[(size_t)(unit >> 3) * 128 + k] = __expf(cumlog);
        __syncthreads();
        bf16x8 yv[2];
#pragma unroll
        for (int ks = 0; ks < 2; ++ks) yv[ks] = *(const LAS bf16x8*)(lds + HG_VT + (16 * w + fr) * 144 + ks * 64 + fq * 16);
        bf16* Pu = ST + (size_t)unit * 16384 + (size_t)(16 * w + fr) * 128 + 4 * fq;
#pragma unroll
        for (int xb = 0; xb < 8; ++xb) { f32x4 acc = {0.f, 0.f, 0.f, 0.f};
#pragma unroll
            for (int ks = 0; ks < 2; ++ks) { const bf16x8 xv = *(const LAS bf16x8*)(lds + HG_B3T + (16 * xb + fr) * 144 + ks * 64 + fq * 16);
                acc = __builtin_amdgcn_mfma_f32_16x16x32_bf16(xv, yv[ks], acc, 0, 0, 0); }
            *(GAS v2u*)(Pu + 16 * xb) = (v2u){pk2(RS[xb][0], RS[xb][1]), pk2(RS[xb][2], RS[xb][3])};
            const f32x4 dl = *(const LAS f32x4*)(DL + 16 * xb + 4 * fq);
            RS[xb] = dl * RS[xb] + acc; }
        if ((unit & 7) == 7) { float* Fu = Fseg + (size_t)(unit >> 3) * 16384 + (size_t)(16 * w + fr) * 128 + 4 * fq;
#pragma unroll
            for (int xb = 0; xb < 8; ++xb) *(GAS f32x4*)(Fu + 16 * xb) = RS[xb]; }
    } else {
        const float r = t0 + t1;
#pragma unroll
        for (int j = 0; j < 16; ++j) { const float bj = off + bcum[j]; const int t = 16 * tg + j;
            const float a1 = qv[j] * __expf(fminf(bj - r, 80.f)), a2 = qv[j] * __expf(bj), b1 = kk[j] * __expf(fminf(r - bj, 80.f));
            *(LAS unsigned short*)(lds + HG_A1 + t * 272 + k * 2) = (unsigned short)f2bf(a1);
            *(LAS unsigned short*)(lds + HG_A2 + t * 272 + k * 2) = (unsigned short)f2bf(a2);
            *(LAS unsigned short*)(lds + HG_B1 + t * 272 + k * 2) = (unsigned short)f2bf(b1); }
        bf16x8 sx[4];
#pragma unroll
        for (int ks = 0; ks < 4; ++ks) { const size_t eo = (size_t)(16 * w + fr) * 128 + 32 * ks + 8 * fq;
            const v4u pl = *(const GAS v4u*)(ST + (size_t)unit * 16384 + eo), gl = *(const GAS v4u*)(Gseg + (size_t)(unit >> 3) * 16384 + eo);
            const f32x4 d0 = *(const GAS f32x4*)(dec + (size_t)unit * 128 + 32 * ks + 8 * fq), d1 = *(const GAS f32x4*)(dec + (size_t)unit * 128 + 32 * ks + 8 * fq + 4);
            v4u so;
            so.x = pk2(d0[0] * __builtin_bit_cast(float, gl.x << 16) + __builtin_bit_cast(float, pl.x << 16), d0[1] * __builtin_bit_cast(float, gl.x & 0xffff0000u) + __builtin_bit_cast(float, pl.x & 0xffff0000u));
            so.y = pk2(d0[2] * __builtin_bit_cast(float, gl.y << 16) + __builtin_bit_cast(float, pl.y << 16), d0[3] * __builtin_bit_cast(float, gl.y & 0xffff0000u) + __builtin_bit_cast(float, pl.y & 0xffff0000u));
            so.z = pk2(d1[0] * __builtin_bit_cast(float, gl.z << 16) + __builtin_bit_cast(float, pl.z << 16), d1[1] * __builtin_bit_cast(float, gl.z & 0xffff0000u) + __builtin_bit_cast(float, pl.z & 0xffff0000u));
            so.w = pk2(d1[2] * __builtin_bit_cast(float, gl.w << 16) + __builtin_bit_cast(float, pl.w << 16), d1[3] * __builtin_bit_cast(float, gl.w & 0xffff0000u) + __builtin_bit_cast(float, pl.w & 0xffff0000u));
            sx[ks] = __builtin_bit_cast(bf16x8, so); }
        __syncthreads();
#pragma unroll
        for (int rep = 0; rep < 2; ++rep) { const int id = w + 8 * rep, sb = id >> 2, tb = id & 3;
            f32x4 acc = {0.f, 0.f, 0.f, 0.f};
            if (sb <= tb) {
#pragma unroll
                for (int ks = 0; ks < 4; ++ks) { const bf16x8 xv = *(const LAS bf16x8*)(lds + HG_B1 + (16 * sb + fr) * 272 + ks * 64 + fq * 16);
                    const bf16x8 yv = *(const LAS bf16x8*)(lds + HG_A1 + (16 * tb + fr) * 272 + ks * 64 + fq * 16);
                    acc = __builtin_amdgcn_mfma_f32_16x16x32_bf16(xv, yv, acc, 0, 0, 0); }
            }
            const int t = 16 * tb + fr, s0 = 16 * sb + 4 * fq;
            float pvv[4];
#pragma unroll
            for (int i = 0; i < 4; ++i) pvv[i] = (sb <= tb && s0 + i <= t) ? acc[i] : 0.f;
            *(LAS v2u*)(lds + HG_P + t * 144 + s0 * 2) = (v2u){pk2(pvv[0], pvv[1]), pk2(pvv[2], pvv[3])}; }
        __syncthreads();
        bf16x8 vx[2];
#pragma unroll
        for (int ks = 0; ks < 2; ++ks) vx[ks] = *(const LAS bf16x8*)(lds + HG_VT + (16 * w + fr) * 144 + ks * 64 + fq * 16);
#pragma unroll
        for (int tb = 0; tb < 4; ++tb) { f32x4 acc = {0.f, 0.f, 0.f, 0.f};
#pragma unroll
            for (int ks = 0; ks < 2; ++ks) { const bf16x8 yv = *(const LAS bf16x8*)(lds + HG_P + (16 * tb + fr) * 144 + ks * 64 + fq * 16);
                acc = __builtin_amdgcn_mfma_f32_16x16x32_bf16(vx[ks], yv, acc, 0, 0, 0); }
#pragma unroll
            for (int ks = 0; ks < 4; ++ks) { const bf16x8 yv = *(const LAS bf16x8*)(lds + HG_A2 + (16 * tb + fr) * 272 + ks * 64 + fq * 16);
                acc = __builtin_amdgcn_mfma_f32_16x16x32_bf16(sx[ks], yv, acc, 0, 0, 0); }
            *(GAS v2u*)(rec + (row0 + 16 * tb + fr) * HW + h * 128 + 16 * w + 4 * fq) = (v2u){pk2(acc[0], acc[1]), pk2(acc[2], acc[3])}; }
    }
    __syncthreads();
}
__device__ __forceinline__ void hgrn_scan(int gtid, int nthreads, const float* Fseg, const float* dseg, bf16* Gseg) {
    typedef float f32x2 __attribute__((ext_vector_type(2)));
    for (int idx = gtid; idx < 16 * 8192; idx += nthreads) {
        const int bh = idx >> 13, e2 = (idx & 8191) * 2, kq = e2 & 127;
        const float* Fp = Fseg + (size_t)bh * 16 * 16384 + e2; const float* dp = dseg + (size_t)bh * 16 * 128 + kq; unsigned* gp = (unsigned*)(Gseg + (size_t)bh * 16 * 16384 + e2);
        f32x2 S = {0.f, 0.f};
#pragma unroll
        for (int sg = 0; sg < 16; ++sg) { const f32x2 lv = *(const GAS f32x2*)(Fp + (size_t)sg * 16384); const f32x2 d = *(const GAS f32x2*)(dp + sg * 128);
            gp[(size_t)sg * 8192] = pk2(S.x, S.y); S = d * S + lv; }
    }
}

__device__ __forceinline__ void rstd_table(LAS float* tab, const float* ssq, int pm, float inv_n, float eps, int tid) {
    const int r = tid >> 1, hf = tid & 1; const f32x4* p = (const f32x4*)(ssq + (size_t)(pm * 256 + r) * 32 + hf * 16);
    const f32x4 a = p[0], b = p[1], c = p[2], d = p[3];
    const float q0 = ((a[0] + a[1]) + (a[2] + a[3])) + ((b[0] + b[1]) + (b[2] + b[3])), q1 = ((c[0] + c[1]) + (c[2] + c[3])) + ((d[0] + d[1]) + (d[2] + d[3]));
    float s = q0 + q1; s += shx(s, tid & 63, 1);
    if (hf == 0) tab[r] = __builtin_amdgcn_rsqf(s * inv_n + eps);
    __syncthreads();
}
#ifndef GEMM_ALIGN
#define GEMM_ALIGN true
#endif
#ifndef GEMM_SP2
#define GEMM_SP2 true
#endif
constexpr int PH_PER_LAYER = 13, N_PHASES = 2 * PH_PER_LAYER + 1;

__global__ void __launch_bounds__(NTHREADS, 2) hymba_fwd(Args args) {
    extern __shared__ __attribute__((aligned(16))) unsigned char lds_raw[];
    LAS unsigned char* lds = (LAS unsigned char*)lds_raw;
    cg::grid_group grid = cg::this_grid();
    const int G = gridDim.x, bx = blockIdx.x;
    const int vcu = (G % 8 == 0) ? (bx % 8) * (G / 8) + bx / 8 : bx;
    const int NGW = G * NWAVES;
    unsigned char* ws = args.ws;
    const float* x_in = args.in[0];
    float* xres = args.out;
    bf16* XN = (bf16*)(ws + WS_XN); bf16* MIX = (bf16*)(ws + WS_MIX); bf16* BIG = (bf16*)(ws + WS_BIG); bf16* ATTO = (bf16*)(ws + WS_ATTO);
    float* SSQ = (float*)(ws + WS_SSQ);
    bf16* REC = (bf16*)xres; bf16* GSEG = (bf16*)((unsigned char*)xres + (64u << 20)); float* FSEG = (float*)((unsigned char*)xres + (96u << 20)); float* DSEG = (float*)((unsigned char*)xres + (120u << 20));     bf16* ST = (bf16*)(ws + WS_ST); float* DEC = (float*)(ws + WS_DEC);
    bf16* Wgu1 = (bf16*)(ws + WS_WGU1); bf16* Wd1 = (bf16*)(ws + WS_WD1); bf16* Win = (bf16*)(ws + WS_WIN); bf16* Wout = (bf16*)(ws + WS_WOUT); bf16* Wgu2 = (bf16*)(ws + WS_WGU2); bf16* Wd2 = (bf16*)(ws + WS_WD2);

    LAS float* RTAB = (LAS float*)(lds + RING_BYTES + 1024);
    unsigned* barw = (unsigned*)(ws + WS_BAR);
    volatile LAS unsigned* bst = (volatile LAS unsigned*)(lds + RING_BYTES);
    const int wave_s = __builtin_amdgcn_readfirstlane((int)threadIdx.x >> 6);
    if (threadIdx.x < 2) bst[threadIdx.x] = 0u;
    if (bx == 0 && args.ph_lo == 0) for (int i = threadIdx.x; i < 4096; i += NTHREADS) __hip_atomic_store(barw + i, 0u, __ATOMIC_RELAXED, __HIP_MEMORY_SCOPE_AGENT);
    __syncthreads();
#ifdef PROBE_MASK
    int probe_rep = 0;
#endif
    XcdBarrier xbar; xbar.bar = barw; xbar.x = 0; xbar.st = bst;
    for (int ph = args.ph_lo; ph < args.ph_hi; ++ph) {
        const int layer = ph / PH_PER_LAYER, p = (ph == N_PHASES - 1) ? 99 : ph % PH_PER_LAYER;
        if (p == 3 || p == 10 || (p == 8 && !HGRN_NAIVE)) continue;
        int tid_o = tid_from_wave(wave_s); asm volatile("" : "+v"(tid_o));
        const int tid = tid_o;
#define PHASE_IDS const int lane = tid & 63, wave = __builtin_amdgcn_readfirstlane(tid >> 6), gw = vcu * NWAVES + wave; (void)lane; (void)wave; (void)gw;
        switch (p) {
        case 0: {
            PHASE_IDS
            LAS float* scr = (LAS float*)(lds + wave * 16384);
            const float* g1 = args.in[2] + (size_t)layer * DM * DFF; const float* u1 = args.in[3] + (size_t)layer * DM * DFF; const float* d1 = args.in[4] + (size_t)layer * DFF * DM;
            const float* wi = args.in[6] + (size_t)layer * DM * INW; const float* wo = args.in[14] + (size_t)layer * DM * DM;
            const float* g2 = args.in[16] + (size_t)layer * DM * DFF; const float* u2 = args.in[17] + (size_t)layer * DM * DFF; const float* d2 = args.in[18] + (size_t)layer * DFF * DM;
            const float* nw1 = args.in[1] + (size_t)layer * DM; const float* nw2 = args.in[5] + (size_t)layer * DM; const float* nw3 = args.in[15] + (size_t)layer * DM;
            constexpr int I_F = (DM / 64) * (DFF / 32), I_IN = (DM / 64) * (INW / 32), I_OUT = (DM / 64) * (DM / 32);
            constexpr int NITEMS = 6 * I_F + I_IN + I_OUT;
            for (int it = gw; it < NITEMS; it += NGW) {
                int r = it;
                if (r < I_F) { transpose_item(g1, DM, DFF, Wgu1, 1, nw1, scr, r, lane); continue; } r -= I_F;
                if (r < I_F) { transpose_item(u1, DM, DFF, Wgu1, 2, nw1, scr, r, lane); continue; } r -= I_F;
                if (r < I_F) { transpose_item(d1, DFF, DM, Wd1, 0, nullptr, scr, r, lane); continue; } r -= I_F;
                if (r < I_IN) { transpose_item(wi, DM, INW, Win, 0, nw2, scr, r, lane); continue; } r -= I_IN;
                if (r < I_OUT) { transpose_item(wo, DM, DM, Wout, 0, nullptr, scr, r, lane); continue; } r -= I_OUT;
                if (r < I_F) { transpose_item(g2, DM, DFF, Wgu2, 1, nw3, scr, r, lane); continue; } r -= I_F;
                if (r < I_F) { transpose_item(u2, DM, DFF, Wgu2, 2, nw3, scr, r, lane); continue; } r -= I_F;
                transpose_item(d2, DFF, DM, Wd2, 0, nullptr, scr, r, lane);
            }
            if (ph == 0) for (int m = gw; m < M; m += NGW) row_to_bf16_ssq(x_in + (size_t)m * DM, XN, m, SSQ + (size_t)m * 32, lane);
        } break;
        case 1: case 11: {
            pg8::Gemm g{XN, p == 1 ? Wgu1 : Wgu2, M, 2 * DFF, DM}; pg8::StaticOrder S; S.init(M, 2 * DFF, G, bx);
            const float* sq = SSQ + (size_t)(layer * 3 + (p == 1 ? 0 : 2)) * M * 32; pg8::Unit u0; S.next(0, u0); rstd_table(RTAB, sq, u0.pm, 1.0f / DM, NORM_EPS, tid);
            pg8::EpiSwiGLU E{BIG, DFF, sq, 1.0f / DM, NORM_EPS, RTAB, u0.pm};
            pg8::gemm_phase<pg8::EpiSwiGLU, pg8::StaticOrder, GEMM_ALIGN, GEMM_SP2>(lds, g, S, E, tid);
        } break;
        case 2: case 12: case 9: {
            const bf16* A = (p == 9) ? MIX : BIG; const bf16* Bt = (p == 2) ? Wd1 : (p == 12) ? Wd2 : Wout; const int K = (p == 9) ? DM : DFF;
            pg8::Gemm g{A, Bt, M, DM, K}; pg8::StaticOrder S; S.init(M, DM, G, bx);
            pg8::EpiResidual E{XN, SSQ + (size_t)(layer * 3 + (p == 2 ? 1 : p == 9 ? 2 : 3)) * M * 32, DM, (p == 9) ? 1.0f : 0.5f};
            pg8::gemm_phase<pg8::EpiResidual, pg8::StaticOrder, GEMM_ALIGN, GEMM_SP2>(lds, g, S, E, tid);
        } break;
        case 4: {
            pg8::Gemm g{XN, Win, M, INW, DM}; pg8::StaticOrder S; S.init(M, INW, G, bx);
            const float* sq = SSQ + (size_t)(layer * 3 + 1) * M * 32; pg8::Unit u0; S.next(0, u0); rstd_table(RTAB, sq, u0.pm, 1.0f / DM, NORM_EPS, tid);
            pg8::EpiProj E{BIG, INW, sq, 1.0f / DM, NORM_EPS, AW, attn_body::C2, RTAB, u0.pm};
            pg8::gemm_phase<pg8::EpiProj, pg8::StaticOrder, GEMM_ALIGN, GEMM_SP2>(lds, g, S, E, tid);
        } break;
        case 5: {
            for (int i = vcu; i < 256; i += G) {
                const int gsel = i >> 3, s = i & 7; const int b = gsel >> 4, hc = gsel & 15, h = hc >> 1;
                for (int qi = 0; qi < 4; ++qi) { const int qb = (qi == 0) ? s : (qi == 1) ? 15 - s : (qi == 2) ? 16 + s : 31 - s;
                    attn_body::attn_unit<8>(b, C_QA + hc * 64, C_KA + hc * 64, C_VA + h * 128, hc * 128, qb, (const attn_body::bf16*)BIG, (attn_body::bf16*)ATTO, (char*)lds_raw, tid); }
            }
            {   int tid2 = tid; asm volatile("" : "+v"(tid2));
#define tid tid2
                int vcu5 = vcu; asm volatile("" : "+s"(vcu5));
                for (int sgm = vcu5; sgm < 256; sgm += G) {
                    f32x4 RS[8]; float cumlog = 0.f;
#pragma unroll
                    for (int xb = 0; xb < 8; ++xb) RS[xb] = (f32x4){0.f, 0.f, 0.f, 0.f};
                    HgRaw cur, nxt; hg_load<1>(cur, sgm * 8, BIG, tid);
                    for (int j = 0; j < 8; ++j) { const int u = sgm * 8 + j; hg_load<1>(nxt, j < 7 ? u + 1 : u, BIG, tid);
                        hgrn_chunk_unit<1>(cur, u, BIG, RS, cumlog, FSEG, DSEG, DEC, ST, GSEG, REC, args.in[12], layer, lds, tid); cur = nxt; } } }
#undef tid
        } break;
        case 6: {
#if HGRN_NAIVE
            for (int item = bx; item < 16; item += G) hgrn_naive_item(item, BIG, REC, args.in[12], layer, lds, tid);
#else
            hgrn_scan(bx * NTHREADS + tid, G * NTHREADS, FSEG, DSEG, GSEG);
#endif
        } break;
        case 7: {
#if !HGRN_NAIVE
            {
                PHASE_IDS
                const float sa = wave_sum(args.in[7][layer * 64 + lane] * args.in[8][layer * 64 + lane], lane), sb = wave_sum(args.in[9][layer * 64 + lane] * args.in[10][layer * 64 + lane], lane);
                const float li = lambda_init_of(layer), lam = __expf(sa) - __expf(sb) + li;
                for (int bc = vcu; bc < 256; bc += G) { const int b = bc >> 7, c = bc & 127;
                    HgRaw cur, nxt; hg_load<3>(cur, (b * 8) * 128 + c, BIG, tid);
                    for (int h = 0; h < 8; ++h) { const int u = (b * 8 + h) * 128 + c; hg_load<3>(nxt, h < 7 ? u + 128 : u, BIG, tid);
                        { f32x4 RSd[8]; float cld = 0.f; hgrn_chunk_unit<3>(cur, u, BIG, RSd, cld, FSEG, DSEG, DEC, ST, GSEG, REC, args.in[12], layer, lds, tid); } cur = nxt; }
                    asm volatile("s_waitcnt vmcnt(0)" ::: "memory"); __syncthreads();
                    const int row0 = b * SEQ + c * 64 + wave * 8;
                    for (int i = 0; i < 8; ++i) postmix_row(row0 + i, lam, 1.0f - li, ATTO, REC, BIG, args.in[11] + layer * 128, args.in[13] + (size_t)layer * HW, MIX, lane);
                }
            }
#endif
        } break;
        default: {
            PHASE_IDS
            for (int m = gw; m < M; m += NGW) rms_row_bf16_to_f32(XN, m, xres + (size_t)m * DM, args.in[19], lane);
        } break;
        }
        if (ph + 1 < args.ph_hi) {
            if (ph == args.ph_lo) { grid.sync(); xbar = xcd_barrier_post(barw, bst, tid); }
            else xcd_barrier(xbar, tid);
        }
#ifdef PROBE_MASK
        if (p < 32 && ((PROBE_MASK >> p) & 1) && !probe_rep && ph != args.ph_lo) { probe_rep = 1; --ph; } else probe_rep = 0;
#endif
    }
}

#ifndef HGRN_NAIVE
#define HGRN_NAIVE 0
#endif
#ifndef N_LAUNCH_MODE
#define N_LAUNCH_MODE 1
#endif
extern "C" void kernel_launch(void* const* d_in, const int* in_sizes, int n_in, void* d_out, int out_size, void* d_ws, size_t ws_size, hipStream_t stream) {
    static int grid = 0;
    if (grid == 0) {
        if (n_in != 20 || out_size != M * DM || ws_size < WS_END) { fprintf(stderr, "kernel_launch: unexpected shapes (n_in %d out %d ws %zu need %zu)\n", n_in, out_size, ws_size, (size_t)WS_END); grid = -1; return; }
        int dev = 0, cus = 0, per_cu = 0;
        (void)hipGetDevice(&dev); (void)hipDeviceGetAttribute(&cus, hipDeviceAttributeMultiprocessorCount, dev);
        if (hipFuncSetAttribute((const void*)hymba_fwd, hipFuncAttributeMaxDynamicSharedMemorySize, LDS_BYTES) != hipSuccess) { fprintf(stderr, "kernel_launch: hipFuncSetAttribute failed\n"); grid = -1; return; }
        if (hipOccupancyMaxActiveBlocksPerMultiprocessor(&per_cu, (const void*)hymba_fwd, NTHREADS, LDS_BYTES) != hipSuccess || per_cu < 1) { fprintf(stderr, "kernel_launch: occupancy query says %d\n", per_cu); per_cu = 1; }
        (void)hipGetLastError();
        grid = cus;
    }
    if (grid < 0) return;
    Args a{};
    for (int i = 0; i < 20; ++i) a.in[i] = (const float*)d_in[i];
    a.out = (float*)d_out; a.ws = (unsigned char*)d_ws;
#if N_LAUNCH_MODE == 1
    a.ph_lo = 0; a.ph_hi = N_PHASES;
    { void* kargs[] = {&a}; hipError_t e = hipLaunchCooperativeKernel((const void*)hymba_fwd, dim3(grid), dim3(NTHREADS), kargs, LDS_BYTES, stream);
      if (e != hipSuccess) fprintf(stderr, "cooperative launch failed: %s (grid %d)\n", hipGetErrorString(e), grid); }
#else
    for (int ph = 0; ph < N_PHASES; ++ph) { if (ph % PH_PER_LAYER == 7) continue; a.ph_lo = ph; a.ph_hi = ph + 1;
        void* kargs[] = {&a}; hipError_t e = hipLaunchCooperativeKernel((const void*)hymba_fwd, dim3(grid), dim3(NTHREADS), kargs, LDS_BYTES, stream);
        if (e != hipSuccess) { fprintf(stderr, "cooperative launch %d failed: %s (grid %d)\n", ph, hipGetErrorString(e), grid); break; } }
#endif
}
```

```cpp
#include <hip/hip_runtime.h>
#include <hip/hip_bf16.h>
#include <hip/hip_cooperative_groups.h>
#include <cstdio>
#include <cstdint>
#include <cmath>
namespace cg = cooperative_groups;
namespace pg8 {
#define PG8_LAS __attribute__((address_space(3)))
typedef unsigned short bf16_t;
typedef short bf16x8 __attribute__((ext_vector_type(8)));
typedef float f32x4 __attribute__((ext_vector_type(4)));
typedef unsigned u32x4 __attribute__((ext_vector_type(4)));
constexpr int BM = 256, BK = 64, HALF = 128, HTB = HALF * BK * 2  , STAGE_BYTES = 8 * HTB, NXCD = 8, WGM = 8;

__host__ __device__ __forceinline__ int lds_byte(int r, int c) { const int st = (r >> 4) * 2 + (c >> 5), rr = r & 15, cc = c & 31, ob = rr * 64 + cc * 2; return st * 1024 + (ob ^ (((ob >> 9) & 1) << 5)); }
__host__ __device__ __forceinline__ void stage_rc(int b, int& R, int& C) { const int st = b / 1024, sb = b % 1024, swz = sb ^ (((sb >> 9) & 1) << 5); R = (st >> 1) * 16 + swz / 64; C = (st & 1) * 32 + (swz % 64) / 2; }
__host__ __device__ __forceinline__ int perm32(int rho) { const int n = rho >> 4, i = rho & 15; return 8 * (i >> 2) + 4 * n + (i & 3); }

struct Unit { int pm, pn; };
__host__ __device__ __forceinline__ size_t toff(int m, int k, int nt) { return ((size_t)((m >> 8) * nt + (k >> 6)) * 256 + (m & 255)) * 64 + (k & 63); }
struct Gemm { const bf16_t* A; const bf16_t* Bt; int M, N, K; };

struct StaticOrder {
    int nM, nN, nwg, G, c;
    __host__ __device__ void init(int M, int N, int G_, int c_) { nM = M / BM; nN = N / BM; nwg = nM * nN; G = G_; c = c_; }
    __host__ __device__ bool next(int i, Unit& u) const {
        const long L = (long)i * G + c; if (L >= nwg) return false;
        int wgid = (int)L; { const int q = nwg / NXCD, r = nwg % NXCD, xcd = wgid % NXCD, off = wgid / NXCD; wgid = (xcd < r ? xcd * (q + 1) : r * (q + 1) + (xcd - r) * q) + off; }
        const int nig = WGM * nN, gid = wgid / nig, fm = gid * WGM, gsz = (nM - fm) < WGM ? (nM - fm) : WGM;
        u.pm = fm + ((wgid % nig) % gsz); u.pn = (wgid % nig) / gsz; return true;
    }
    __device__ __forceinline__ void a_ready(const Unit&) const {}
    __device__ __forceinline__ void done(const Unit&) const {}
};

__device__ __forceinline__ unsigned cvt_pk_bf16(float lo, float hi) { unsigned r; asm volatile("v_cvt_pk_bf16_f32 %0, %1, %2" : "=v"(r) : "v"(lo), "v"(hi)); return r; }
typedef float f32x2 __attribute__((ext_vector_type(2)));
__device__ __forceinline__ f32x2 gelu_pk(f32x2 v) {
    const f32x2 av = __builtin_elementwise_abs(v), d = av * 0.2316418882f + 1.0f;
    f32x2 t; t.x = __builtin_amdgcn_rcpf(d.x); t.y = __builtin_amdgcn_rcpf(d.y);
    f32x2 q = t * 0.5307027145f + (-0.7265760135f); q = q * t + 0.7107068705f; q = q * t + (-0.142248368f); q = q * t + 0.127414796f; q = q * t;
    const f32x2 s = (v * v) * (-0.72134752044f);
    f32x2 e; e.x = __builtin_amdgcn_exp2f(s.x); e.y = __builtin_amdgcn_exp2f(s.y);
    const f32x2 m = v * (q * e), r = v - m;
    f32x2 o; o.x = v.x < 0.f ? m.x : r.x; o.y = v.y < 0.f ? m.y : r.y; return o;
}

template <int ACT  > struct EpiBf16 {
    static constexpr bool PERM = true, AFTER_DRAIN = false; static_assert(ACT == 0 || ACT == 1, "EpiBf16: ACT is 0 (none) or 1 (gelu_pk)");
    bf16_t* O; int ldc; const float* bias; int split_cols; size_t split_stride; float scale0;
    __device__ __forceinline__ void operator()(const f32x4 (&acc)[2][2][4][2], const Unit& u, int wr, int wc, int fr, int fq) const {
        const int row0 = u.pm * BM + wr * 64 + fr; int colt = u.pn * BM; bf16_t* base = O;
        float sc = 1.f; if (split_cols) { const int t = colt / split_cols; base += (size_t)t * split_stride; colt -= t * split_cols; if (t == 0) sc = scale0; }
        const int col0 = colt + wc * 32 + 8 * fq, bcol0 = u.pn * BM + wc * 32 + 8 * fq;
        f32x4 bv[2][2];
#pragma unroll
        for (int bj = 0; bj < 2; ++bj)
#pragma unroll
            for (int n = 0; n < 2; ++n) bv[bj][n] = bias ? *(const f32x4*)(bias + bcol0 + bj * HALF + 4 * n) : (f32x4){0.f, 0.f, 0.f, 0.f};
#pragma unroll
        for (int ai = 0; ai < 2; ++ai)
#pragma unroll
            for (int m = 0; m < 4; ++m) { bf16_t* rowp = base + (size_t)(row0 + ai * HALF + m * 16) * ldc + col0;
#pragma unroll
                for (int bj = 0; bj < 2; ++bj) { f32x4 v0 = acc[ai][bj][m][0] + bv[bj][0], v1 = acc[ai][bj][m][1] + bv[bj][1];
                    if (ACT == 1) { f32x2 a = gelu_pk((f32x2){v0[0], v0[1]}), b = gelu_pk((f32x2){v0[2], v0[3]}), c = gelu_pk((f32x2){v1[0], v1[1]}), d = gelu_pk((f32x2){v1[2], v1[3]});
                        v0 = (f32x4){a.x, a.y, b.x, b.y}; v1 = (f32x4){c.x, c.y, d.x, d.y}; }
                    v0 = v0 * sc; v1 = v1 * sc; u32x4 w; w.x = cvt_pk_bf16(v0[0], v0[1]); w.y = cvt_pk_bf16(v0[2], v0[3]); w.z = cvt_pk_bf16(v1[0], v1[1]); w.w = cvt_pk_bf16(v1[2], v1[3]);
                    *(u32x4*)(rowp + bj * HALF) = w; } }
    }
};
__device__ __forceinline__ float shx(float v, int lane, int m) { return __builtin_bit_cast(float, __builtin_amdgcn_ds_bpermute((lane ^ m) << 2, __builtin_bit_cast(int, v))); }
__device__ __forceinline__ void row_rstd(float (&rs)[2][4], const float* ssq, int row0, int fq, float inv_n, float eps, const PG8_LAS float* tab, int tab_pm, int pm) {
    const int lane = (row0 & 15) + 16 * fq;
    if (pm == tab_pm) {
#pragma unroll
        for (int ai = 0; ai < 2; ++ai)
#pragma unroll
            for (int m = 0; m < 4; ++m) rs[ai][m] = tab[(row0 & 255) + ai * HALF + m * 16];
        return;
    }
#pragma unroll
    for (int ai = 0; ai < 2; ++ai)
#pragma unroll
        for (int m = 0; m < 4; ++m) { const f32x4* p = (const f32x4*)(ssq + (size_t)(row0 + ai * HALF + m * 16) * 32 + fq * 8); const f32x4 a = p[0], b = p[1];
            float s = ((a[0] + a[1]) + (a[2] + a[3])) + ((b[0] + b[1]) + (b[2] + b[3])); s += shx(s, lane, 16); s += shx(s, lane, 32);
            rs[ai][m] = __builtin_amdgcn_rsqf(s * inv_n + eps); }
}
struct EpiSwiGLU {
    static constexpr bool PERM = true, AFTER_DRAIN = false;
    bf16_t* O; int ldc; const float* ssq; float inv_n, eps; const PG8_LAS float* tab; int tab_pm;
    __device__ __forceinline__ void operator()(const f32x4 (&acc)[2][2][4][2], const Unit& u, int wr, int wc, int fr, int fq) const {
        const int row0 = u.pm * BM + wr * 64 + fr; const int col0 = u.pn * HALF + wc * 32 + 8 * fq;
        float rs[2][4]; row_rstd(rs, ssq, row0, fq, inv_n, eps, tab, tab_pm, u.pm);
#pragma unroll
        for (int ai = 0; ai < 2; ++ai)
#pragma unroll
            for (int m = 0; m < 4; ++m) { bf16_t* rowp = O + toff(row0 + ai * HALF + m * 16, col0, ldc >> 6);
                const float r = rs[ai][m]; const f32x2 c1 = {-1.4426950408889634f * r, -1.4426950408889634f * r}, r2 = {r * r, r * r};
                unsigned wv[4];
#pragma unroll
                for (int n = 0; n < 2; ++n)
#pragma unroll
                    for (int e = 0; e < 4; e += 2) { const f32x2 g = {acc[ai][0][m][n][e], acc[ai][0][m][n][e + 1]}, up = {acc[ai][1][m][n][e], acc[ai][1][m][n][e + 1]};
                        const f32x2 t = g * c1; f32x2 d; d.x = __builtin_amdgcn_exp2f(t.x); d.y = __builtin_amdgcn_exp2f(t.y); d = d + 1.0f;
                        f32x2 rc; rc.x = __builtin_amdgcn_rcpf(d.x); rc.y = __builtin_amdgcn_rcpf(d.y);
                        const f32x2 hv = ((g * up) * r2) * rc; wv[n * 2 + (e >> 1)] = cvt_pk_bf16(hv.x, hv.y); }
                u32x4 w; w.x = wv[0]; w.y = wv[1]; w.z = wv[2]; w.w = wv[3];
                *(u32x4*)rowp = w; }
    }
};
struct EpiProj {
    static constexpr bool PERM = true, AFTER_DRAIN = false;
    bf16_t* O; int ldc; const float* ssq; float inv_n, eps; int qcols; float qscale; const PG8_LAS float* tab; int tab_pm;
    __device__ __forceinline__ void operator()(const f32x4 (&acc)[2][2][4][2], const Unit& u, int wr, int wc, int fr, int fq) const {
        const int row0 = u.pm * BM + wr * 64 + fr; const int col0 = u.pn * BM + wc * 32 + 8 * fq;
        float rs[2][4]; row_rstd(rs, ssq, row0, fq, inv_n, eps, tab, tab_pm, u.pm);
        const float cs = (u.pn * BM < qcols) ? qscale : 1.0f;
#pragma unroll
        for (int ai = 0; ai < 2; ++ai)
#pragma unroll
            for (int m = 0; m < 4; ++m) { bf16_t* rowp = O + (size_t)(row0 + ai * HALF + m * 16) * ldc + col0; const float r = rs[ai][m] * cs;
#pragma unroll
                for (int bj = 0; bj < 2; ++bj) { const f32x4 v0 = acc[ai][bj][m][0] * r, v1 = acc[ai][bj][m][1] * r;
                    u32x4 w; w.x = cvt_pk_bf16(v0[0], v0[1]); w.y = cvt_pk_bf16(v0[2], v0[3]); w.z = cvt_pk_bf16(v1[0], v1[1]); w.w = cvt_pk_bf16(v1[2], v1[3]);
                    *(u32x4*)(rowp + bj * HALF) = w; } }
    }
};
struct EpiResidual {
    static constexpr bool PERM = true, AFTER_DRAIN = false;
    bf16_t* xb; float* ssq; int ldc; float alpha;
    __device__ __forceinline__ void operator()(const f32x4 (&acc)[2][2][4][2], const Unit& u, int wr, int wc, int fr, int fq) const {
        const int row0 = u.pm * BM + wr * 64 + fr; const int col0 = u.pn * BM + wc * 32 + 8 * fq;
#pragma unroll
        for (int ai = 0; ai < 2; ++ai) {
            u32x4 bs[4][2];
#pragma unroll
            for (int m = 0; m < 4; ++m) {
#pragma unroll
                for (int bj = 0; bj < 2; ++bj) bs[m][bj] = *(const u32x4*)(xb + toff(row0 + ai * HALF + m * 16, col0 + bj * HALF, ldc >> 6)); }
            asm volatile("" ::: "memory");
#pragma unroll
            for (int m = 0; m < 4; ++m) { const int row = row0 + ai * HALF + m * 16; float ss = 0.f;
#pragma unroll
                for (int bj = 0; bj < 2; ++bj) { const u32x4 b = bs[m][bj];
                    const f32x4 b0 = {__builtin_bit_cast(float, b.x << 16), __builtin_bit_cast(float, b.x & 0xffff0000u), __builtin_bit_cast(float, b.y << 16), __builtin_bit_cast(float, b.y & 0xffff0000u)};
                    const f32x4 b1 = {__builtin_bit_cast(float, b.z << 16), __builtin_bit_cast(float, b.z & 0xffff0000u), __builtin_bit_cast(float, b.w << 16), __builtin_bit_cast(float, b.w & 0xffff0000u)};
                    const f32x4 o0 = b0 + acc[ai][bj][m][0] * alpha, o1 = b1 + acc[ai][bj][m][1] * alpha;
                    ss += (o0[0] * o0[0] + o0[1] * o0[1]) + (o0[2] * o0[2] + o0[3] * o0[3]) + (o1[0] * o1[0] + o1[1] * o1[1]) + (o1[2] * o1[2] + o1[3] * o1[3]);
                    u32x4 w; w.x = cvt_pk_bf16(o0[0], o0[1]); w.y = cvt_pk_bf16(o0[2], o0[3]); w.z = cvt_pk_bf16(o1[0], o1[1]); w.w = cvt_pk_bf16(o1[2], o1[3]);
                    *(u32x4*)(xb + toff(row, col0 + bj * HALF, ldc >> 6)) = w; }
                ss += shx(ss, fr + 16 * fq, 16); ss += shx(ss, fr + 16 * fq, 32);
                if (fq == 0) ssq[(size_t)row * 32 + u.pn * 4 + wc] = ss; }
            asm volatile("" ::: "memory");
        }
    }
};

template <class Epi, class Sched, bool ALIGN_EPI = false, bool SP2 = false>
__device__ __forceinline__ void gemm_phase(PG8_LAS unsigned char* lds, const Gemm g, const Sched& S, const Epi& E) {
    int tid_o = threadIdx.x; asm volatile("" : "+v"(tid_o));
    const int tid = tid_o, wid = __builtin_amdgcn_readfirstlane(tid >> 6), lane = tid & 63, wr = wid >> 2, wc = wid & 3, fr = lane & 15, fq = lane >> 4;
    const int K = g.K, nt = K / BK;
    unsigned voffA[2], voffB[2];
#pragma unroll
    for (int i = 0; i < 2; ++i) { int R, C; stage_rc(tid * 16 + i * 8192, R, C); const int Rb = Epi::PERM ? ((R & ~31) + perm32(R & 31)) : R;
        voffA[i] = (unsigned)(R * BK + C) * 2u; voffB[i] = (unsigned)(Rb * BK + C) * 2u; }
    const size_t kstep = (size_t)(BK * 2), kstepB = (size_t)BM * BK * 2;
    const size_t hstep = (size_t)HALF * K * 2, hstepB = (size_t)HALF * BK * 2;
    const size_t tstep = 2 * hstep;
    const unsigned ldsw = (unsigned)wid * 1024u;
    const int aoff = lds_byte(wr * 64 + fr, fq * 8), boff = lds_byte(wc * 32 + fr, fq * 8);
#define PG8_SA(b, h) (((b) * 2 + (h)) * HTB)
#define PG8_SB(b, h) ((4 + (b) * 2 + (h)) * HTB)
#define PG8_STAGE(bufoff, gbase, voff) do { _Pragma("unroll") for (int _i = 0; _i < 2; ++_i) \
        __builtin_amdgcn_global_load_lds((const unsigned*)((const char*)(gbase) + (voff)[_i]), (PG8_LAS unsigned*)(lds + (bufoff) + ldsw + _i * 8192), 16, 0, 0); } while (0)
#define PG8_LDA(dst, b, h) do { _Pragma("unroll") for (int m = 0; m < 4; ++m) _Pragma("unroll") for (int k = 0; k < 2; ++k) dst[m][k] = *(const PG8_LAS bf16x8*)(lds + PG8_SA(b, h) + aoff + m * 2048 + k * 1024); } while (0)
#define PG8_LDB(dst, b, h) do { _Pragma("unroll") for (int n = 0; n < 2; ++n) _Pragma("unroll") for (int k = 0; k < 2; ++k) dst[n][k] = *(const PG8_LAS bf16x8*)(lds + PG8_SB(b, h) + boff + n * 2048 + k * 1024); } while (0)
#define PG8_MMA(ai, bj, At, Bt) do { __builtin_amdgcn_s_setprio(1); _Pragma("unroll") for (int m = 0; m < 4; ++m) _Pragma("unroll") for (int n = 0; n < 2; ++n) _Pragma("unroll") for (int k = 0; k < 2; ++k) \
        acc[ai][bj][m][n] = __builtin_amdgcn_mfma_f32_16x16x32_bf16(Bt[n][k], At[m][k], acc[ai][bj][m][n], 0, 0, 0); __builtin_amdgcn_s_setprio(0); } while (0)
#define PG8_WAIT_V(n) asm volatile("s_waitcnt vmcnt(" #n ")" ::: "memory")
#define PG8_WAIT_L(n) asm volatile("s_waitcnt lgkmcnt(" #n ")" ::: "memory")
#define PG8_BAR __builtin_amdgcn_s_barrier()
#define PG8_SCHED __builtin_amdgcn_sched_barrier(0)
    Unit cur, nxt; int ui = 0;
    if (!S.next(0, cur)) return;
    f32x4 acc[2][2][4][2];
#pragma unroll
    for (int a = 0; a < 2; ++a)
#pragma unroll
        for (int b = 0; b < 2; ++b)
#pragma unroll
            for (int m = 0; m < 4; ++m)
#pragma unroll
                for (int n = 0; n < 2; ++n) acc[a][b][m][n] = (f32x4){0.f, 0.f, 0.f, 0.f};
    bf16x8 At[4][2], B0[2][2], B1[2][2];
    const char* cA = (const char*)g.A + (size_t)cur.pm * tstep; const char* cB = (const char*)g.Bt + (size_t)cur.pn * tstep;
    S.a_ready(cur);
    if constexpr (SP2) {
        PG8_STAGE(PG8_SB(0, 0), cB, voffB); PG8_STAGE(PG8_SB(0, 1), cB + hstepB, voffB); PG8_STAGE(PG8_SA(0, 0), cA, voffA); PG8_STAGE(PG8_SA(0, 1), cA + hstepB, voffA);
        if (wr == 1) PG8_BAR;
        PG8_WAIT_V(2); PG8_BAR;
        PG8_STAGE(PG8_SB(1, 0), cB + kstepB, voffB); PG8_STAGE(PG8_SA(1, 0), cA + kstepB, voffA); PG8_STAGE(PG8_SB(1, 1), cB + hstepB + kstepB, voffB);
        PG8_WAIT_V(6); PG8_BAR;
    } else {
        PG8_STAGE(PG8_SB(0, 0), cB, voffB); PG8_STAGE(PG8_SA(0, 0), cA, voffA); PG8_STAGE(PG8_SB(0, 1), cB + hstepB, voffB); PG8_STAGE(PG8_SA(0, 1), cA + hstepB, voffA);
        if (wr == 1) PG8_BAR;
        PG8_WAIT_V(4); PG8_BAR;
        PG8_STAGE(PG8_SB(1, 0), cB + kstepB, voffB); PG8_STAGE(PG8_SA(1, 0), cA + kstepB, voffA); PG8_STAGE(PG8_SB(1, 1), cB + hstepB + kstepB, voffB);
        PG8_WAIT_V(6); PG8_BAR;
    }
    for (;;) {
        const bool has_next = S.next(ui + 1, nxt);
        const char* nA = has_next ? (const char*)g.A + (size_t)nxt.pm * tstep : cA; const char* nB = has_next ? (const char*)g.Bt + (size_t)nxt.pn * tstep : cB;
        for (int t = 0; t < nt; t += 2) {
            const bool last = (t == nt - 2);
            const char* a1 = cA + (size_t)(t + 1) * kstepB;
            const char* a2 = last ? nA : cA + (size_t)(t + 2) * kstepB; const char* b2 = last ? nB : cB + (size_t)(t + 2) * kstepB;
            const char* a3 = a2 + kstepB; const char* b3 = b2 + kstepB;
            if (last && has_next) S.a_ready(nxt);
            if constexpr (SP2) {
            PG8_LDB(B0, 0, 0); PG8_LDB(B1, 0, 1); PG8_SCHED; PG8_LDA(At, 0, 0); PG8_STAGE(PG8_SA(1, 1), a1 + hstepB, voffA);
            PG8_WAIT_V(8); PG8_WAIT_L(0); PG8_BAR; PG8_MMA(0, 0, At, B0); PG8_MMA(0, 1, At, B1); PG8_BAR; PG8_SCHED;
            PG8_LDA(At, 0, 1); PG8_STAGE(PG8_SB(0, 0), b2, voffB); PG8_STAGE(PG8_SB(0, 1), b2 + hstepB, voffB); PG8_STAGE(PG8_SA(0, 0), a2, voffA);
            PG8_WAIT_V(8); PG8_WAIT_L(0); PG8_BAR; PG8_MMA(1, 0, At, B0); PG8_MMA(1, 1, At, B1); PG8_BAR; PG8_SCHED;
            PG8_LDB(B0, 1, 0); PG8_LDB(B1, 1, 1); PG8_SCHED; PG8_LDA(At, 1, 0); PG8_STAGE(PG8_SA(0, 1), a2 + hstepB, voffA);
            PG8_WAIT_V(8); PG8_WAIT_L(0); PG8_BAR; PG8_MMA(0, 0, At, B0); PG8_MMA(0, 1, At, B1); PG8_BAR; PG8_SCHED;
            PG8_LDA(At, 1, 1); PG8_STAGE(PG8_SB(1, 0), b3, voffB); PG8_STAGE(PG8_SB(1, 1), b3 + hstepB, voffB); PG8_STAGE(PG8_SA(1, 0), a3, voffA);
            PG8_WAIT_V(8); PG8_WAIT_L(0); PG8_BAR; PG8_MMA(1, 0, At, B0); PG8_MMA(1, 1, At, B1); PG8_BAR; PG8_SCHED;
            } else {
            PG8_LDB(B0, 0, 0); PG8_SCHED; PG8_LDA(At, 0, 0); PG8_STAGE(PG8_SA(1, 1), a1 + hstepB, voffA);
            PG8_WAIT_L(8); PG8_BAR; PG8_WAIT_L(0); PG8_MMA(0, 0, At, B0); PG8_BAR; PG8_SCHED;
            PG8_LDB(B1, 0, 1); PG8_STAGE(PG8_SB(0, 0), b2, voffB);
            PG8_BAR; PG8_WAIT_L(0); PG8_MMA(0, 1, At, B1); PG8_BAR;
            PG8_LDA(At, 0, 1); PG8_STAGE(PG8_SA(0, 0), a2, voffA);
            PG8_BAR; PG8_WAIT_L(0); PG8_MMA(1, 0, At, B0); PG8_BAR; PG8_SCHED;
            PG8_STAGE(PG8_SB(0, 1), b2 + hstepB, voffB);
            PG8_WAIT_V(6); PG8_BAR; PG8_MMA(1, 1, At, B1); PG8_BAR;
            PG8_LDB(B0, 1, 0); PG8_SCHED; PG8_LDA(At, 1, 0); PG8_STAGE(PG8_SA(0, 1), a2 + hstepB, voffA);
            PG8_WAIT_L(8); PG8_BAR; PG8_WAIT_L(0); PG8_MMA(0, 0, At, B0); PG8_BAR; PG8_SCHED;
            PG8_LDB(B1, 1, 1); PG8_STAGE(PG8_SB(1, 0), b3, voffB);
            PG8_BAR; PG8_WAIT_L(0); PG8_MMA(0, 1, At, B1); PG8_BAR;
            PG8_LDA(At, 1, 1); PG8_STAGE(PG8_SA(1, 0), a3, voffA);
            PG8_BAR; PG8_WAIT_L(0); PG8_MMA(1, 0, At, B0); PG8_BAR; PG8_SCHED;
            PG8_STAGE(PG8_SB(1, 1), b3 + hstepB, voffB);
            PG8_WAIT_V(6); PG8_BAR; PG8_MMA(1, 1, At, B1); PG8_BAR;
            }
        }
        if constexpr (ALIGN_EPI) { if (wr == 0) PG8_BAR; }
        if constexpr (!Epi::AFTER_DRAIN) { E(acc, cur, wr, wc, fr, fq); S.done(cur); }
        if (!has_next) break;
#pragma unroll
        for (int a = 0; a < 2; ++a)
#pragma unroll
            for (int b = 0; b < 2; ++b)
#pragma unroll
                for (int m = 0; m < 4; ++m)
#pragma unroll
                    for (int n = 0; n < 2; ++n) acc[a][b][m][n] = (f32x4){0.f, 0.f, 0.f, 0.f};
        cur = nxt; cA = nA; cB = nB; ++ui;
        if constexpr (ALIGN_EPI) { if (wr == 1) PG8_BAR; }
    }
    PG8_WAIT_V(0);
    if constexpr (!ALIGN_EPI) { if (wr == 0) PG8_BAR; }
    PG8_BAR;
    if constexpr (Epi::AFTER_DRAIN) { E.fused(acc, cur, wr, wc, fr, fq, lds, wid, lane); S.done(cur); }
#undef PG8_SA
#undef PG8_SB
#undef PG8_STAGE
#undef PG8_LDA
#undef PG8_LDB
#undef PG8_MMA
#undef PG8_WAIT_V
#undef PG8_WAIT_L
#undef PG8_BAR
#undef PG8_SCHED
}
}
namespace attn_body {
using bf16=__hip_bfloat16;
using bf16x8=__attribute__((ext_vector_type(8)))short;
using s16x4=__attribute__((ext_vector_type(4)))short;
using f32x16=__attribute__((ext_vector_type(16)))float;
using u32x4=__attribute__((ext_vector_type(4)))unsigned;
constexpr int BATCH=2,SEQ=8192,D=64,PIN=7168,POUT=2048;
constexpr int NW=8,QBLK=32,QB=QBLK*NW,KVBLK=64,NQB=SEQ/QB;
constexpr int ATTN_UNIT_ROWS=QB;
__device__ __forceinline__ int crow(int r,int hi){return (r&3)+8*(r>>2)+4*hi;}
#define SBAR() __builtin_amdgcn_sched_barrier(0)
__device__ __forceinline__ void cmask(f32x16&p0,f32x16&p1,int jb,int qrel,int hi){
  const float NEG=-INFINITY; int kb=64*jb+4*hi;
  #pragma unroll
  for(int r=0;r<16;++r){int kv=kb+(r&3)+8*(r>>2); if(kv>qrel)p0[r]=NEG; if(kv+32>qrel)p1[r]=NEG;}
}

constexpr int NSLOT=3, SLOTB=8192;
constexpr int VSLOTB=2*SLOTB;
constexpr int LDS_K=0, LDS_V=NSLOT*SLOTB, LDS_WS=LDS_V+NSLOT*VSLOTB, LDS_OST=LDS_WS+NW*64*4, LDS_BYTES=LDS_OST+NW*4096;
constexpr float C2=0.125f*1.4426950408889634f;
__device__ __forceinline__ void glds16(const void*gsrc,unsigned lds_dst){unsigned keep;
  asm volatile("s_mov_b32 %0, m0\n\ts_mov_b32 m0, %2\n\ts_nop 0\n\tglobal_load_lds_dwordx4 %1, off\n\ts_mov_b32 m0, %0":"=&s"(keep):"v"(gsrc),"s"(lds_dst):"memory");}
__device__ __forceinline__ float max3f(float a,float b,float c){float r;asm("v_max3_f32 %0, %1, %2, %3":"=v"(r):"v"(a),"v"(b),"v"(c));return r;}
__device__ __forceinline__ float max2f(float a,float b){float r;asm("v_max_f32_e32 %0, %1, %2":"=v"(r):"v"(a),"v"(b));return r;}
__device__ __forceinline__ float fadd_s(float a,float b){float r;asm("v_add_f32_e32 %0, %1, %2":"=v"(r):"v"(a),"v"(b));return r;}
__device__ __forceinline__ float fsub_s(float a,float b){float r;asm("v_sub_f32_e32 %0, %1, %2":"=v"(r):"v"(a),"v"(b));return r;}
typedef float f32x2_t __attribute__((ext_vector_type(2))); typedef __bf16 bf16x2_t __attribute__((ext_vector_type(2)));
__device__ __forceinline__ unsigned cvtpk_s(float lo,float hi){f32x2_t v={lo,hi};bf16x2_t b=__builtin_convertvector(v,bf16x2_t);return __builtin_bit_cast(unsigned,b);}
#define WAIT_BAR(N) asm volatile("s_waitcnt vmcnt(" #N ") lgkmcnt(0)\n\ts_barrier":::"memory")

__device__ __forceinline__ void qkt(f32x16&p0,f32x16&p1,const char*Kslot,const bf16x8*qr,const f32x16&negm,int r32,int hi){
  const char*kb=Kslot+hi*1024+r32*16;
  #pragma unroll
  for(int d0=0;d0<4;++d0){
    const bf16x8 b0=*reinterpret_cast<const bf16x8*>(kb+d0*2048);
    const bf16x8 b1=*reinterpret_cast<const bf16x8*>(kb+d0*2048+512);
    if(d0==0){p0=__builtin_amdgcn_mfma_f32_32x32x16_bf16(b0,qr[0],negm,0,0,0);p1=__builtin_amdgcn_mfma_f32_32x32x16_bf16(b1,qr[0],negm,0,0,0);}
    else{p0=__builtin_amdgcn_mfma_f32_32x32x16_bf16(b0,qr[d0],p0,0,0,0);p1=__builtin_amdgcn_mfma_f32_32x32x16_bf16(b1,qr[d0],p1,0,0,0);}}
}
typedef __attribute__((address_space(3))) const char* lds_cptr;
typedef short v4i16_t __attribute__((ext_vector_type(4)));
__device__ __forceinline__ void kload8(bf16x8*kf,lds_cptr kp){
  kf[0]=*(const __attribute__((address_space(3))) bf16x8*)(kp);      kf[1]=*(const __attribute__((address_space(3))) bf16x8*)(kp+512);
  kf[2]=*(const __attribute__((address_space(3))) bf16x8*)(kp+2048); kf[3]=*(const __attribute__((address_space(3))) bf16x8*)(kp+2560);
  kf[4]=*(const __attribute__((address_space(3))) bf16x8*)(kp+4096); kf[5]=*(const __attribute__((address_space(3))) bf16x8*)(kp+4608);
  kf[6]=*(const __attribute__((address_space(3))) bf16x8*)(kp+6144); kf[7]=*(const __attribute__((address_space(3))) bf16x8*)(kp+6656);
}
__device__ __forceinline__ void kload2(bf16x8*kf,lds_cptr kp,int j){ kf[2*j]=*(const __attribute__((address_space(3))) bf16x8*)(kp+j*2048); kf[2*j+1]=*(const __attribute__((address_space(3))) bf16x8*)(kp+j*2048+512); }
__device__ __forceinline__ s16x4 vtr(lds_cptr p){ return __builtin_bit_cast(s16x4,__builtin_amdgcn_ds_read_tr16_b64_v4i16((__attribute__((address_space(3))) v4i16_t*)p)); }
__device__ __forceinline__ float rowmax(const f32x16&p0,const f32x16&p1){
  float a=max3f(p0[0],p0[1],p1[0]),b=max3f(p0[2],p0[3],p1[1]);a=max3f(a,p1[2],p1[3]);
  #pragma unroll
  for(int r=4;r<16;r+=4){a=max3f(a,p0[r],p0[r+1]);b=max3f(b,p0[r+2],p0[r+3]);a=max3f(a,p1[r],p1[r+1]);b=max3f(b,p1[r+2],p1[r+3]);}
  const float m=max2f(a,b);
  auto rr=__builtin_amdgcn_permlane32_swap(__float_as_uint(m),__float_as_uint(m),false,false);
  return max2f(__uint_as_float(rr[0]),__uint_as_float(rr[1]));
}
__device__ __forceinline__ void pv(f32x16*o,int vb,bf16x8 pa0,bf16x8 pa1,bf16x8 pa2,bf16x8 pa3){
  #pragma unroll
  for(int d0=0;d0<2;++d0){s16x4 lo[4],hi[4];
    #pragma unroll
    for(int ks=0;ks<4;++ks){
      asm volatile("ds_read_b64_tr_b16 %0,%1 offset:%c2":"=&v"(lo[ks]):"v"(vb),"i"(d0*4096+ks*1024):"memory");
      asm volatile("ds_read_b64_tr_b16 %0,%1 offset:%c2":"=&v"(hi[ks]):"v"(vb),"i"(d0*4096+ks*1024+512):"memory");}
    asm volatile("s_waitcnt lgkmcnt(0)":::"memory");SBAR();
    #define PK(k) (bf16x8){lo[k][0],lo[k][1],lo[k][2],lo[k][3],hi[k][0],hi[k][1],hi[k][2],hi[k][3]}
    o[d0]=__builtin_amdgcn_mfma_f32_32x32x16_bf16(pa0,PK(0),o[d0],0,0,0);
    o[d0]=__builtin_amdgcn_mfma_f32_32x32x16_bf16(pa1,PK(1),o[d0],0,0,0);
    o[d0]=__builtin_amdgcn_mfma_f32_32x32x16_bf16(pa2,PK(2),o[d0],0,0,0);
    o[d0]=__builtin_amdgcn_mfma_f32_32x32x16_bf16(pa3,PK(3),o[d0],0,0,0);
    #undef PK
  }
}

#ifndef ATTN_STORE16
#define ATTN_STORE16(p,v) (*(u32x4*)(p)=(v))
#endif
template<int THRL> __device__ __forceinline__ void attn_unit(int b,int qcol,int kcol,int vcol,int ocol,int qb,const bf16*__restrict__ P,bf16*__restrict__ O,char*shm){
  int tid_o=threadIdx.x; asm volatile("":"+v"(tid_o)); const int tid=tid_o,lane=tid&63,r32=lane&31,hi=lane>>5; const int wid=__builtin_amdgcn_readfirstlane(tid>>6);
  const long rowbase=(long)b*SEQ; const int q0=qb*QB;
  const bf16*Qw=P+(rowbase+q0+wid*QBLK)*PIN+qcol;
  const bf16*Kh=P+rowbase*PIN+kcol,*Vh=P+rowbase*PIN+vcol;
  const unsigned lds0=(unsigned)(uintptr_t)shm;
  float*wsf=(float*)(shm+LDS_WS)+wid*64;
  const bf16*ksrc=Kh+(long)lane*PIN+wid*8;
  const bf16*vsrc=Vh+(long)(16*(wid&3)+(lane>>2))*PIN+(wid>>2)*32+(lane&3)*8;
  const unsigned kdst=lds0+LDS_K+wid*1024, vdst=lds0+LDS_V+wid*1024;
  #define DMA_K(t,slot) glds16(ksrc+(long)(t)*KVBLK*PIN,(unsigned)__builtin_amdgcn_readfirstlane(kdst+(slot)))
  #define DMA_V(t,slot) do{ glds16(vsrc+(long)(t)*KVBLK*PIN,(unsigned)__builtin_amdgcn_readfirstlane(vdst+2*(slot))); glds16(vsrc+(long)(t)*KVBLK*PIN+64,(unsigned)__builtin_amdgcn_readfirstlane(vdst+2*(slot)+SLOTB)); }while(0)
  const int vb0=(int)(lds0+LDS_V)+((lane>>4)&1)*32+(lane&3)*8+(4*hi+((lane&15)>>2))*64;
  const char*Kbase=shm+LDS_K; bf16x8 kf[8];
  const lds_cptr shm3=(lds_cptr)shm; const lds_cptr kp0=shm3+LDS_K+hi*1024+r32*16; const lds_cptr vp0=shm3+LDS_V+((lane>>4)&1)*32+(lane&3)*8+(4*hi+((lane&15)>>2))*64;
  const int NT=(q0+QB)/KVBLK;
  DMA_K(0,0);DMA_V(0,0);DMA_K(1,SLOTB);
  bf16x8 qr[4];
  #pragma unroll
  for(int d0=0;d0<4;++d0)qr[d0]=*reinterpret_cast<const bf16x8*>(&Qw[(long)r32*PIN+d0*16+hi*8]);
  float mhat=0.f,l_reg=0.f;f32x16 o[4];o[0]=f32x16{};o[1]=f32x16{};o[2]=f32x16{};o[3]=f32x16{};f32x16 negm=f32x16{};asm volatile("":"+v"(negm));
  const int qrel=wid*QBLK+r32;
  #define CMASK(P0,P1,t) do{int jb_=(t)-(NT-4); if(jb_>=0)cmask(P0,P1,jb_,qrel,hi);}while(0)
  bool resc=false;
  #define START(P0,P1) do{ const float rm=rowmax(P0,P1); resc=false; \
    { const float dl=rm; mhat=fadd_s(mhat,dl); \
      _Pragma("unroll") for(int r=0;r<16;++r){P0[r]=fsub_s(P0[r],dl);P1[r]=fsub_s(P1[r],dl);} \
      _Pragma("unroll") for(int r=0;r<16;++r)negm[r]=-mhat; asm volatile("":"+v"(negm)); } \
    _Pragma("unroll") for(int r=0;r<16;++r)P0[r]=__builtin_amdgcn_exp2f(P0[r]); }while(0)
  #define RESC() do{ if(resc){ asm volatile("s_waitcnt lgkmcnt(0)":::"memory"); \
      _Pragma("unroll") for(int d_=0;d_<4;++d_) _Pragma("unroll") for(int r=0;r<16;++r)o[d_][r]*=wsf[crow(r,hi)]; } }while(0)
  f32x16 pA0,pA1,pB0,pB1;
  int sl_prev=0,sl_cur=0,sl_next=SLOTB;
  #define ROT() do{sl_prev=sl_cur;sl_cur=sl_next;sl_next=(sl_next==(NSLOT-1)*SLOTB)?0:sl_next+SLOTB;}while(0)
  DMA_K(2,2*SLOTB);
  WAIT_BAR(4);
  qkt(pA0,pA1,Kbase,qr,negm,r32,hi);asm volatile("s_nop 15\n\ts_nop 7":"+v"(pA0),"+v"(pA1));CMASK(pA0,pA1,0);
  START(pA0,pA1);
  _Pragma("unroll") for(int r=0;r<16;++r)pA1[r]=__builtin_amdgcn_exp2f(pA1[r]);
  WAIT_BAR(0);
  DMA_K(3,0);DMA_V(1,SLOTB);
  ROT();
  kload8(kf,kp0+sl_cur);
  WAIT_BAR(3);
  s16x4 vlo[8],vhi[8]; u32x4 pw0,pw1,pw2,pw3;
  #define PKW(P,B) cvtpk_s(P[B],P[B+1])
  #define PAF(k) __builtin_bit_cast(bf16x8,pw##k)
  #define VFR(i) (bf16x8){vlo[i][0],vlo[i][1],vlo[i][2],vlo[i][3],vhi[i][0],vhi[i][1],vhi[i][2],vhi[i][3]}
  #define PIN(x) asm volatile("":"+v"(x))
  #define MX3(a,b,c) __builtin_fmaxf(__builtin_fmaxf((a),(b)),(c))
  #define GAPA(MF,A0,A1,A2,A3,W0,W1,PW) do{ MF; sacc+=A0; sacc+=A1; sacc+=A2; sacc+=A3; PIN(sacc); W0; W1; PIN(PW); SBAR(); }while(0)
  #define EX(v) __builtin_amdgcn_exp2f(v)
  #define GAPB(MF,X,B) do{ MF; X[B]=EX(X[B]); X[B+1]=EX(X[B+1]); X[B+2]=EX(X[B+2]); X[B+3]=EX(X[B+3]); PIN(X); SBAR(); }while(0)
  #define VRD(i) do{ vlo[i]=vtr(vp_+(((i)>>2)*4096+((i)&3)*1024)); vhi[i]=vtr(vp_+(((i)>>2)*4096+((i)&3)*1024+512)); }while(0)
  #define VRD2(i) do{ vlo[i]=vtr(vp_+(SLOTB+((i)>>2)*4096+((i)&3)*1024)); vhi[i]=vtr(vp_+(SLOTB+((i)>>2)*4096+((i)&3)*1024+512)); SBAR(); }while(0)
  #define GAPB2(MF,X,B) do{ MF; X[B]=EX(X[B]); X[B+1]=EX(X[B+1]); PIN(X); SBAR(); }while(0)
  #define KRD(G,j) do{ if(G){ kload2(kf,kp0+sl_next,j); SBAR(); } }while(0)
  #define STEP(C0,C1,P0,P1,t,GK,GV,GL) do{ SBAR(); \
    const lds_cptr vp_=vp0+2*sl_prev; \
    VRD(0); SBAR(); float sacc=(P0[0]+P0[1]); \
    GAPA(C0=__builtin_amdgcn_mfma_f32_32x32x16_bf16(kf[0],qr[0],negm,0,0,0), P0[2],P0[3],P0[4],P0[5],     pw0[0]=PKW(P0,0), pw0[1]=PKW(P0,2), pw0); \
    VRD(4); SBAR(); GAPA(C1=__builtin_amdgcn_mfma_f32_32x32x16_bf16(kf[1],qr[0],negm,0,0,0), P0[6],P0[7],P0[8],P0[9],     pw0[2]=PKW(P0,4), pw0[3]=PKW(P0,6), pw0); \
    VRD(1); SBAR(); GAPA(C0=__builtin_amdgcn_mfma_f32_32x32x16_bf16(kf[2],qr[1],C0,0,0,0),   P0[10],P0[11],P0[12],P0[13], pw1[0]=PKW(P0,8), pw1[1]=PKW(P0,10), pw1); \
    VRD(5); SBAR(); GAPA(C1=__builtin_amdgcn_mfma_f32_32x32x16_bf16(kf[3],qr[1],C1,0,0,0),   P0[14],P0[15],P1[0],P1[1],   pw1[2]=PKW(P0,12),pw1[3]=PKW(P0,14), pw1); \
    VRD(2); SBAR(); GAPA(C0=__builtin_amdgcn_mfma_f32_32x32x16_bf16(kf[4],qr[2],C0,0,0,0),   P1[2],P1[3],P1[4],P1[5],     pw2[0]=PKW(P1,0), pw2[1]=PKW(P1,2), pw2); \
    VRD(6); SBAR(); GAPA(C1=__builtin_amdgcn_mfma_f32_32x32x16_bf16(kf[5],qr[2],C1,0,0,0),   P1[6],P1[7],P1[8],P1[9],     pw2[2]=PKW(P1,4), pw2[3]=PKW(P1,6), pw2); \
    VRD(3); SBAR(); GAPA(C0=__builtin_amdgcn_mfma_f32_32x32x16_bf16(kf[6],qr[3],C0,0,0,0),   P1[10],P1[11],P1[12],P1[13], pw3[0]=PKW(P1,8), pw3[1]=PKW(P1,10), pw3); \
    VRD(7); SBAR(); GAPA(C1=__builtin_amdgcn_mfma_f32_32x32x16_bf16(kf[7],qr[3],C1,0,0,0),   P1[14],P1[15],0.f,0.f,       pw3[2]=PKW(P1,12),pw3[3]=PKW(P1,14), pw3); \
    l_reg+=sacc; \
    if(GK){DMA_K((t)+3,sl_cur);} if(GV){DMA_V((t)+1,sl_next);} \
    CMASK(C0,C1,t); \
    { float a=MX3(C0[0],C0[1],C1[0]),b=MX3(C0[2],C0[3],C1[1]); a=MX3(a,C1[2],C1[3]); \
      _Pragma("unroll") for(int r=4;r<16;r+=4){a=MX3(a,C0[r],C0[r+1]);b=MX3(b,C0[r+2],C0[r+3]);a=MX3(a,C1[r],C1[r+1]);b=MX3(b,C1[r+2],C1[r+3]);} \
      float rm=__builtin_fmaxf(a,b); { auto rr=__builtin_amdgcn_permlane32_swap(__float_as_uint(rm),__float_as_uint(rm),false,false); rm=__builtin_fmaxf(__uint_as_float(rr[0]),__uint_as_float(rr[1])); } \
      resc=false; \
      if(__builtin_expect(__any(rm>(float)THRL),0)){ const float dl=__builtin_fmaxf(rm,0.f); mhat+=dl; \
        _Pragma("unroll") for(int r=0;r<16;++r){C0[r]-=dl;C1[r]-=dl;} \
        _Pragma("unroll") for(int r=0;r<16;++r)negm[r]=-mhat; asm volatile("":"+v"(negm)); \
        const float f=__builtin_amdgcn_exp2f(-dl); l_reg*=f; if(hi==0)wsf[r32]=f; resc=true; } } \
    SBAR(); \
    GAPB2(o[0]=__builtin_amdgcn_mfma_f32_32x32x16_bf16(PAF(0),VFR(0),o[0],0,0,0), C0,0); VRD2(0); \
    GAPB2(o[1]=__builtin_amdgcn_mfma_f32_32x32x16_bf16(PAF(0),VFR(4),o[1],0,0,0), C0,2); VRD2(4); \
    KRD(GL,0); GAPB2(o[0]=__builtin_amdgcn_mfma_f32_32x32x16_bf16(PAF(1),VFR(1),o[0],0,0,0), C0,4); VRD2(1); \
    KRD(GL,1); GAPB2(o[1]=__builtin_amdgcn_mfma_f32_32x32x16_bf16(PAF(1),VFR(5),o[1],0,0,0), C0,6); VRD2(5); \
    KRD(GL,2); GAPB2(o[0]=__builtin_amdgcn_mfma_f32_32x32x16_bf16(PAF(2),VFR(2),o[0],0,0,0), C0,8); VRD2(2); \
    KRD(GL,3); GAPB2(o[1]=__builtin_amdgcn_mfma_f32_32x32x16_bf16(PAF(2),VFR(6),o[1],0,0,0), C0,10); VRD2(6); \
    GAPB2(o[0]=__builtin_amdgcn_mfma_f32_32x32x16_bf16(PAF(3),VFR(3),o[0],0,0,0), C0,12); VRD2(3); \
    GAPB2(o[1]=__builtin_amdgcn_mfma_f32_32x32x16_bf16(PAF(3),VFR(7),o[1],0,0,0), C0,14); VRD2(7); \
    GAPB2(o[2]=__builtin_amdgcn_mfma_f32_32x32x16_bf16(PAF(0),VFR(0),o[2],0,0,0), C1,0); \
    GAPB2(o[3]=__builtin_amdgcn_mfma_f32_32x32x16_bf16(PAF(0),VFR(4),o[3],0,0,0), C1,2); \
    GAPB2(o[2]=__builtin_amdgcn_mfma_f32_32x32x16_bf16(PAF(1),VFR(1),o[2],0,0,0), C1,4); \
    GAPB2(o[3]=__builtin_amdgcn_mfma_f32_32x32x16_bf16(PAF(1),VFR(5),o[3],0,0,0), C1,6); \
    GAPB2(o[2]=__builtin_amdgcn_mfma_f32_32x32x16_bf16(PAF(2),VFR(2),o[2],0,0,0), C1,8); \
    GAPB2(o[3]=__builtin_amdgcn_mfma_f32_32x32x16_bf16(PAF(2),VFR(6),o[3],0,0,0), C1,10); \
    GAPB2(o[2]=__builtin_amdgcn_mfma_f32_32x32x16_bf16(PAF(3),VFR(3),o[2],0,0,0), C1,12); \
    GAPB2(o[3]=__builtin_amdgcn_mfma_f32_32x32x16_bf16(PAF(3),VFR(7),o[3],0,0,0), C1,14); \
    }while(0)
  int t=1;
  #undef CMASK
  #define CMASK(P0,P1,t) do{}while(0)
  for(;t+5<NT;t+=2){
    STEP(pB0,pB1,pA0,pA1,t,true,true,true);     WAIT_BAR(3); RESC(); ROT();
    STEP(pA0,pA1,pB0,pB1,t+1,true,true,true);   WAIT_BAR(3); RESC(); ROT();
  }
  #undef CMASK
  #define CMASK(P0,P1,t) do{int jb_=(t)-(NT-4); if(jb_>=0)cmask(P0,P1,jb_,qrel,hi);}while(0)
  #define ENDW(tt) do{ if((tt)+3<NT){WAIT_BAR(3);} else if((tt)+2<NT){WAIT_BAR(2);} else {WAIT_BAR(0);} }while(0)
  for(;t+1<NT;t+=2){
    STEP(pB0,pB1,pA0,pA1,t,(t+3<NT),(t+1<NT),(t+1<NT));       ENDW(t);   RESC(); ROT();
    STEP(pA0,pA1,pB0,pB1,t+1,(t+4<NT),(t+2<NT),(t+2<NT));     ENDW(t+1); RESC(); ROT();
  }
  STEP(pB0,pB1,pA0,pA1,NT-1,false,false,false); RESC();
  { float sacc=pB0[0]+pB0[1]; _Pragma("unroll") for(int r=2;r<16;++r)sacc+=pB0[r]; _Pragma("unroll") for(int r=0;r<16;++r)sacc+=pB1[r]; l_reg+=sacc;
    pw0=(u32x4){PKW(pB0,0),PKW(pB0,2),PKW(pB0,4),PKW(pB0,6)};pw1=(u32x4){PKW(pB0,8),PKW(pB0,10),PKW(pB0,12),PKW(pB0,14)};pw2=(u32x4){PKW(pB1,0),PKW(pB1,2),PKW(pB1,4),PKW(pB1,6)};pw3=(u32x4){PKW(pB1,8),PKW(pB1,10),PKW(pB1,12),PKW(pB1,14)};
    SBAR(); pv(o,vb0+2*sl_cur,PAF(0),PAF(1),PAF(2),PAF(3)); pv(o+2,vb0+2*sl_cur+SLOTB,PAF(0),PAF(1),PAF(2),PAF(3)); }
  #undef PKW
  #undef PAF
  #undef VFR
  #undef PIN
  #undef MX3
  #undef GAPA
  #undef GAPB
  #undef EX
  #undef VRD
  #undef VRD2
  #undef GAPB2
  #undef KRD
  #undef STEP
  #undef ENDW
  {auto rr=__builtin_amdgcn_permlane32_swap(__float_as_uint(l_reg),__float_as_uint(l_reg),false,false);l_reg=__uint_as_float(rr[0])+__uint_as_float(rr[1]);}
  if(hi==0)wsf[32+r32]=l_reg;asm volatile("s_waitcnt lgkmcnt(0)":::"memory");
  float rli[16];
  #pragma unroll
  for(int r=0;r<16;++r)rli[r]=__builtin_amdgcn_rcpf(wsf[32+crow(r,hi)]);
  bf16*Ow=O+(rowbase+q0+wid*QBLK)*POUT+ocol;
  { bf16*stg=(bf16*)(shm+LDS_OST)+wid*2048;
    #pragma unroll
    for(int vh=0;vh<2;++vh){
    #pragma unroll
    for(int r=0;r<16;++r){const int orow=crow(r,hi);
      #pragma unroll
      for(int d0=0;d0<2;++d0)stg[orow*64+d0*32+r32]=__float2bfloat16(o[2*vh+d0][r]*rli[r]);}
    asm volatile("s_waitcnt lgkmcnt(0)":::"memory");
    #pragma unroll
    for(int i=0;i<4;++i){const int row=i*8+(lane>>3),ch=lane&7; const u32x4 v=*(const u32x4*)(stg+row*64+ch*8); ATTN_STORE16(Ow+(long)row*POUT+vh*64+ch*8,v);}
    asm volatile("s_waitcnt lgkmcnt(0)":::"memory"); } }
  asm volatile("s_waitcnt lgkmcnt(0)\n\ts_barrier":::"memory");
  #undef DMA_K
  #undef DMA_V
  #undef CMASK
  #undef START
  #undef RESC
  #undef ROT
}
constexpr int ATTN_LDS_BYTES=LDS_BYTES;
#undef SBAR
#undef WAIT_BAR
}
#define GAS __attribute__((address_space(1)))
#define LAS __attribute__((address_space(3)))
typedef unsigned short bf16;
typedef unsigned v4u __attribute__((ext_vector_type(4)));
typedef unsigned v2u __attribute__((ext_vector_type(2)));
typedef float f32x4 __attribute__((ext_vector_type(4)));
typedef short bf16x8 __attribute__((ext_vector_type(8)));
#define LDS_WAIT() asm volatile("s_waitcnt lgkmcnt(0)" ::: "memory")

#ifndef HGRN_NAIVE
#define HGRN_NAIVE 0
#endif
constexpr int NWAVES = 8, NTHREADS = 512;
constexpr int BATCH = 2, SEQ = 8192, DM = 2048, M = BATCH * SEQ, DFF = 5632, INW = 7168, AW = 1024, HW = 1024, NH = 8;
constexpr int C_QA = 0, C_KA = 1024, C_VA = 2048, C_QH = 3072, C_FH = 4096, C_IH = 5120, C_GH = 6144;
constexpr float NORM_EPS = 1e-6f, SUBLN_EPS = 1e-5f;
constexpr int LDS_BYTES = 147456, RING_BYTES = 131072;

constexpr size_t SZ_WGU = (size_t)2 * DFF * DM * 2, SZ_WD = (size_t)DM * DFF * 2, SZ_WIN = (size_t)INW * DM * 2, SZ_WOUT = (size_t)DM * DM * 2;
constexpr size_t WS_WGU1 = 0, WS_WD1 = WS_WGU1 + SZ_WGU, WS_WIN = WS_WD1 + SZ_WD, WS_WOUT = WS_WIN + SZ_WIN, WS_WGU2 = WS_WOUT + SZ_WOUT, WS_WD2 = WS_WGU2 + SZ_WGU;
constexpr size_t WS_XN = WS_WD2 + SZ_WD;
constexpr size_t WS_MIX = WS_XN + (size_t)M * DM * 2;
constexpr size_t WS_BIG = WS_MIX + (size_t)M * DM * 2;
constexpr size_t WS_ATTO = WS_BIG + (size_t)M * INW * 2;
constexpr size_t WS_ST = WS_ATTO + (size_t)M * DM * 2;
constexpr size_t WS_DEC = WS_ST + (size_t)2048 * 128 * 128 * 2;
constexpr size_t WS_BAR = WS_DEC + (size_t)2048 * 128 * 4;
constexpr size_t WS_SSQ = WS_BAR + 16384;
constexpr size_t WS_END = WS_SSQ + (size_t)7 * M * 32 * 4;

__device__ __forceinline__ unsigned pk2(float lo, float hi) { typedef float f2_t __attribute__((ext_vector_type(2))); typedef __bf16 b2_t __attribute__((ext_vector_type(2))); const f2_t v = {lo, hi}; return __builtin_bit_cast(unsigned, __builtin_convertvector(v, b2_t)); }
__device__ __forceinline__ unsigned f2bf(float f) { return pk2(f, f) & 0xffffu; }
__device__ __forceinline__ float bf2f(unsigned short b) { return __builtin_bit_cast(float, (unsigned)b << 16); }
using pg8::shx;
__device__ __forceinline__ float wave_sum(float v, int lane) {
#pragma unroll
    for (int o = 1; o < 64; o <<= 1) v += shx(v, lane, o);
    return v;
}

#define RLX_AGENT __ATOMIC_RELAXED, __HIP_MEMORY_SCOPE_AGENT
#define XB_TMO      128
#define XB_XCNT(j)  (256  + 64 * (j))
#define XB_XSUB(j)  (1280 + 64 * (j))
#define XB_XGEN(j)  (2304 + 64 * (j))
#define XB_TOP      3328
#define XB_TOPGEN   3392
#define XCD_BAR_WORDS 3456
#define XB_SPIN_CAP (1u << 18)

__device__ __forceinline__ unsigned xb_ld(unsigned* p)              { return __hip_atomic_load(p, __ATOMIC_RELAXED, __HIP_MEMORY_SCOPE_AGENT); }
__device__ __forceinline__ unsigned xb_add(unsigned* p, unsigned v) { return __hip_atomic_fetch_add(p, v, __ATOMIC_RELAXED, __HIP_MEMORY_SCOPE_AGENT); }
__device__ __forceinline__ unsigned xb_xcc_id() { return (unsigned)__builtin_amdgcn_s_getreg((3 << 11) | 20) & 0xFu; }
#define XB_SPIN(cond, bar) do { unsigned _sp = 0; while (cond) { __builtin_amdgcn_s_sleep(1); \
    if ((++_sp & 255u) == 0u) { if (xb_ld(&(bar)[XB_TMO])) break; if (_sp > XB_SPIN_CAP) { atomicAdd(&(bar)[XB_TMO], 1u); break; } } } } while (0)

struct XcdBarrier {
    unsigned* bar; unsigned x;
    volatile LAS unsigned* st;
};

__device__ __forceinline__ XcdBarrier xcd_barrier_post(unsigned* bar, volatile LAS unsigned* st) {
    XcdBarrier b; b.bar = bar; b.x = xb_xcc_id(); b.st = st;
    if (threadIdx.x == 0) (void)xb_add(&bar[XB_XCNT(b.x)], 1u);
    return b;
}
__device__ __forceinline__ void xcd_barrier_complete(unsigned* bar, unsigned x, unsigned& nloc, unsigned& nx) {
    const unsigned G = gridDim.x * gridDim.y * gridDim.z;
    unsigned sum, cnt, mine, sp = 0u;
    for (;;) {
        sum = 0u; cnt = 0u; mine = 0u;
#pragma unroll
        for (unsigned j = 0; j < 16; ++j) { const unsigned c = xb_ld(&bar[XB_XCNT(j)]); sum += c; cnt += (c > 0u) ? 1u : 0u; mine = (j == x) ? c : mine; }
        if (sum == G) break;
        __builtin_amdgcn_s_sleep(1);
        if ((++sp & 255u) == 0u) { if (xb_ld(&bar[XB_TMO])) break; if (sp > XB_SPIN_CAP) { atomicAdd(&bar[XB_TMO], 1u); break; } }
    }
    nloc = mine > 0u ? mine : 1u; nx = cnt > 0u ? cnt : 1u;
}

__device__ __forceinline__ void xcd_barrier(const XcdBarrier& b) {
    asm volatile("s_waitcnt vmcnt(0)" ::: "memory");
    __syncthreads();
    if (threadIdx.x == 0) {
        unsigned* bar = b.bar;
        __builtin_amdgcn_s_waitcnt(0);
        unsigned nloc = b.st[0], nx = b.st[1];
        if (nloc == 0u) { xcd_barrier_complete(bar, b.x, nloc, nx); b.st[0] = nloc; b.st[1] = nx; }
        const unsigned old = xb_add(&bar[XB_XSUB(b.x)], 1u);
        const unsigned gen = old / nloc;
        if (old + 1u == (gen + 1u) * nloc) {
            __builtin_amdgcn_fence(__ATOMIC_RELEASE, "agent");
            asm volatile("s_waitcnt vmcnt(0)" ::: "memory");
            const unsigned og = xb_add(&bar[XB_TOP], 1u);
            const unsigned tg = og / nx;
            if (og + 1u == (tg + 1u) * nx) xb_add(&bar[XB_TOPGEN], 1u);
            else XB_SPIN(xb_ld(&bar[XB_TOPGEN]) == tg, bar);
            __builtin_amdgcn_fence(__ATOMIC_ACQUIRE, "agent");
            xb_add(&bar[XB_XGEN(b.x)], 1u);
            asm volatile("s_waitcnt vmcnt(0)" ::: "memory");
        } else {
            XB_SPIN(xb_ld(&bar[XB_XGEN(b.x)]) == gen, bar);
            __builtin_amdgcn_fence(__ATOMIC_ACQUIRE, "agent");
            asm volatile("s_waitcnt vmcnt(0)" ::: "memory");
        }
    }
    __syncthreads();
}

struct Args { const float* in[20]; float* out; unsigned char* ws; int ph_lo, ph_hi; };

__device__ __forceinline__ void transpose_item(const float* W, int K, int N, bf16* WT, int mode, const float* nw, LAS float* scr, int item, int lane) {
    const int nblk = N / 32, kb = item / nblk, nb = item % nblk, k0 = 64 * kb, n0 = 32 * nb;
    const int drow0 = (mode == 0) ? n0 : ((n0 >> 7) * 256 + (n0 & 127) + (mode == 2 ? 128 : 0));
#pragma unroll 8
    for (int i = 0; i < 32; ++i) { const int kk = 2 * i + (lane >> 5); scr[kk * 33 + (lane & 31)] = W[(size_t)(k0 + kk) * N + n0 + (lane & 31)]; }
    LDS_WAIT(); asm volatile("" ::: "memory");
    const int c = lane & 7;
    f32x4 na = {1.f, 1.f, 1.f, 1.f}, nb2 = na;
    if (nw) { na = *(const GAS f32x4*)(nw + k0 + 8 * c); nb2 = *(const GAS f32x4*)(nw + k0 + 8 * c + 4); }
#pragma unroll
    for (int j = 0; j < 4; ++j) { const int n = (lane >> 3) + 8 * j; const LAS float* s = scr + (8 * c) * 33 + n;
        v4u o; o.x = pk2(s[0 * 33] * na.x, s[1 * 33] * na.y); o.y = pk2(s[2 * 33] * na.z, s[3 * 33] * na.w); o.z = pk2(s[4 * 33] * nb2.x, s[5 * 33] * nb2.y); o.w = pk2(s[6 * 33] * nb2.z, s[7 * 33] * nb2.w);
        const int r = drow0 + n; *(GAS v4u*)(WT + ((size_t)((r >> 8) * (K >> 6) + kb) * 256 + (r & 255)) * 64 + 8 * c) = o; }
    LDS_WAIT(); asm volatile("" ::: "memory");
}
__device__ __forceinline__ void rms_row_to_bf16(const float* xrow, const float* w, bf16* orow, int lane) {
    const GAS f32x4* xr = (const GAS f32x4*)xrow + lane; const GAS f32x4* wr = (const GAS f32x4*)w + lane;
    f32x4 v[8]; float s = 0.f;
#pragma unroll
    for (int j = 0; j < 8; ++j) { v[j] = xr[64 * j]; s += (v[j].x * v[j].x + v[j].y * v[j].y) + (v[j].z * v[j].z + v[j].w * v[j].w); }
    const float rstd = 1.0f / sqrtf(wave_sum(s, lane) * (1.f / DM) + NORM_EPS);
    GAS v2u* o8 = (GAS v2u*)orow + lane;
#pragma unroll
    for (int j = 0; j < 8; ++j) { const f32x4 ww = wr[64 * j]; v2u o; o.x = pk2(v[j].x * rstd * ww.x, v[j].y * rstd * ww.y); o.y = pk2(v[j].z * rstd * ww.z, v[j].w * rstd * ww.w); o8[64 * j] = o; }
}
__device__ __forceinline__ void row_to_bf16_ssq(const float* xrow, bf16* xn, int m, float* ssq, int lane) {
    const GAS f32x4* xr = (const GAS f32x4*)xrow + lane; float s = 0.f;
#pragma unroll
    for (int j = 0; j < 8; ++j) { const f32x4 v = xr[64 * j]; s += (v.x * v.x + v.y * v.y) + (v.z * v.z + v.w * v.w); v2u o; o.x = pk2(v.x, v.y); o.y = pk2(v.z, v.w); *(GAS v2u*)(xn + pg8::toff(m, 4 * lane + 256 * j, DM / 64)) = o; }
    s = wave_sum(s, lane); if (lane < 32) ssq[lane] = (lane == 0) ? s : 0.f;
}
__device__ __forceinline__ void rms_row_bf16_to_f32(const bf16* xn, int m, float* orow, const float* w, int lane) {
    f32x4 v[4][2]; float s = 0.f;
#pragma unroll
    for (int j = 0; j < 4; ++j) { const v4u b = *(const GAS v4u*)(xn + pg8::toff(m, 8 * lane + 512 * j, DM / 64));
        v[j][0] = (f32x4){__builtin_bit_cast(float, b.x << 16), __builtin_bit_cast(float, b.x & 0xffff0000u), __builtin_bit_cast(float, b.y << 16), __builtin_bit_cast(float, b.y & 0xffff0000u)};
        v[j][1] = (f32x4){__builtin_bit_cast(float, b.z << 16), __builtin_bit_cast(float, b.z & 0xffff0000u), __builtin_bit_cast(float, b.w << 16), __builtin_bit_cast(float, b.w & 0xffff0000u)};
#pragma unroll
        for (int h = 0; h < 2; ++h) s += (v[j][h].x * v[j][h].x + v[j][h].y * v[j][h].y) + (v[j][h].z * v[j][h].z + v[j][h].w * v[j][h].w); }
    const float rstd = 1.0f / sqrtf(wave_sum(s, lane) * (1.f / DM) + NORM_EPS);
#pragma unroll
    for (int j = 0; j < 4; ++j)
#pragma unroll
        for (int h = 0; h < 2; ++h) { const int col = 512 * j + 8 * lane + 4 * h; const f32x4 ww = *(const GAS f32x4*)(w + col); *(GAS f32x4*)(orow + col) = v[j][h] * rstd * ww; }
}
__device__ __forceinline__ void rms_row_to_f32(float* xrow, const float* w, int lane) {
    GAS f32x4* xr = (GAS f32x4*)xrow + lane; const GAS f32x4* wr = (const GAS f32x4*)w + lane;
    f32x4 v[8]; float s = 0.f;
#pragma unroll
    for (int j = 0; j < 8; ++j) { v[j] = xr[64 * j]; s += (v[j].x * v[j].x + v[j].y * v[j].y) + (v[j].z * v[j].z + v[j].w * v[j].w); }
    const float rstd = 1.0f / sqrtf(wave_sum(s, lane) * (1.f / DM) + NORM_EPS);
#pragma unroll
    for (int j = 0; j < 8; ++j) { const f32x4 ww = wr[64 * j]; xr[64 * j] = v[j] * rstd * ww; }
}
__device__ __forceinline__ float lambda_init_of(int layer) { return layer == 0 ? 0.2f : 0.35550907f; }

struct PmRaw { v4u a[4]; v2u r[4], g[4]; };
__device__ __forceinline__ void pm_load(PmRaw& P, int row, const bf16* atto, const bf16* rec, const bf16* proj, int lane) {
#pragma unroll
    for (int j = 0; j < 4; ++j) { P.a[j] = *(const GAS v4u*)(atto + (size_t)row * 2048 + j * 512 + lane * 8); P.r[j] = ((const GAS v2u*)(rec + (size_t)row * HW) + lane)[64 * j];
        P.g[j] = *(const GAS v2u*)(proj + (size_t)row * INW + C_GH + 4 * lane + 256 * j); }
}
__device__ __forceinline__ void pm_compute(const PmRaw& P, int row, float lam, const float (&sw)[8], const f32x4 (&gw)[4], bf16* mix, int lane) {
    const int vb = (lane & 15) * 8;
#pragma unroll
    for (int j = 0; j < 4; ++j) {
        const v4u raw = P.a[j];
        float v[8], d[8]; float ss = 0.f;
#pragma unroll
        for (int e = 0; e < 4; ++e) { const unsigned w = raw[e]; v[2 * e] = __builtin_bit_cast(float, w << 16); v[2 * e + 1] = __builtin_bit_cast(float, w & 0xffff0000u); }
#pragma unroll
        for (int e = 0; e < 8; ++e) { const float p = shx(v[e], lane | 16, 0); d[e] = v[e] - lam * p; ss += d[e] * d[e]; }
        ss += shx(ss, lane, 1); ss += shx(ss, lane, 2); ss += shx(ss, lane, 4); ss += shx(ss, lane, 8);
        const float rstd = 1.0f / sqrtf(ss * (1.f / 128.f) + SUBLN_EPS);
        v4u o; o.x = pk2(d[0] * rstd * sw[0], d[1] * rstd * sw[1]); o.y = pk2(d[2] * rstd * sw[2], d[3] * rstd * sw[3]); o.z = pk2(d[4] * rstd * sw[4], d[5] * rstd * sw[5]); o.w = pk2(d[6] * rstd * sw[6], d[7] * rstd * sw[7]);
        const int h = 2 * j + (lane >> 5);
        if ((lane & 16) == 0) *(GAS v4u*)(mix + pg8::toff(row, h * 128 + vb, DM / 64)) = o;
    }
    f32x4 r[4]; float s = 0.f;
#pragma unroll
    for (int j = 0; j < 4; ++j) { const v2u rw = P.r[j]; r[j] = (f32x4){__builtin_bit_cast(float, rw.x << 16), __builtin_bit_cast(float, rw.x & 0xffff0000u), __builtin_bit_cast(float, rw.y << 16), __builtin_bit_cast(float, rw.y & 0xffff0000u)};
        s += (r[j].x * r[j].x + r[j].y * r[j].y) + (r[j].z * r[j].z + r[j].w * r[j].w); }
    const float rstd = 1.0f / sqrtf(wave_sum(s, lane) * (1.f / HW) + NORM_EPS);
#pragma unroll
    for (int j = 0; j < 4; ++j) { const int col = 4 * lane + 256 * j; const v2u graw = P.g[j];
        float g[4] = { __builtin_bit_cast(float, graw.x << 16), __builtin_bit_cast(float, graw.x & 0xffff0000u), __builtin_bit_cast(float, graw.y << 16), __builtin_bit_cast(float, graw.y & 0xffff0000u) };
        float o[4];
#pragma unroll
        for (int e = 0; e < 4; ++e) { const float sg = g[e] / (1.0f + __expf(-g[e])); o[e] = r[j][e] * rstd * gw[j][e] * sg; }
        v2u ov; ov.x = pk2(o[0], o[1]); ov.y = pk2(o[2], o[3]);
        *(GAS v2u*)(mix + pg8::toff(row, 1024 + col, DM / 64)) = ov; }
}

__device__ __forceinline__ float hgrn_lb(const float* lbsrc, int layer, int ch) { return layer == 0 ? 0.f : 1.0f / (1.0f + __expf(lbsrc[ch] - lbsrc[HW + ch])); }

__device__ __forceinline__ void hgrn_naive_item(int item, const bf16* proj, float* rec, const float* lbsrc, int layer, LAS unsigned char* lds, int tid) {
    typedef float f32x2 __attribute__((ext_vector_type(2)));
    LAS f32x2* tile = (LAS f32x2*)lds;
    const int b = item >> 3, h = item & 7, lane = tid & 63, wave = tid >> 6;
    const int k = tid & 127, tq = tid >> 7;
    const float lb = hgrn_lb(lbsrc, layer, h * 128 + k);
    float S[128];
#pragma unroll
    for (int i = 0; i < 128; ++i) S[i] = 0.f;
    for (int tb = 0; tb < SEQ / 64; ++tb) {
        const size_t row0 = (size_t)b * SEQ + (size_t)tb * 64;
#pragma unroll 4
        for (int j = 0; j < 16; ++j) { const int t = tq + 4 * j; const bf16* pr = proj + (row0 + t) * INW + h * 128 + k;
            const float z = bf2f(pr[C_FH]), q = bf2f(pr[C_QH]); const float f = lb + (1.0f - lb) / (1.0f + __expf(-z));
            tile[t * 128 + k] = (f32x2){f, q}; }
        __syncthreads();
        if (wave < 2) { const int v = wave * 64 + lane;
            for (int t = 0; t < 64; ++t) { const float iv = bf2f(proj[(row0 + t) * INW + C_IH + h * 128 + v]); float o = 0.f;
#pragma unroll
                for (int kk = 0; kk < 128; ++kk) { const f32x2 fq = tile[t * 128 + kk]; S[kk] = fq.x * (S[kk] - iv) + iv; o += fq.y * S[kk]; }
                rec[(row0 + t) * HW + h * 128 + v] = o; } }
        __syncthreads();
    }
}

constexpr int HG_TOT = 0, HG_A1 = 2048, HG_A2 = HG_A1 + 64 * 272, HG_B1 = HG_A2 + 64 * 272, HG_VT = HG_B1 + 64 * 272, HG_P = HG_VT + 128 * 144, HG_END = HG_P + 64 * 144;
constexpr int HG_B3T = 2048;
static_assert(HG_B3T + 128 * 144 <= HG_VT && HG_END <= RING_BYTES, "HGRN LDS map");
struct HgRaw { unsigned zq[16], vv[8]; };
template <int PASS>
__device__ __forceinline__ void hg_load(HgRaw& R, int unit, const bf16* proj, int tid) {
    const int bh = unit >> 7, c = unit & 127, b = bh >> 3, h = bh & 7; const size_t row0 = (size_t)b * SEQ + (size_t)c * 64; const int k = tid & 127, tg = tid >> 7;
    const bf16* pz = proj + (row0 + 16 * tg) * INW + h * 128 + k;
#pragma unroll
    for (int j = 0; j < 16; ++j) { const unsigned z = pz[(size_t)j * INW + C_FH]; const unsigned q = (PASS == 3) ? pz[(size_t)j * INW + C_QH] : 0u; R.zq[j] = z | (q << 16); }
#pragma unroll
    for (int j = 0; j < 8; ++j) { const unsigned a = pz[(size_t)(2 * j) * INW + C_IH], b2 = pz[(size_t)(2 * j + 1) * INW + C_IH]; R.vv[j] = a | (b2 << 16); }
}
template <int PASS>
__device__ __forceinline__ void hgrn_chunk_unit(const HgRaw& R, int unit, const bf16* proj, bf16* Lbuf, float* dec, const bf16* ST, bf16* rec, float lb, LAS unsigned char* lds, int tid) {
    const int bh = unit >> 7, c = unit & 127, b = bh >> 3, h = bh & 7;
    const size_t row0 = (size_t)b * SEQ + (size_t)c * 64;
    const int k = tid & 127, tg = tid >> 7, lane = tid & 63, w = __builtin_amdgcn_readfirstlane(tid >> 6), fr = lane & 15, fq = lane >> 4;
    LAS float* TOT = (LAS float*)(lds + HG_TOT);
    float bcum[16], kk[16], qv[16];
    {   float run = 0.f;
#pragma unroll
        for (int j = 0; j < 16; ++j) { const float z = __builtin_bit_cast(float, R.zq[j] << 16);
            if (PASS == 3) qv[j] = __builtin_bit_cast(float, R.zq[j] & 0xffff0000u);
            const float e = __expf(-z); const float sg = 1.0f / (1.0f + e);
            const float f = fmaxf(lb + (1.0f - lb) * sg, 1e-26f);
            kk[j] = (1.0f - lb) * (e * sg);
            run += __logf(f); bcum[j] = run; }
        TOT[tg * 128 + k] = run;
    }
    {   v4u o0, o1;
        o0.x = R.vv[0]; o0.y = R.vv[1]; o0.z = R.vv[2]; o0.w = R.vv[3]; o1.x = R.vv[4]; o1.y = R.vv[5]; o1.z = R.vv[6]; o1.w = R.vv[7];
        *(LAS v4u*)(lds + HG_VT + k * 144 + tg * 32) = o0; *(LAS v4u*)(lds + HG_VT + k * 144 + tg * 32 + 16) = o1;
    }
    __syncthreads();
    const float t0 = TOT[k], t1 = TOT[128 + k], t2 = TOT[256 + k], t3 = TOT[384 + k];
    const float off = (tg > 0 ? t0 : 0.f) + (tg > 1 ? t1 : 0.f) + (tg > 2 ? t2 : 0.f);
    const float blast = (t0 + t1) + (t2 + t3);
    if (PASS == 1) {
        unsigned pkd[8];
#pragma unroll
        for (int j = 0; j < 16; j += 2) pkd[j >> 1] = pk2(kk[j] * __expf(blast - (off + bcum[j])), kk[j + 1] * __expf(blast - (off + bcum[j + 1])));
        *(LAS v4u*)(lds + HG_B3T + k * 144 + tg * 32) = (v4u){pkd[0], pkd[1], pkd[2], pkd[3]};
        *(LAS v4u*)(lds + HG_B3T + k * 144 + tg * 32 + 16) = (v4u){pkd[4], pkd[5], pkd[6], pkd[7]};
        if (tg == 0) dec[(size_t)unit * 128 + k] = __expf(blast);
        __syncthreads();
        bf16x8 yv[2];
#pragma unroll
        for (int ks = 0; ks < 2; ++ks) yv[ks] = *(const LAS bf16x8*)(lds + HG_VT + (16 * w + fr) * 144 + ks * 64 + fq * 16);
        bf16* Lu = Lbuf + (size_t)unit * 16384 + (size_t)(16 * w + fr) * 128 + 4 * fq;
#pragma unroll
        for (int xb = 0; xb < 8; ++xb) { f32x4 acc = {0.f, 0.f, 0.f, 0.f};
#pragma unroll
            for (int ks = 0; ks < 2; ++ks) { const bf16x8 xv = *(const LAS bf16x8*)(lds + HG_B3T + (16 * xb + fr) * 144 + ks * 64 + fq * 16);
                acc = __builtin_amdgcn_mfma_f32_16x16x32_bf16(xv, yv[ks], acc, 0, 0, 0); }
            *(GAS v2u*)(Lu + 16 * xb) = (v2u){pk2(acc[0], acc[1]), pk2(acc[2], acc[3])}; }
    } else {
        const float r = t0 + t1;
#pragma unroll
        for (int j = 0; j < 16; ++j) { const float bj = off + bcum[j]; const int t = 16 * tg + j;
            const float a1 = qv[j] * __expf(fminf(bj - r, 80.f)), a2 = qv[j] * __expf(bj), b1 = kk[j] * __expf(fminf(r - bj, 80.f));
            const unsigned w12 = pk2(a1, a2), w3 = pk2(b1, b1);
            *(LAS unsigned short*)(lds + HG_A1 + t * 272 + k * 2) = (unsigned short)w12;
            *(LAS unsigned short*)(lds + HG_A2 + t * 272 + k * 2) = (unsigned short)(w12 >> 16);
            *(LAS unsigned short*)(lds + HG_B1 + t * 272 + k * 2) = (unsigned short)w3; }
        bf16x8 sx[4];
#pragma unroll
        for (int ks = 0; ks < 4; ++ks) sx[ks] = *(const GAS bf16x8*)(ST + (size_t)unit * 16384 + (size_t)(16 * w + fr) * 128 + 32 * ks + 8 * fq);
        __syncthreads();
#pragma unroll
        for (int rep = 0; rep < 2; ++rep) { const int id = w + 8 * rep, sb = id >> 2, tb = id & 3;
            f32x4 acc = {0.f, 0.f, 0.f, 0.f};
            if (sb <= tb) {
#pragma unroll
                for (int ks = 0; ks < 4; ++ks) { const bf16x8 xv = *(const LAS bf16x8*)(lds + HG_B1 + (16 * sb + fr) * 272 + ks * 64 + fq * 16);
                    const bf16x8 yv = *(const LAS bf16x8*)(lds + HG_A1 + (16 * tb + fr) * 272 + ks * 64 + fq * 16);
                    acc = __builtin_amdgcn_mfma_f32_16x16x32_bf16(xv, yv, acc, 0, 0, 0); }
            }
            const int t = 16 * tb + fr, s0 = 16 * sb + 4 * fq;
            float pvv[4];
#pragma unroll
            for (int i = 0; i < 4; ++i) pvv[i] = (sb <= tb && s0 + i <= t) ? acc[i] : 0.f;
            *(LAS v2u*)(lds + HG_P + t * 144 + s0 * 2) = (v2u){pk2(pvv[0], pvv[1]), pk2(pvv[2], pvv[3])}; }
        __syncthreads();
        bf16x8 vx[2];
#pragma unroll
        for (int ks = 0; ks < 2; ++ks) vx[ks] = *(const LAS bf16x8*)(lds + HG_VT + (16 * w + fr) * 144 + ks * 64 + fq * 16);
#pragma unroll
        for (int tb = 0; tb < 4; ++tb) { f32x4 acc = {0.f, 0.f, 0.f, 0.f};
#pragma unroll
            for (int ks = 0; ks < 2; ++ks) { const bf16x8 yv = *(const LAS bf16x8*)(lds + HG_P + (16 * tb + fr) * 144 + ks * 64 + fq * 16);
                acc = __builtin_amdgcn_mfma_f32_16x16x32_bf16(vx[ks], yv, acc, 0, 0, 0); }
#pragma unroll
            for (int ks = 0; ks < 4; ++ks) { const bf16x8 yv = *(const LAS bf16x8*)(lds + HG_A2 + (16 * tb + fr) * 272 + ks * 64 + fq * 16);
                acc = __builtin_amdgcn_mfma_f32_16x16x32_bf16(sx[ks], yv, acc, 0, 0, 0); }
            *(GAS v2u*)(rec + (row0 + 16 * tb + fr) * HW + h * 128 + 16 * w + 4 * fq) = (v2u){pk2(acc[0], acc[1]), pk2(acc[2], acc[3])}; }
    }
    __syncthreads();
}
__device__ __forceinline__ void hgrn_scan(int gtid, int nthreads, const bf16* Lbuf, const float* dec, bf16* ST) {
    typedef float f32x2 __attribute__((ext_vector_type(2)));
    for (int idx = gtid; idx < 16 * 8192; idx += nthreads) {
        const int bh = idx >> 13, e2 = (idx & 8191) * 2, kq = e2 & 127;
        const unsigned* Lp = (const unsigned*)(Lbuf + (size_t)bh * 128 * 16384 + e2); const float* dp = dec + (size_t)bh * 128 * 128 + kq; unsigned* sp = (unsigned*)(ST + (size_t)bh * 128 * 16384 + e2);
        f32x2 S = {0.f, 0.f};
#pragma unroll 8
        for (int c = 0; c < 128; ++c) { const unsigned lw = Lp[(size_t)c * 8192]; const f32x2 lv = {__builtin_bit_cast(float, lw << 16), __builtin_bit_cast(float, lw & 0xffff0000u)}; const f32x2 d = *(const GAS f32x2*)(dp + c * 128);
            sp[(size_t)c * 8192] = pk2(S.x, S.y); S = d * S + lv; }
    }
}

__device__ __forceinline__ void rstd_table(LAS float* tab, const float* ssq, int pm, float inv_n, float eps, int tid) {
    const int r = tid >> 1, hf = tid & 1; const f32x4* p = (const f32x4*)(ssq + (size_t)(pm * 256 + r) * 32 + hf * 16);
    const f32x4 a = p[0], b = p[1], c = p[2], d = p[3];
    const float q0 = ((a[0] + a[1]) + (a[2] + a[3])) + ((b[0] + b[1]) + (b[2] + b[3])), q1 = ((c[0] + c[1]) + (c[2] + c[3])) + ((d[0] + d[1]) + (d[2] + d[3]));
    float s = q0 + q1; s += shx(s, tid & 63, 1);
    if (hf == 0) tab[r] = __builtin_amdgcn_rsqf(s * inv_n + eps);
    __syncthreads();
}
#ifndef GEMM_ALIGN
#define GEMM_ALIGN true
#endif
#ifndef GEMM_SP2
#define GEMM_SP2 true
#endif
constexpr int PH_PER_LAYER = 13, N_PHASES = 2 * PH_PER_LAYER + 1;

__global__ void __launch_bounds__(NTHREADS, 2) hymba_fwd(Args args) {
    extern __shared__ __attribute__((aligned(16))) unsigned char lds_raw[];
    LAS unsigned char* lds = (LAS unsigned char*)lds_raw;
    cg::grid_group grid = cg::this_grid();
    const int G = gridDim.x, bx = blockIdx.x;
    const int vcu = (G % 8 == 0) ? (bx % 8) * (G / 8) + bx / 8 : bx;
    const int NGW = G * NWAVES;
    unsigned char* ws = args.ws;
    const float* x_in = args.in[0];
    float* xres = args.out;
    bf16* XN = (bf16*)(ws + WS_XN); bf16* MIX = (bf16*)(ws + WS_MIX); bf16* BIG = (bf16*)(ws + WS_BIG); bf16* ATTO = (bf16*)(ws + WS_ATTO);
    float* SSQ = (float*)(ws + WS_SSQ);
    bf16* REC = (bf16*)xres; bf16* LBUF = (bf16*)xres;     bf16* ST = (bf16*)(ws + WS_ST); float* DEC = (float*)(ws + WS_DEC);
    bf16* Wgu1 = (bf16*)(ws + WS_WGU1); bf16* Wd1 = (bf16*)(ws + WS_WD1); bf16* Win = (bf16*)(ws + WS_WIN); bf16* Wout = (bf16*)(ws + WS_WOUT); bf16* Wgu2 = (bf16*)(ws + WS_WGU2); bf16* Wd2 = (bf16*)(ws + WS_WD2);

    LAS float* RTAB = (LAS float*)(lds + RING_BYTES + 1024);
    unsigned* barw = (unsigned*)(ws + WS_BAR);
    volatile LAS unsigned* bst = (volatile LAS unsigned*)(lds + RING_BYTES);
    if (threadIdx.x < 2) bst[threadIdx.x] = 0u;
    if (bx == 0 && args.ph_lo == 0) for (int i = threadIdx.x; i < 4096; i += NTHREADS) __hip_atomic_store(barw + i, 0u, __ATOMIC_RELAXED, __HIP_MEMORY_SCOPE_AGENT);
    __syncthreads();
#ifdef PROBE_MASK
    int probe_rep = 0;
#endif
    XcdBarrier xbar; xbar.bar = barw; xbar.x = 0; xbar.st = bst;
    for (int ph = args.ph_lo; ph < args.ph_hi; ++ph) {
        const int layer = ph / PH_PER_LAYER, p = (ph == N_PHASES - 1) ? 99 : ph % PH_PER_LAYER;
        if (p == 3 || p == 10 || (p == 8 && !HGRN_NAIVE)) continue;
        int tid_o = threadIdx.x; asm volatile("" : "+v"(tid_o));
        const int tid = tid_o;
#define PHASE_IDS const int lane = tid & 63, wave = __builtin_amdgcn_readfirstlane(tid >> 6), gw = vcu * NWAVES + wave; (void)lane; (void)wave; (void)gw;
        switch (p) {
        case 0: {
            PHASE_IDS
            LAS float* scr = (LAS float*)(lds + wave * 16384);
            const float* g1 = args.in[2] + (size_t)layer * DM * DFF; const float* u1 = args.in[3] + (size_t)layer * DM * DFF; const float* d1 = args.in[4] + (size_t)layer * DFF * DM;
            const float* wi = args.in[6] + (size_t)layer * DM * INW; const float* wo = args.in[14] + (size_t)layer * DM * DM;
            const float* g2 = args.in[16] + (size_t)layer * DM * DFF; const float* u2 = args.in[17] + (size_t)layer * DM * DFF; const float* d2 = args.in[18] + (size_t)layer * DFF * DM;
            const float* nw1 = args.in[1] + (size_t)layer * DM; const float* nw2 = args.in[5] + (size_t)layer * DM; const float* nw3 = args.in[15] + (size_t)layer * DM;
            constexpr int I_F = (DM / 64) * (DFF / 32), I_IN = (DM / 64) * (INW / 32), I_OUT = (DM / 64) * (DM / 32);
            constexpr int NITEMS = 6 * I_F + I_IN + I_OUT;
            for (int it = gw; it < NITEMS; it += NGW) {
                int r = it;
                if (r < I_F) { transpose_item(g1, DM, DFF, Wgu1, 1, nw1, scr, r, lane); continue; } r -= I_F;
                if (r < I_F) { transpose_item(u1, DM, DFF, Wgu1, 2, nw1, scr, r, lane); continue; } r -= I_F;
                if (r < I_F) { transpose_item(d1, DFF, DM, Wd1, 0, nullptr, scr, r, lane); continue; } r -= I_F;
                if (r < I_IN) { transpose_item(wi, DM, INW, Win, 0, nw2, scr, r, lane); continue; } r -= I_IN;
                if (r < I_OUT) { transpose_item(wo, DM, DM, Wout, 0, nullptr, scr, r, lane); continue; } r -= I_OUT;
                if (r < I_F) { transpose_item(g2, DM, DFF, Wgu2, 1, nw3, scr, r, lane); continue; } r -= I_F;
                if (r < I_F) { transpose_item(u2, DM, DFF, Wgu2, 2, nw3, scr, r, lane); continue; } r -= I_F;
                transpose_item(d2, DFF, DM, Wd2, 0, nullptr, scr, r, lane);
            }
            if (ph == 0) for (int m = gw; m < M; m += NGW) row_to_bf16_ssq(x_in + (size_t)m * DM, XN, m, SSQ + (size_t)m * 32, lane);
        } break;
        case 1: case 11: {
            pg8::Gemm g{XN, p == 1 ? Wgu1 : Wgu2, M, 2 * DFF, DM}; pg8::StaticOrder S; S.init(M, 2 * DFF, G, bx);
            const float* sq = SSQ + (size_t)(layer * 3 + (p == 1 ? 0 : 2)) * M * 32; pg8::Unit u0; S.next(0, u0); rstd_table(RTAB, sq, u0.pm, 1.0f / DM, NORM_EPS, tid);
            pg8::EpiSwiGLU E{BIG, DFF, sq, 1.0f / DM, NORM_EPS, RTAB, u0.pm};
            pg8::gemm_phase<pg8::EpiSwiGLU, pg8::StaticOrder, GEMM_ALIGN, GEMM_SP2>(lds, g, S, E);
        } break;
        case 2: case 12: case 9: {
            const bf16* A = (p == 9) ? MIX : BIG; const bf16* Bt = (p == 2) ? Wd1 : (p == 12) ? Wd2 : Wout; const int K = (p == 9) ? DM : DFF;
            pg8::Gemm g{A, Bt, M, DM, K}; pg8::StaticOrder S; S.init(M, DM, G, bx);
            pg8::EpiResidual E{XN, SSQ + (size_t)(layer * 3 + (p == 2 ? 1 : p == 9 ? 2 : 3)) * M * 32, DM, (p == 9) ? 1.0f : 0.5f};
            pg8::gemm_phase<pg8::EpiResidual, pg8::StaticOrder, GEMM_ALIGN, GEMM_SP2>(lds, g, S, E);
        } break;
        case 4: {
            pg8::Gemm g{XN, Win, M, INW, DM}; pg8::StaticOrder S; S.init(M, INW, G, bx);
            const float* sq = SSQ + (size_t)(layer * 3 + 1) * M * 32; pg8::Unit u0; S.next(0, u0); rstd_table(RTAB, sq, u0.pm, 1.0f / DM, NORM_EPS, tid);
            pg8::EpiProj E{BIG, INW, sq, 1.0f / DM, NORM_EPS, AW, attn_body::C2, RTAB, u0.pm};
            pg8::gemm_phase<pg8::EpiProj, pg8::StaticOrder, GEMM_ALIGN, GEMM_SP2>(lds, g, S, E);
        } break;
        case 5: {
            for (int i = vcu; i < 256; i += G) {
                const int gsel = i >> 3, s = i & 7; const int b = gsel >> 4, hc = gsel & 15, h = hc >> 1;
                for (int qi = 0; qi < 4; ++qi) { const int qb = (qi == 0) ? s : (qi == 1) ? 15 - s : (qi == 2) ? 16 + s : 31 - s;
                    attn_body::attn_unit<8>(b, C_QA + hc * 64, C_KA + hc * 64, C_VA + h * 128, hc * 128, qb, (const attn_body::bf16*)BIG, (attn_body::bf16*)ATTO, (char*)lds_raw); }
            }
            {   int tid2 = tid; asm volatile("" : "+v"(tid2));
#define tid tid2
                HgRaw cur, nxt; hg_load<1>(cur, vcu < 2048 ? vcu : 2047, BIG, tid);
                for (int u = vcu; u < 2048; u += G) { hg_load<1>(nxt, u + G < 2048 ? u + G : u, BIG, tid);
                    hgrn_chunk_unit<1>(cur, u, BIG, LBUF, DEC, ST, REC, hgrn_lb(args.in[12], layer, ((u >> 7) & 7) * 128 + (tid & 127)), lds, tid); cur = nxt; } }
#undef tid
        } break;
        case 6: {
#if HGRN_NAIVE
            for (int item = bx; item < 16; item += G) hgrn_naive_item(item, BIG, REC, args.in[12], layer, lds, tid);
#else
            hgrn_scan(bx * NTHREADS + tid, G * NTHREADS, LBUF, DEC, ST);
#endif
        } break;
        case 7: {
#if !HGRN_NAIVE
            {
                PHASE_IDS
                const float sa = wave_sum(args.in[7][layer * 64 + lane] * args.in[8][layer * 64 + lane], lane), sb = wave_sum(args.in[9][layer * 64 + lane] * args.in[10][layer * 64 + lane], lane);
                const float li = lambda_init_of(layer), lam = __expf(sa) - __expf(sb) + li;
                for (int bc = vcu; bc < 256; bc += G) { const int b = bc >> 7, c = bc & 127;
                    float lb_cur = hgrn_lb(args.in[12], layer, (tid & 127)), lb_nxt;
                    HgRaw cur, nxt; hg_load<3>(cur, (b * 8) * 128 + c, BIG, tid);
                    for (int h = 0; h < 8; ++h) { const int u = (b * 8 + h) * 128 + c; hg_load<3>(nxt, h < 7 ? u + 128 : u, BIG, tid); lb_nxt = hgrn_lb(args.in[12], layer, (h < 7 ? h + 1 : h) * 128 + (tid & 127));
                        hgrn_chunk_unit<3>(cur, u, BIG, LBUF, DEC, ST, REC, lb_cur, lds, tid); cur = nxt; lb_cur = lb_nxt; }
                    asm volatile("s_waitcnt vmcnt(0)" ::: "memory"); __syncthreads();
                    const int row0 = b * SEQ + c * 64 + wave * 8;
                    float sw[8]; f32x4 gw[4];
#pragma unroll
                    for (int e = 0; e < 8; ++e) sw[e] = args.in[11][layer * 128 + (lane & 15) * 8 + e] * (1.0f - li);
#pragma unroll
                    for (int j = 0; j < 4; ++j) gw[j] = *(const GAS f32x4*)(args.in[13] + (size_t)layer * HW + 4 * lane + 256 * j);
                    PmRaw pc, pn; pm_load(pc, row0, ATTO, REC, BIG, lane);
                    for (int i = 0; i < 8; ++i) { pm_load(pn, row0 + (i < 7 ? i + 1 : i), ATTO, REC, BIG, lane); pm_compute(pc, row0 + i, lam, sw, gw, MIX, lane); pc = pn; }
                }
            }
#endif
        } break;
        default: {
            PHASE_IDS
            for (int m = gw; m < M; m += NGW) rms_row_bf16_to_f32(XN, m, xres + (size_t)m * DM, args.in[19], lane);
        } break;
        }
        if (ph + 1 < args.ph_hi) {
            if (ph == args.ph_lo) { grid.sync(); xbar = xcd_barrier_post(barw, bst); }
            else xcd_barrier(xbar);
        }
#ifdef PROBE_MASK
        if (p < 32 && ((PROBE_MASK >> p) & 1) && !probe_rep && ph != args.ph_lo) { probe_rep = 1; --ph; } else probe_rep = 0;
#endif
    }
}

#ifndef HGRN_NAIVE
#define HGRN_NAIVE 0
#endif
#ifndef N_LAUNCH_MODE
#define N_LAUNCH_MODE 1
#endif
extern "C" void kernel_launch(void* const* d_in, const int* in_sizes, int n_in, void* d_out, int out_size, void* d_ws, size_t ws_size, hipStream_t stream) {
    static int grid = 0;
    if (grid == 0) {
        if (n_in != 20 || out_size != M * DM || ws_size < WS_END) { fprintf(stderr, "kernel_launch: unexpected shapes (n_in %d out %d ws %zu need %zu)\n", n_in, out_size, ws_size, (size_t)WS_END); grid = -1; return; }
        int dev = 0, cus = 0, per_cu = 0;
        (void)hipGetDevice(&dev); (void)hipDeviceGetAttribute(&cus, hipDeviceAttributeMultiprocessorCount, dev);
        if (hipFuncSetAttribute((const void*)hymba_fwd, hipFuncAttributeMaxDynamicSharedMemorySize, LDS_BYTES) != hipSuccess) { fprintf(stderr, "kernel_launch: hipFuncSetAttribute failed\n"); grid = -1; return; }
        if (hipOccupancyMaxActiveBlocksPerMultiprocessor(&per_cu, (const void*)hymba_fwd, NTHREADS, LDS_BYTES) != hipSuccess || per_cu < 1) { fprintf(stderr, "kernel_launch: occupancy query says %d\n", per_cu); per_cu = 1; }
        (void)hipGetLastError();
        grid = cus;
    }
    if (grid < 0) return;
    Args a{};
    for (int i = 0; i < 20; ++i) a.in[i] = (const float*)d_in[i];
    a.out = (float*)d_out; a.ws = (unsigned char*)d_ws;
#if N_LAUNCH_MODE == 1
    a.ph_lo = 0; a.ph_hi = N_PHASES;
    { void* kargs[] = {&a}; hipError_t e = hipLaunchCooperativeKernel((const void*)hymba_fwd, dim3(grid), dim3(NTHREADS), kargs, LDS_BYTES, stream);
      if (e != hipSuccess) fprintf(stderr, "cooperative launch failed: %s (grid %d)\n", hipGetErrorString(e), grid); }
#else
    for (int ph = 0; ph < N_PHASES; ++ph) { if (ph % PH_PER_LAYER == 7) continue; a.ph_lo = ph; a.ph_hi = ph + 1;
        void* kargs[] = {&a}; hipError_t e = hipLaunchCooperativeKernel((const void*)hymba_fwd, dim3(grid), dim3(NTHREADS), kargs, LDS_BYTES, stream);
        if (e != hipSuccess) { fprintf(stderr, "cooperative launch %d failed: %s (grid %d)\n", ph, hipGetErrorString(e), grid); break; } }
#endif
}
```

```cpp
#include <hip/hip_runtime.h>
#include <hip/hip_bf16.h>
#include <hip/hip_cooperative_groups.h>
#include <cstdio>
#include <cstdint>
#include <cmath>
namespace cg = cooperative_groups;
namespace pg8 {
#define PG8_LAS __attribute__((address_space(3)))
typedef unsigned short bf16_t;
typedef short bf16x8 __attribute__((ext_vector_type(8)));
typedef float f32x4 __attribute__((ext_vector_type(4)));
typedef unsigned u32x4 __attribute__((ext_vector_type(4)));
constexpr int BM = 256, BK = 64, HALF = 128, HTB = HALF * BK * 2  , STAGE_BYTES = 8 * HTB, NXCD = 8, WGM = 8;

__host__ __device__ __forceinline__ int lds_byte(int r, int c) { const int st = (r >> 4) * 2 + (c >> 5), rr = r & 15, cc = c & 31, ob = rr * 64 + cc * 2; return st * 1024 + (ob ^ (((ob >> 9) & 1) << 5)); }
__host__ __device__ __forceinline__ void stage_rc(int b, int& R, int& C) { const int st = b / 1024, sb = b % 1024, swz = sb ^ (((sb >> 9) & 1) << 5); R = (st >> 1) * 16 + swz / 64; C = (st & 1) * 32 + (swz % 64) / 2; }
__host__ __device__ __forceinline__ int perm32(int rho) { const int n = rho >> 4, i = rho & 15; return 8 * (i >> 2) + 4 * n + (i & 3); }

struct Unit { int pm, pn; };
__host__ __device__ __forceinline__ size_t toff(int m, int k, int nt) { return ((size_t)((m >> 8) * nt + (k >> 6)) * 256 + (m & 255)) * 64 + (k & 63); }
struct Gemm { const bf16_t* A; const bf16_t* Bt; int M, N, K; };

struct StaticOrder {
    int nM, nN, nwg, G, c;
    __host__ __device__ void init(int M, int N, int G_, int c_) { nM = M / BM; nN = N / BM; nwg = nM * nN; G = G_; c = c_; }
    __host__ __device__ bool next(int i, Unit& u) const {
        const long L = (long)i * G + c; if (L >= nwg) return false;
        int wgid = (int)L; { const int q = nwg / NXCD, r = nwg % NXCD, xcd = wgid % NXCD, off = wgid / NXCD; wgid = (xcd < r ? xcd * (q + 1) : r * (q + 1) + (xcd - r) * q) + off; }
        const int nig = WGM * nN, gid = wgid / nig, fm = gid * WGM, gsz = (nM - fm) < WGM ? (nM - fm) : WGM;
        u.pm = fm + ((wgid % nig) % gsz); u.pn = (wgid % nig) / gsz; return true;
    }
    __device__ __forceinline__ void a_ready(const Unit&) const {}
    __device__ __forceinline__ void done(const Unit&) const {}
};

__device__ __forceinline__ unsigned cvt_pk_bf16(float lo, float hi) { unsigned r; asm volatile("v_cvt_pk_bf16_f32 %0, %1, %2" : "=v"(r) : "v"(lo), "v"(hi)); return r; }
typedef float f32x2 __attribute__((ext_vector_type(2)));
__device__ __forceinline__ f32x2 gelu_pk(f32x2 v) {
    const f32x2 av = __builtin_elementwise_abs(v), d = av * 0.2316418882f + 1.0f;
    f32x2 t; t.x = __builtin_amdgcn_rcpf(d.x); t.y = __builtin_amdgcn_rcpf(d.y);
    f32x2 q = t * 0.5307027145f + (-0.7265760135f); q = q * t + 0.7107068705f; q = q * t + (-0.142248368f); q = q * t + 0.127414796f; q = q * t;
    const f32x2 s = (v * v) * (-0.72134752044f);
    f32x2 e; e.x = __builtin_amdgcn_exp2f(s.x); e.y = __builtin_amdgcn_exp2f(s.y);
    const f32x2 m = v * (q * e), r = v - m;
    f32x2 o; o.x = v.x < 0.f ? m.x : r.x; o.y = v.y < 0.f ? m.y : r.y; return o;
}

template <int ACT  > struct EpiBf16 {
    static constexpr bool PERM = true, AFTER_DRAIN = false; static_assert(ACT == 0 || ACT == 1, "EpiBf16: ACT is 0 (none) or 1 (gelu_pk)");
    bf16_t* O; int ldc; const float* bias; int split_cols; size_t split_stride; float scale0;
    __device__ __forceinline__ void operator()(const f32x4 (&acc)[2][2][4][2], const Unit& u, int wr, int wc, int fr, int fq) const {
        const int row0 = u.pm * BM + wr * 64 + fr; int colt = u.pn * BM; bf16_t* base = O;
        float sc = 1.f; if (split_cols) { const int t = colt / split_cols; base += (size_t)t * split_stride; colt -= t * split_cols; if (t == 0) sc = scale0; }
        const int col0 = colt + wc * 32 + 8 * fq, bcol0 = u.pn * BM + wc * 32 + 8 * fq;
        f32x4 bv[2][2];
#pragma unroll
        for (int bj = 0; bj < 2; ++bj)
#pragma unroll
            for (int n = 0; n < 2; ++n) bv[bj][n] = bias ? *(const f32x4*)(bias + bcol0 + bj * HALF + 4 * n) : (f32x4){0.f, 0.f, 0.f, 0.f};
#pragma unroll
        for (int ai = 0; ai < 2; ++ai)
#pragma unroll
            for (int m = 0; m < 4; ++m) { bf16_t* rowp = base + (size_t)(row0 + ai * HALF + m * 16) * ldc + col0;
#pragma unroll
                for (int bj = 0; bj < 2; ++bj) { f32x4 v0 = acc[ai][bj][m][0] + bv[bj][0], v1 = acc[ai][bj][m][1] + bv[bj][1];
                    if (ACT == 1) { f32x2 a = gelu_pk((f32x2){v0[0], v0[1]}), b = gelu_pk((f32x2){v0[2], v0[3]}), c = gelu_pk((f32x2){v1[0], v1[1]}), d = gelu_pk((f32x2){v1[2], v1[3]});
                        v0 = (f32x4){a.x, a.y, b.x, b.y}; v1 = (f32x4){c.x, c.y, d.x, d.y}; }
                    v0 = v0 * sc; v1 = v1 * sc; u32x4 w; w.x = cvt_pk_bf16(v0[0], v0[1]); w.y = cvt_pk_bf16(v0[2], v0[3]); w.z = cvt_pk_bf16(v1[0], v1[1]); w.w = cvt_pk_bf16(v1[2], v1[3]);
                    *(u32x4*)(rowp + bj * HALF) = w; } }
    }
};
__device__ __forceinline__ float shx(float v, int lane, int m) { return __builtin_bit_cast(float, __builtin_amdgcn_ds_bpermute((lane ^ m) << 2, __builtin_bit_cast(int, v))); }
__device__ __forceinline__ void row_rstd(float (&rs)[2][4], const float* ssq, int row0, int fq, float inv_n, float eps, const PG8_LAS float* tab, int tab_pm, int pm) {
    const int lane = (row0 & 15) + 16 * fq;
    if (pm == tab_pm) {
#pragma unroll
        for (int ai = 0; ai < 2; ++ai)
#pragma unroll
            for (int m = 0; m < 4; ++m) rs[ai][m] = tab[(row0 & 255) + ai * HALF + m * 16];
        return;
    }
#pragma unroll
    for (int ai = 0; ai < 2; ++ai)
#pragma unroll
        for (int m = 0; m < 4; ++m) { const f32x4* p = (const f32x4*)(ssq + (size_t)(row0 + ai * HALF + m * 16) * 32 + fq * 8); const f32x4 a = p[0], b = p[1];
            float s = ((a[0] + a[1]) + (a[2] + a[3])) + ((b[0] + b[1]) + (b[2] + b[3])); s += shx(s, lane, 16); s += shx(s, lane, 32);
            rs[ai][m] = __builtin_amdgcn_rsqf(s * inv_n + eps); }
}
struct EpiSwiGLU {
    static constexpr bool PERM = true, AFTER_DRAIN = false;
    bf16_t* O; int ldc; const float* ssq; float inv_n, eps; const PG8_LAS float* tab; int tab_pm;
    __device__ __forceinline__ void operator()(const f32x4 (&acc)[2][2][4][2], const Unit& u, int wr, int wc, int fr, int fq) const {
        const int row0 = u.pm * BM + wr * 64 + fr; const int col0 = u.pn * HALF + wc * 32 + 8 * fq;
        float rs[2][4]; row_rstd(rs, ssq, row0, fq, inv_n, eps, tab, tab_pm, u.pm);
#pragma unroll
        for (int ai = 0; ai < 2; ++ai)
#pragma unroll
            for (int m = 0; m < 4; ++m) { bf16_t* rowp = O + toff(row0 + ai * HALF + m * 16, col0, ldc >> 6);
                const float r = rs[ai][m]; const f32x2 c1 = {-1.4426950408889634f * r, -1.4426950408889634f * r}, r2 = {r * r, r * r};
                unsigned wv[4];
#pragma unroll
                for (int n = 0; n < 2; ++n)
#pragma unroll
                    for (int e = 0; e < 4; e += 2) { const f32x2 g = {acc[ai][0][m][n][e], acc[ai][0][m][n][e + 1]}, up = {acc[ai][1][m][n][e], acc[ai][1][m][n][e + 1]};
                        const f32x2 t = g * c1; f32x2 d; d.x = __builtin_amdgcn_exp2f(t.x); d.y = __builtin_amdgcn_exp2f(t.y); d = d + 1.0f;
                        f32x2 rc; rc.x = __builtin_amdgcn_rcpf(d.x); rc.y = __builtin_amdgcn_rcpf(d.y);
                        const f32x2 hv = ((g * up) * r2) * rc; wv[n * 2 + (e >> 1)] = cvt_pk_bf16(hv.x, hv.y); }
                u32x4 w; w.x = wv[0]; w.y = wv[1]; w.z = wv[2]; w.w = wv[3];
                *(u32x4*)rowp = w; }
    }
};
struct EpiProj {
    static constexpr bool PERM = true, AFTER_DRAIN = false;
    bf16_t* O; int ldc; const float* ssq; float inv_n, eps; int qcols; float qscale; const PG8_LAS float* tab; int tab_pm;
    __device__ __forceinline__ void operator()(const f32x4 (&acc)[2][2][4][2], const Unit& u, int wr, int wc, int fr, int fq) const {
        const int row0 = u.pm * BM + wr * 64 + fr; const int col0 = u.pn * BM + wc * 32 + 8 * fq;
        float rs[2][4]; row_rstd(rs, ssq, row0, fq, inv_n, eps, tab, tab_pm, u.pm);
        const float cs = (u.pn * BM < qcols) ? qscale : 1.0f;
#pragma unroll
        for (int ai = 0; ai < 2; ++ai)
#pragma unroll
            for (int m = 0; m < 4; ++m) { bf16_t* rowp = O + (size_t)(row0 + ai * HALF + m * 16) * ldc + col0; const float r = rs[ai][m] * cs;
#pragma unroll
                for (int bj = 0; bj < 2; ++bj) { const f32x4 v0 = acc[ai][bj][m][0] * r, v1 = acc[ai][bj][m][1] * r;
                    u32x4 w; w.x = cvt_pk_bf16(v0[0], v0[1]); w.y = cvt_pk_bf16(v0[2], v0[3]); w.z = cvt_pk_bf16(v1[0], v1[1]); w.w = cvt_pk_bf16(v1[2], v1[3]);
                    *(u32x4*)(rowp + bj * HALF) = w; } }
    }
};
struct EpiResidual {
    static constexpr bool PERM = true, AFTER_DRAIN = false;
    bf16_t* xb; float* ssq; int ldc; float alpha;
    __device__ __forceinline__ void operator()(const f32x4 (&acc)[2][2][4][2], const Unit& u, int wr, int wc, int fr, int fq) const {
        const int row0 = u.pm * BM + wr * 64 + fr; const int col0 = u.pn * BM + wc * 32 + 8 * fq;
#pragma unroll
        for (int ai = 0; ai < 2; ++ai) {
            u32x4 bs[4][2];
#pragma unroll
            for (int m = 0; m < 4; ++m) {
#pragma unroll
                for (int bj = 0; bj < 2; ++bj) bs[m][bj] = *(const u32x4*)(xb + toff(row0 + ai * HALF + m * 16, col0 + bj * HALF, ldc >> 6)); }
            asm volatile("" ::: "memory");
#pragma unroll
            for (int m = 0; m < 4; ++m) { const int row = row0 + ai * HALF + m * 16; float ss = 0.f;
#pragma unroll
                for (int bj = 0; bj < 2; ++bj) { const u32x4 b = bs[m][bj];
                    const f32x4 b0 = {__builtin_bit_cast(float, b.x << 16), __builtin_bit_cast(float, b.x & 0xffff0000u), __builtin_bit_cast(float, b.y << 16), __builtin_bit_cast(float, b.y & 0xffff0000u)};
                    const f32x4 b1 = {__builtin_bit_cast(float, b.z << 16), __builtin_bit_cast(float, b.z & 0xffff0000u), __builtin_bit_cast(float, b.w << 16), __builtin_bit_cast(float, b.w & 0xffff0000u)};
                    const f32x4 o0 = b0 + acc[ai][bj][m][0] * alpha, o1 = b1 + acc[ai][bj][m][1] * alpha;
                    ss += (o0[0] * o0[0] + o0[1] * o0[1]) + (o0[2] * o0[2] + o0[3] * o0[3]) + (o1[0] * o1[0] + o1[1] * o1[1]) + (o1[2] * o1[2] + o1[3] * o1[3]);
                    u32x4 w; w.x = cvt_pk_bf16(o0[0], o0[1]); w.y = cvt_pk_bf16(o0[2], o0[3]); w.z = cvt_pk_bf16(o1[0], o1[1]); w.w = cvt_pk_bf16(o1[2], o1[3]);
                    *(u32x4*)(xb + toff(row, col0 + bj * HALF, ldc >> 6)) = w; }
                ss += shx(ss, fr + 16 * fq, 16); ss += shx(ss, fr + 16 * fq, 32);
                if (fq == 0) ssq[(size_t)row * 32 + u.pn * 4 + wc] = ss; }
            asm volatile("" ::: "memory");
        }
    }
};

template <class Epi, class Sched, bool ALIGN_EPI = false, bool SP2 = false>
__device__ __forceinline__ void gemm_phase(PG8_LAS unsigned char* lds, const Gemm g, const Sched& S, const Epi& E) {
    int tid_o = threadIdx.x; asm volatile("" : "+v"(tid_o));
    const int tid = tid_o, wid = __builtin_amdgcn_readfirstlane(tid >> 6), lane = tid & 63, wr = wid >> 2, wc = wid & 3, fr = lane & 15, fq = lane >> 4;
    const int K = g.K, nt = K / BK;
    unsigned voffA[2], voffB[2];
#pragma unroll
    for (int i = 0; i < 2; ++i) { int R, C; stage_rc(tid * 16 + i * 8192, R, C); const int Rb = Epi::PERM ? ((R & ~31) + perm32(R & 31)) : R;
        voffA[i] = (unsigned)(R * BK + C) * 2u; voffB[i] = (unsigned)(Rb * BK + C) * 2u; }
    const size_t kstep = (size_t)(BK * 2), kstepB = (size_t)BM * BK * 2;
    const size_t hstep = (size_t)HALF * K * 2, hstepB = (size_t)HALF * BK * 2;
    const size_t tstep = 2 * hstep;
    const unsigned ldsw = (unsigned)wid * 1024u;
    const int aoff = lds_byte(wr * 64 + fr, fq * 8), boff = lds_byte(wc * 32 + fr, fq * 8);
#define PG8_SA(b, h) (((b) * 2 + (h)) * HTB)
#define PG8_SB(b, h) ((4 + (b) * 2 + (h)) * HTB)
#define PG8_STAGE(bufoff, gbase, voff) do { _Pragma("unroll") for (int _i = 0; _i < 2; ++_i) \
        __builtin_amdgcn_global_load_lds((const unsigned*)((const char*)(gbase) + (voff)[_i]), (PG8_LAS unsigned*)(lds + (bufoff) + ldsw + _i * 8192), 16, 0, 0); } while (0)
#define PG8_LDA(dst, b, h) do { _Pragma("unroll") for (int m = 0; m < 4; ++m) _Pragma("unroll") for (int k = 0; k < 2; ++k) dst[m][k] = *(const PG8_LAS bf16x8*)(lds + PG8_SA(b, h) + aoff + m * 2048 + k * 1024); } while (0)
#define PG8_LDB(dst, b, h) do { _Pragma("unroll") for (int n = 0; n < 2; ++n) _Pragma("unroll") for (int k = 0; k < 2; ++k) dst[n][k] = *(const PG8_LAS bf16x8*)(lds + PG8_SB(b, h) + boff + n * 2048 + k * 1024); } while (0)
#define PG8_MMA(ai, bj, At, Bt) do { __builtin_amdgcn_s_setprio(1); _Pragma("unroll") for (int m = 0; m < 4; ++m) _Pragma("unroll") for (int n = 0; n < 2; ++n) _Pragma("unroll") for (int k = 0; k < 2; ++k) \
        acc[ai][bj][m][n] = __builtin_amdgcn_mfma_f32_16x16x32_bf16(Bt[n][k], At[m][k], acc[ai][bj][m][n], 0, 0, 0); __builtin_amdgcn_s_setprio(0); } while (0)
#define PG8_WAIT_V(n) asm volatile("s_waitcnt vmcnt(" #n ")" ::: "memory")
#define PG8_WAIT_L(n) asm volatile("s_waitcnt lgkmcnt(" #n ")" ::: "memory")
#define PG8_BAR __builtin_amdgcn_s_barrier()
#define PG8_SCHED __builtin_amdgcn_sched_barrier(0)
    Unit cur, nxt; int ui = 0;
    if (!S.next(0, cur)) return;
    f32x4 acc[2][2][4][2];
#pragma unroll
    for (int a = 0; a < 2; ++a)
#pragma unroll
        for (int b = 0; b < 2; ++b)
#pragma unroll
            for (int m = 0; m < 4; ++m)
#pragma unroll
                for (int n = 0; n < 2; ++n) acc[a][b][m][n] = (f32x4){0.f, 0.f, 0.f, 0.f};
    bf16x8 At[4][2], B0[2][2], B1[2][2];
    const char* cA = (const char*)g.A + (size_t)cur.pm * tstep; const char* cB = (const char*)g.Bt + (size_t)cur.pn * tstep;
    S.a_ready(cur);
    if constexpr (SP2) {
        PG8_STAGE(PG8_SB(0, 0), cB, voffB); PG8_STAGE(PG8_SB(0, 1), cB + hstepB, voffB); PG8_STAGE(PG8_SA(0, 0), cA, voffA); PG8_STAGE(PG8_SA(0, 1), cA + hstepB, voffA);
        if (wr == 1) PG8_BAR;
        PG8_WAIT_V(2); PG8_BAR;
        PG8_STAGE(PG8_SB(1, 0), cB + kstepB, voffB); PG8_STAGE(PG8_SA(1, 0), cA + kstepB, voffA); PG8_STAGE(PG8_SB(1, 1), cB + hstepB + kstepB, voffB);
        PG8_WAIT_V(6); PG8_BAR;
    } else {
        PG8_STAGE(PG8_SB(0, 0), cB, voffB); PG8_STAGE(PG8_SA(0, 0), cA, voffA); PG8_STAGE(PG8_SB(0, 1), cB + hstepB, voffB); PG8_STAGE(PG8_SA(0, 1), cA + hstepB, voffA);
        if (wr == 1) PG8_BAR;
        PG8_WAIT_V(4); PG8_BAR;
        PG8_STAGE(PG8_SB(1, 0), cB + kstepB, voffB); PG8_STAGE(PG8_SA(1, 0), cA + kstepB, voffA); PG8_STAGE(PG8_SB(1, 1), cB + hstepB + kstepB, voffB);
        PG8_WAIT_V(6); PG8_BAR;
    }
    for (;;) {
        const bool has_next = S.next(ui + 1, nxt);
        const char* nA = has_next ? (const char*)g.A + (size_t)nxt.pm * tstep : cA; const char* nB = has_next ? (const char*)g.Bt + (size_t)nxt.pn * tstep : cB;
        for (int t = 0; t < nt; t += 2) {
            const bool last = (t == nt - 2);
            const char* a1 = cA + (size_t)(t + 1) * kstepB;
            const char* a2 = last ? nA : cA + (size_t)(t + 2) * kstepB; const char* b2 = last ? nB : cB + (size_t)(t + 2) * kstepB;
            const char* a3 = a2 + kstepB; const char* b3 = b2 + kstepB;
            if (last && has_next) S.a_ready(nxt);
            if constexpr (SP2) {
            PG8_LDB(B0, 0, 0); PG8_LDB(B1, 0, 1); PG8_SCHED; PG8_LDA(At, 0, 0); PG8_STAGE(PG8_SA(1, 1), a1 + hstepB, voffA);
            PG8_WAIT_V(8); PG8_WAIT_L(0); PG8_BAR; PG8_MMA(0, 0, At, B0); PG8_MMA(0, 1, At, B1); PG8_BAR; PG8_SCHED;
            PG8_LDA(At, 0, 1); PG8_STAGE(PG8_SB(0, 0), b2, voffB); PG8_STAGE(PG8_SB(0, 1), b2 + hstepB, voffB); PG8_STAGE(PG8_SA(0, 0), a2, voffA);
            PG8_WAIT_V(8); PG8_WAIT_L(0); PG8_BAR; PG8_MMA(1, 0, At, B0); PG8_MMA(1, 1, At, B1); PG8_BAR; PG8_SCHED;
            PG8_LDB(B0, 1, 0); PG8_LDB(B1, 1, 1); PG8_SCHED; PG8_LDA(At, 1, 0); PG8_STAGE(PG8_SA(0, 1), a2 + hstepB, voffA);
            PG8_WAIT_V(8); PG8_WAIT_L(0); PG8_BAR; PG8_MMA(0, 0, At, B0); PG8_MMA(0, 1, At, B1); PG8_BAR; PG8_SCHED;
            PG8_LDA(At, 1, 1); PG8_STAGE(PG8_SB(1, 0), b3, voffB); PG8_STAGE(PG8_SB(1, 1), b3 + hstepB, voffB); PG8_STAGE(PG8_SA(1, 0), a3, voffA);
            PG8_WAIT_V(8); PG8_WAIT_L(0); PG8_BAR; PG8_MMA(1, 0, At, B0); PG8_MMA(1, 1, At, B1); PG8_BAR; PG8_SCHED;
            } else {
            PG8_LDB(B0, 0, 0); PG8_SCHED; PG8_LDA(At, 0, 0); PG8_STAGE(PG8_SA(1, 1), a1 + hstepB, voffA);
            PG8_WAIT_L(8); PG8_BAR; PG8_WAIT_L(0); PG8_MMA(0, 0, At, B0); PG8_BAR; PG8_SCHED;
            PG8_LDB(B1, 0, 1); PG8_STAGE(PG8_SB(0, 0), b2, voffB);
            PG8_BAR; PG8_WAIT_L(0); PG8_MMA(0, 1, At, B1); PG8_BAR;
            PG8_LDA(At, 0, 1); PG8_STAGE(PG8_SA(0, 0), a2, voffA);
            PG8_BAR; PG8_WAIT_L(0); PG8_MMA(1, 0, At, B0); PG8_BAR; PG8_SCHED;
            PG8_STAGE(PG8_SB(0, 1), b2 + hstepB, voffB);
            PG8_WAIT_V(6); PG8_BAR; PG8_MMA(1, 1, At, B1); PG8_BAR;
            PG8_LDB(B0, 1, 0); PG8_SCHED; PG8_LDA(At, 1, 0); PG8_STAGE(PG8_SA(0, 1), a2 + hstepB, voffA);
            PG8_WAIT_L(8); PG8_BAR; PG8_WAIT_L(0); PG8_MMA(0, 0, At, B0); PG8_BAR; PG8_SCHED;
            PG8_LDB(B1, 1, 1); PG8_STAGE(PG8_SB(1, 0), b3, voffB);
            PG8_BAR; PG8_WAIT_L(0); PG8_MMA(0, 1, At, B1); PG8_BAR;
            PG8_LDA(At, 1, 1); PG8_STAGE(PG8_SA(1, 0), a3, voffA);
            PG8_BAR; PG8_WAIT_L(0); PG8_MMA(1, 0, At, B0); PG8_BAR; PG8_SCHED;
            PG8_STAGE(PG8_SB(1, 1), b3 + hstepB, voffB);
            PG8_WAIT_V(6); PG8_BAR; PG8_MMA(1, 1, At, B1); PG8_BAR;
            }
        }
        if constexpr (ALIGN_EPI) { if (wr == 0) PG8_BAR; }
        if constexpr (!Epi::AFTER_DRAIN) { E(acc, cur, wr, wc, fr, fq); S.done(cur); }
        if (!has_next) break;
#pragma unroll
        for (int a = 0; a < 2; ++a)
#pragma unroll
            for (int b = 0; b < 2; ++b)
#pragma unroll
                for (int m = 0; m < 4; ++m)
#pragma unroll
                    for (int n = 0; n < 2; ++n) acc[a][b][m][n] = (f32x4){0.f, 0.f, 0.f, 0.f};
        cur = nxt; cA = nA; cB = nB; ++ui;
        if constexpr (ALIGN_EPI) { if (wr == 1) PG8_BAR; }
    }
    PG8_WAIT_V(0);
    if constexpr (!ALIGN_EPI) { if (wr == 0) PG8_BAR; }
    PG8_BAR;
    if constexpr (Epi::AFTER_DRAIN) { E.fused(acc, cur, wr, wc, fr, fq, lds, wid, lane); S.done(cur); }
#undef PG8_SA
#undef PG8_SB
#undef PG8_STAGE
#undef PG8_LDA
#undef PG8_LDB
#undef PG8_MMA
#undef PG8_WAIT_V
#undef PG8_WAIT_L
#undef PG8_BAR
#undef PG8_SCHED
}
}
namespace attn_body {
using bf16=__hip_bfloat16;
using bf16x8=__attribute__((ext_vector_type(8)))short;
using s16x4=__attribute__((ext_vector_type(4)))short;
using f32x16=__attribute__((ext_vector_type(16)))float;
using u32x4=__attribute__((ext_vector_type(4)))unsigned;
constexpr int BATCH=2,SEQ=8192,D=64,PIN=7168,POUT=2048;
constexpr int NW=8,QBLK=32,QB=QBLK*NW,KVBLK=64,NQB=SEQ/QB;
constexpr int ATTN_UNIT_ROWS=QB;
__device__ __forceinline__ int crow(int r,int hi){return (r&3)+8*(r>>2)+4*hi;}
#define SBAR() __builtin_amdgcn_sched_barrier(0)
__device__ __forceinline__ void cmask(f32x16&p0,f32x16&p1,int jb,int qrel,int hi){
  const float NEG=-INFINITY; int kb=64*jb+4*hi;
  #pragma unroll
  for(int r=0;r<16;++r){int kv=kb+(r&3)+8*(r>>2); if(kv>qrel)p0[r]=NEG; if(kv+32>qrel)p1[r]=NEG;}
}

constexpr int NSLOT=3, SLOTB=8192;
constexpr int VSLOTB=2*SLOTB;
constexpr int LDS_K=0, LDS_V=NSLOT*SLOTB, LDS_WS=LDS_V+NSLOT*VSLOTB, LDS_OST=LDS_WS+NW*64*4, LDS_BYTES=LDS_OST+NW*4096;
constexpr float C2=0.125f*1.4426950408889634f;
__device__ __forceinline__ void glds16(const void*gsrc,unsigned lds_dst){unsigned keep;
  asm volatile("s_mov_b32 %0, m0\n\ts_mov_b32 m0, %2\n\ts_nop 0\n\tglobal_load_lds_dwordx4 %1, off\n\ts_mov_b32 m0, %0":"=&s"(keep):"v"(gsrc),"s"(lds_dst):"memory");}
__device__ __forceinline__ float max3f(float a,float b,float c){float r;asm("v_max3_f32 %0, %1, %2, %3":"=v"(r):"v"(a),"v"(b),"v"(c));return r;}
__device__ __forceinline__ float max2f(float a,float b){float r;asm("v_max_f32_e32 %0, %1, %2":"=v"(r):"v"(a),"v"(b));return r;}
__device__ __forceinline__ float fadd_s(float a,float b){float r;asm("v_add_f32_e32 %0, %1, %2":"=v"(r):"v"(a),"v"(b));return r;}
__device__ __forceinline__ float fsub_s(float a,float b){float r;asm("v_sub_f32_e32 %0, %1, %2":"=v"(r):"v"(a),"v"(b));return r;}
typedef float f32x2_t __attribute__((ext_vector_type(2))); typedef __bf16 bf16x2_t __attribute__((ext_vector_type(2)));
__device__ __forceinline__ unsigned cvtpk_s(float lo,float hi){f32x2_t v={lo,hi};bf16x2_t b=__builtin_convertvector(v,bf16x2_t);return __builtin_bit_cast(unsigned,b);}
#define WAIT_BAR(N) asm volatile("s_waitcnt vmcnt(" #N ") lgkmcnt(0)\n\ts_barrier":::"memory")

__device__ __forceinline__ void qkt(f32x16&p0,f32x16&p1,const char*Kslot,const bf16x8*qr,const f32x16&negm,int r32,int hi){
  const char*kb=Kslot+hi*1024+r32*16;
  #pragma unroll
  for(int d0=0;d0<4;++d0){
    const bf16x8 b0=*reinterpret_cast<const bf16x8*>(kb+d0*2048);
    const bf16x8 b1=*reinterpret_cast<const bf16x8*>(kb+d0*2048+512);
    if(d0==0){p0=__builtin_amdgcn_mfma_f32_32x32x16_bf16(b0,qr[0],negm,0,0,0);p1=__builtin_amdgcn_mfma_f32_32x32x16_bf16(b1,qr[0],negm,0,0,0);}
    else{p0=__builtin_amdgcn_mfma_f32_32x32x16_bf16(b0,qr[d0],p0,0,0,0);p1=__builtin_amdgcn_mfma_f32_32x32x16_bf16(b1,qr[d0],p1,0,0,0);}}
}
typedef __attribute__((address_space(3))) const char* lds_cptr;
typedef short v4i16_t __attribute__((ext_vector_type(4)));
__device__ __forceinline__ void kload8(bf16x8*kf,lds_cptr kp){
  kf[0]=*(const __attribute__((address_space(3))) bf16x8*)(kp);      kf[1]=*(const __attribute__((address_space(3))) bf16x8*)(kp+512);
  kf[2]=*(const __attribute__((address_space(3))) bf16x8*)(kp+2048); kf[3]=*(const __attribute__((address_space(3))) bf16x8*)(kp+2560);
  kf[4]=*(const __attribute__((address_space(3))) bf16x8*)(kp+4096); kf[5]=*(const __attribute__((address_space(3))) bf16x8*)(kp+4608);
  kf[6]=*(const __attribute__((address_space(3))) bf16x8*)(kp+6144); kf[7]=*(const __attribute__((address_space(3))) bf16x8*)(kp+6656);
}
__device__ __forceinline__ void kload2(bf16x8*kf,lds_cptr kp,int j){ kf[2*j]=*(const __attribute__((address_space(3))) bf16x8*)(kp+j*2048); kf[2*j+1]=*(const __attribute__((address_space(3))) bf16x8*)(kp+j*2048+512); }
__device__ __forceinline__ s16x4 vtr(lds_cptr p){ return __builtin_bit_cast(s16x4,__builtin_amdgcn_ds_read_tr16_b64_v4i16((__attribute__((address_space(3))) v4i16_t*)p)); }
__device__ __forceinline__ float rowmax(const f32x16&p0,const f32x16&p1){
  float a=max3f(p0[0],p0[1],p1[0]),b=max3f(p0[2],p0[3],p1[1]);a=max3f(a,p1[2],p1[3]);
  #pragma unroll
  for(int r=4;r<16;r+=4){a=max3f(a,p0[r],p0[r+1]);b=max3f(b,p0[r+2],p0[r+3]);a=max3f(a,p1[r],p1[r+1]);b=max3f(b,p1[r+2],p1[r+3]);}
  const float m=max2f(a,b);
  auto rr=__builtin_amdgcn_permlane32_swap(__float_as_uint(m),__float_as_uint(m),false,false);
  return max2f(__uint_as_float(rr[0]),__uint_as_float(rr[1]));
}
__device__ __forceinline__ void pv(f32x16*o,int vb,bf16x8 pa0,bf16x8 pa1,bf16x8 pa2,bf16x8 pa3){
  #pragma unroll
  for(int d0=0;d0<2;++d0){s16x4 lo[4],hi[4];
    #pragma unroll
    for(int ks=0;ks<4;++ks){
      asm volatile("ds_read_b64_tr_b16 %0,%1 offset:%c2":"=&v"(lo[ks]):"v"(vb),"i"(d0*4096+ks*1024):"memory");
      asm volatile("ds_read_b64_tr_b16 %0,%1 offset:%c2":"=&v"(hi[ks]):"v"(vb),"i"(d0*4096+ks*1024+512):"memory");}
    asm volatile("s_waitcnt lgkmcnt(0)":::"memory");SBAR();
    #define PK(k) (bf16x8){lo[k][0],lo[k][1],lo[k][2],lo[k][3],hi[k][0],hi[k][1],hi[k][2],hi[k][3]}
    o[d0]=__builtin_amdgcn_mfma_f32_32x32x16_bf16(pa0,PK(0),o[d0],0,0,0);
    o[d0]=__builtin_amdgcn_mfma_f32_32x32x16_bf16(pa1,PK(1),o[d0],0,0,0);
    o[d0]=__builtin_amdgcn_mfma_f32_32x32x16_bf16(pa2,PK(2),o[d0],0,0,0);
    o[d0]=__builtin_amdgcn_mfma_f32_32x32x16_bf16(pa3,PK(3),o[d0],0,0,0);
    #undef PK
  }
}

#ifndef ATTN_STORE16
#define ATTN_STORE16(p,v) (*(u32x4*)(p)=(v))
#endif
template<int THRL> __device__ __forceinline__ void attn_unit(int b,int qcol,int kcol,int vcol,int ocol,int qb,const bf16*__restrict__ P,bf16*__restrict__ O,char*shm){
  int tid_o=threadIdx.x; asm volatile("":"+v"(tid_o)); const int tid=tid_o,lane=tid&63,r32=lane&31,hi=lane>>5; const int wid=__builtin_amdgcn_readfirstlane(tid>>6);
  const long rowbase=(long)b*SEQ; const int q0=qb*QB;
  const bf16*Qw=P+(rowbase+q0+wid*QBLK)*PIN+qcol;
  const bf16*Kh=P+rowbase*PIN+kcol,*Vh=P+rowbase*PIN+vcol;
  const unsigned lds0=(unsigned)(uintptr_t)shm;
  float*wsf=(float*)(shm+LDS_WS)+wid*64;
  const bf16*ksrc=Kh+(long)lane*PIN+wid*8;
  const bf16*vsrc=Vh+(long)(16*(wid&3)+(lane>>2))*PIN+(wid>>2)*32+(lane&3)*8;
  const unsigned kdst=lds0+LDS_K+wid*1024, vdst=lds0+LDS_V+wid*1024;
  #define DMA_K(t,slot) glds16(ksrc+(long)(t)*KVBLK*PIN,(unsigned)__builtin_amdgcn_readfirstlane(kdst+(slot)))
  #define DMA_V(t,slot) do{ glds16(vsrc+(long)(t)*KVBLK*PIN,(unsigned)__builtin_amdgcn_readfirstlane(vdst+2*(slot))); glds16(vsrc+(long)(t)*KVBLK*PIN+64,(unsigned)__builtin_amdgcn_readfirstlane(vdst+2*(slot)+SLOTB)); }while(0)
  const int vb0=(int)(lds0+LDS_V)+((lane>>4)&1)*32+(lane&3)*8+(4*hi+((lane&15)>>2))*64;
  const char*Kbase=shm+LDS_K; bf16x8 kf[8];
  const lds_cptr shm3=(lds_cptr)shm; const lds_cptr kp0=shm3+LDS_K+hi*1024+r32*16; const lds_cptr vp0=shm3+LDS_V+((lane>>4)&1)*32+(lane&3)*8+(4*hi+((lane&15)>>2))*64;
  const int NT=(q0+QB)/KVBLK;
  DMA_K(0,0);DMA_V(0,0);DMA_K(1,SLOTB);
  bf16x8 qr[4];
  #pragma unroll
  for(int d0=0;d0<4;++d0)qr[d0]=*reinterpret_cast<const bf16x8*>(&Qw[(long)r32*PIN+d0*16+hi*8]);
  float mhat=0.f,l_reg=0.f;f32x16 o[4];o[0]=f32x16{};o[1]=f32x16{};o[2]=f32x16{};o[3]=f32x16{};f32x16 negm=f32x16{};asm volatile("":"+v"(negm));
  const int qrel=wid*QBLK+r32;
  #define CMASK(P0,P1,t) do{int jb_=(t)-(NT-4); if(jb_>=0)cmask(P0,P1,jb_,qrel,hi);}while(0)
  bool resc=false;
  #define START(P0,P1) do{ const float rm=rowmax(P0,P1); resc=false; \
    { const float dl=rm; mhat=fadd_s(mhat,dl); \
      _Pragma("unroll") for(int r=0;r<16;++r){P0[r]=fsub_s(P0[r],dl);P1[r]=fsub_s(P1[r],dl);} \
      _Pragma("unroll") for(int r=0;r<16;++r)negm[r]=-mhat; asm volatile("":"+v"(negm)); } \
    _Pragma("unroll") for(int r=0;r<16;++r)P0[r]=__builtin_amdgcn_exp2f(P0[r]); }while(0)
  #define RESC() do{ if(resc){ asm volatile("s_waitcnt lgkmcnt(0)":::"memory"); \
      _Pragma("unroll") for(int d_=0;d_<4;++d_) _Pragma("unroll") for(int r=0;r<16;++r)o[d_][r]*=wsf[crow(r,hi)]; } }while(0)
  f32x16 pA0,pA1,pB0,pB1;
  int sl_prev=0,sl_cur=0,sl_next=SLOTB;
  #define ROT() do{sl_prev=sl_cur;sl_cur=sl_next;sl_next=(sl_next==(NSLOT-1)*SLOTB)?0:sl_next+SLOTB;}while(0)
  DMA_K(2,2*SLOTB);
  WAIT_BAR(4);
  qkt(pA0,pA1,Kbase,qr,negm,r32,hi);asm volatile("s_nop 15\n\ts_nop 7":"+v"(pA0),"+v"(pA1));CMASK(pA0,pA1,0);
  START(pA0,pA1);
  _Pragma("unroll") for(int r=0;r<16;++r)pA1[r]=__builtin_amdgcn_exp2f(pA1[r]);
  WAIT_BAR(0);
  DMA_K(3,0);DMA_V(1,SLOTB);
  ROT();
  kload8(kf,kp0+sl_cur);
  WAIT_BAR(3);
  s16x4 vlo[8],vhi[8]; u32x4 pw0,pw1,pw2,pw3;
  #define PKW(P,B) cvtpk_s(P[B],P[B+1])
  #define PAF(k) __builtin_bit_cast(bf16x8,pw##k)
  #define VFR(i) (bf16x8){vlo[i][0],vlo[i][1],vlo[i][2],vlo[i][3],vhi[i][0],vhi[i][1],vhi[i][2],vhi[i][3]}
  #define PIN(x) asm volatile("":"+v"(x))
  #define MX3(a,b,c) __builtin_fmaxf(__builtin_fmaxf((a),(b)),(c))
  #define GAPA(MF,A0,A1,A2,A3,W0,W1,PW) do{ MF; sacc+=A0; sacc+=A1; sacc+=A2; sacc+=A3; PIN(sacc); W0; W1; PIN(PW); SBAR(); }while(0)
  #define EX(v) __builtin_amdgcn_exp2f(v)
  #define GAPB(MF,X,B) do{ MF; X[B]=EX(X[B]); X[B+1]=EX(X[B+1]); X[B+2]=EX(X[B+2]); X[B+3]=EX(X[B+3]); PIN(X); SBAR(); }while(0)
  #define VRD(i) do{ vlo[i]=vtr(vp_+(((i)>>2)*4096+((i)&3)*1024)); vhi[i]=vtr(vp_+(((i)>>2)*4096+((i)&3)*1024+512)); }while(0)
  #define VRD2(i) do{ vlo[i]=vtr(vp_+(SLOTB+((i)>>2)*4096+((i)&3)*1024)); vhi[i]=vtr(vp_+(SLOTB+((i)>>2)*4096+((i)&3)*1024+512)); SBAR(); }while(0)
  #define GAPB2(MF,X,B) do{ MF; X[B]=EX(X[B]); X[B+1]=EX(X[B+1]); PIN(X); SBAR(); }while(0)
  #define KRD(G,j) do{ if(G){ kload2(kf,kp0+sl_next,j); SBAR(); } }while(0)
  #define STEP(C0,C1,P0,P1,t,GK,GV,GL) do{ SBAR(); \
    const lds_cptr vp_=vp0+2*sl_prev; \
    VRD(0); SBAR(); float sacc=(P0[0]+P0[1]); \
    GAPA(C0=__builtin_amdgcn_mfma_f32_32x32x16_bf16(kf[0],qr[0],negm,0,0,0), P0[2],P0[3],P0[4],P0[5],     pw0[0]=PKW(P0,0), pw0[1]=PKW(P0,2), pw0); \
    VRD(4); SBAR(); GAPA(C1=__builtin_amdgcn_mfma_f32_32x32x16_bf16(kf[1],qr[0],negm,0,0,0), P0[6],P0[7],P0[8],P0[9],     pw0[2]=PKW(P0,4), pw0[3]=PKW(P0,6), pw0); \
    VRD(1); SBAR(); GAPA(C0=__builtin_amdgcn_mfma_f32_32x32x16_bf16(kf[2],qr[1],C0,0,0,0),   P0[10],P0[11],P0[12],P0[13], pw1[0]=PKW(P0,8), pw1[1]=PKW(P0,10), pw1); \
    VRD(5); SBAR(); GAPA(C1=__builtin_amdgcn_mfma_f32_32x32x16_bf16(kf[3],qr[1],C1,0,0,0),   P0[14],P0[15],P1[0],P1[1],   pw1[2]=PKW(P0,12),pw1[3]=PKW(P0,14), pw1); \
    VRD(2); SBAR(); GAPA(C0=__builtin_amdgcn_mfma_f32_32x32x16_bf16(kf[4],qr[2],C0,0,0,0),   P1[2],P1[3],P1[4],P1[5],     pw2[0]=PKW(P1,0), pw2[1]=PKW(P1,2), pw2); \
    VRD(6); SBAR(); GAPA(C1=__builtin_amdgcn_mfma_f32_32x32x16_bf16(kf[5],qr[2],C1,0,0,0),   P1[6],P1[7],P1[8],P1[9],     pw2[2]=PKW(P1,4), pw2[3]=PKW(P1,6), pw2); \
    VRD(3); SBAR(); GAPA(C0=__builtin_amdgcn_mfma_f32_32x32x16_bf16(kf[6],qr[3],C0,0,0,0),   P1[10],P1[11],P1[12],P1[13], pw3[0]=PKW(P1,8), pw3[1]=PKW(P1,10), pw3); \
    VRD(7); SBAR(); GAPA(C1=__builtin_amdgcn_mfma_f32_32x32x16_bf16(kf[7],qr[3],C1,0,0,0),   P1[14],P1[15],0.f,0.f,       pw3[2]=PKW(P1,12),pw3[3]=PKW(P1,14), pw3); \
    l_reg+=sacc; \
    if(GK){DMA_K((t)+3,sl_cur);} if(GV){DMA_V((t)+1,sl_next);} \
    CMASK(C0,C1,t); \
    { float a=MX3(C0[0],C0[1],C1[0]),b=MX3(C0[2],C0[3],C1[1]); a=MX3(a,C1[2],C1[3]); \
      _Pragma("unroll") for(int r=4;r<16;r+=4){a=MX3(a,C0[r],C0[r+1]);b=MX3(b,C0[r+2],C0[r+3]);a=MX3(a,C1[r],C1[r+1]);b=MX3(b,C1[r+2],C1[r+3]);} \
      float rm=__builtin_fmaxf(a,b); { auto rr=__builtin_amdgcn_permlane32_swap(__float_as_uint(rm),__float_as_uint(rm),false,false); rm=__builtin_fmaxf(__uint_as_float(rr[0]),__uint_as_float(rr[1])); } \
      resc=false; \
      if(__builtin_expect(__any(rm>(float)THRL),0)){ const float dl=__builtin_fmaxf(rm,0.f); mhat+=dl; \
        _Pragma("unroll") for(int r=0;r<16;++r){C0[r]-=dl;C1[r]-=dl;} \
        _Pragma("unroll") for(int r=0;r<16;++r)negm[r]=-mhat; asm volatile("":"+v"(negm)); \
        const float f=__builtin_amdgcn_exp2f(-dl); l_reg*=f; if(hi==0)wsf[r32]=f; resc=true; } } \
    SBAR(); \
    GAPB2(o[0]=__builtin_amdgcn_mfma_f32_32x32x16_bf16(PAF(0),VFR(0),o[0],0,0,0), C0,0); VRD2(0); \
    GAPB2(o[1]=__builtin_amdgcn_mfma_f32_32x32x16_bf16(PAF(0),VFR(4),o[1],0,0,0), C0,2); VRD2(4); \
    KRD(GL,0); GAPB2(o[0]=__builtin_amdgcn_mfma_f32_32x32x16_bf16(PAF(1),VFR(1),o[0],0,0,0), C0,4); VRD2(1); \
    KRD(GL,1); GAPB2(o[1]=__builtin_amdgcn_mfma_f32_32x32x16_bf16(PAF(1),VFR(5),o[1],0,0,0), C0,6); VRD2(5); \
    KRD(GL,2); GAPB2(o[0]=__builtin_amdgcn_mfma_f32_32x32x16_bf16(PAF(2),VFR(2),o[0],0,0,0), C0,8); VRD2(2); \
    KRD(GL,3); GAPB2(o[1]=__builtin_amdgcn_mfma_f32_32x32x16_bf16(PAF(2),VFR(6),o[1],0,0,0), C0,10); VRD2(6); \
    GAPB2(o[0]=__builtin_amdgcn_mfma_f32_32x32x16_bf16(PAF(3),VFR(3),o[0],0,0,0), C0,12); VRD2(3); \
    GAPB2(o[1]=__builtin_amdgcn_mfma_f32_32x32x16_bf16(PAF(3),VFR(7),o[1],0,0,0), C0,14); VRD2(7); \
    GAPB2(o[2]=__builtin_amdgcn_mfma_f32_32x32x16_bf16(PAF(0),VFR(0),o[2],0,0,0), C1,0); \
    GAPB2(o[3]=__builtin_amdgcn_mfma_f32_32x32x16_bf16(PAF(0),VFR(4),o[3],0,0,0), C1,2); \
    GAPB2(o[2]=__builtin_amdgcn_mfma_f32_32x32x16_bf16(PAF(1),VFR(1),o[2],0,0,0), C1,4); \
    GAPB2(o[3]=__builtin_amdgcn_mfma_f32_32x32x16_bf16(PAF(1),VFR(5),o[3],0,0,0), C1,6); \
    GAPB2(o[2]=__builtin_amdgcn_mfma_f32_32x32x16_bf16(PAF(2),VFR(2),o[2],0,0,0), C1,8); \
    GAPB2(o[3]=__builtin_amdgcn_mfma_f32_32x32x16_bf16(PAF(2),VFR(6),o[3],0,0,0), C1,10); \
    GAPB2(o[2]=__builtin_amdgcn_mfma_f32_32x32x16_bf16(PAF(3),VFR(3),o[2],0,0,0), C1,12); \
    GAPB2(o[3]=__builtin_amdgcn_mfma_f32_32x32x16_bf16(PAF(3),VFR(7),o[3],0,0,0), C1,14); \
    }while(0)
  int t=1;
  #undef CMASK
  #define CMASK(P0,P1,t) do{}while(0)
  for(;t+5<NT;t+=2){
    STEP(pB0,pB1,pA0,pA1,t,true,true,true);     WAIT_BAR(3); RESC(); ROT();
    STEP(pA0,pA1,pB0,pB1,t+1,true,true,true);   WAIT_BAR(3); RESC(); ROT();
  }
  #undef CMASK
  #define CMASK(P0,P1,t) do{int jb_=(t)-(NT-4); if(jb_>=0)cmask(P0,P1,jb_,qrel,hi);}while(0)
  #define ENDW(tt) do{ if((tt)+3<NT){WAIT_BAR(3);} else if((tt)+2<NT){WAIT_BAR(2);} else {WAIT_BAR(0);} }while(0)
  for(;t+1<NT;t+=2){
    STEP(pB0,pB1,pA0,pA1,t,(t+3<NT),(t+1<NT),(t+1<NT));       ENDW(t);   RESC(); ROT();
    STEP(pA0,pA1,pB0,pB1,t+1,(t+4<NT),(t+2<NT),(t+2<NT));     ENDW(t+1); RESC(); ROT();
  }
  STEP(pB0,pB1,pA0,pA1,NT-1,false,false,false); RESC();
  { float sacc=pB0[0]+pB0[1]; _Pragma("unroll") for(int r=2;r<16;++r)sacc+=pB0[r]; _Pragma("unroll") for(int r=0;r<16;++r)sacc+=pB1[r]; l_reg+=sacc;
    pw0=(u32x4){PKW(pB0,0),PKW(pB0,2),PKW(pB0,4),PKW(pB0,6)};pw1=(u32x4){PKW(pB0,8),PKW(pB0,10),PKW(pB0,12),PKW(pB0,14)};pw2=(u32x4){PKW(pB1,0),PKW(pB1,2),PKW(pB1,4),PKW(pB1,6)};pw3=(u32x4){PKW(pB1,8),PKW(pB1,10),PKW(pB1,12),PKW(pB1,14)};
    SBAR(); pv(o,vb0+2*sl_cur,PAF(0),PAF(1),PAF(2),PAF(3)); pv(o+2,vb0+2*sl_cur+SLOTB,PAF(0),PAF(1),PAF(2),PAF(3)); }
  #undef PKW
  #undef PAF
  #undef VFR
  #undef PIN
  #undef MX3
  #undef GAPA
  #undef GAPB
  #undef EX
  #undef VRD
  #undef VRD2
  #undef GAPB2
  #undef KRD
  #undef STEP
  #undef ENDW
  {auto rr=__builtin_amdgcn_permlane32_swap(__float_as_uint(l_reg),__float_as_uint(l_reg),false,false);l_reg=__uint_as_float(rr[0])+__uint_as_float(rr[1]);}
  if(hi==0)wsf[32+r32]=l_reg;asm volatile("s_waitcnt lgkmcnt(0)":::"memory");
  float rli[16];
  #pragma unroll
  for(int r=0;r<16;++r)rli[r]=__builtin_amdgcn_rcpf(wsf[32+crow(r,hi)]);
  bf16*Ow=O+(rowbase+q0+wid*QBLK)*POUT+ocol;
  { bf16*stg=(bf16*)(shm+LDS_OST)+wid*2048;
    #pragma unroll
    for(int vh=0;vh<2;++vh){
    #pragma unroll
    for(int r=0;r<16;++r){const int orow=crow(r,hi);
      #pragma unroll
      for(int d0=0;d0<2;++d0)stg[orow*64+d0*32+r32]=__float2bfloat16(o[2*vh+d0][r]*rli[r]);}
    asm volatile("s_waitcnt lgkmcnt(0)":::"memory");
    #pragma unroll
    for(int i=0;i<4;++i){const int row=i*8+(lane>>3),ch=lane&7; const u32x4 v=*(const u32x4*)(stg+row*64+ch*8); ATTN_STORE16(Ow+(long)row*POUT+vh*64+ch*8,v);}
    asm volatile("s_waitcnt lgkmcnt(0)":::"memory"); } }
  asm volatile("s_waitcnt lgkmcnt(0)\n\ts_barrier":::"memory");
  #undef DMA_K
  #undef DMA_V
  #undef CMASK
  #undef START
  #undef RESC
  #undef ROT
}
constexpr int ATTN_LDS_BYTES=LDS_BYTES;
#undef SBAR
#undef WAIT_BAR
}
#define GAS __attribute__((address_space(1)))
#define LAS __attribute__((address_space(3)))
typedef unsigned short bf16;
typedef unsigned v4u __attribute__((ext_vector_type(4)));
typedef unsigned v2u __attribute__((ext_vector_type(2)));
typedef float f32x4 __attribute__((ext_vector_type(4)));
typedef short bf16x8 __attribute__((ext_vector_type(8)));
#define LDS_WAIT() asm volatile("s_waitcnt lgkmcnt(0)" ::: "memory")

#ifndef HGRN_NAIVE
#define HGRN_NAIVE 0
#endif
constexpr int NWAVES = 8, NTHREADS = 512;
constexpr int BATCH = 2, SEQ = 8192, DM = 2048, M = BATCH * SEQ, DFF = 5632, INW = 7168, AW = 1024, HW = 1024, NH = 8;
constexpr int C_QA = 0, C_KA = 1024, C_VA = 2048, C_QH = 3072, C_FH = 4096, C_IH = 5120, C_GH = 6144;
constexpr float NORM_EPS = 1e-6f, SUBLN_EPS = 1e-5f;
constexpr int LDS_BYTES = 147456, RING_BYTES = 131072;

constexpr size_t SZ_WGU = (size_t)2 * DFF * DM * 2, SZ_WD = (size_t)DM * DFF * 2, SZ_WIN = (size_t)INW * DM * 2, SZ_WOUT = (size_t)DM * DM * 2;
constexpr size_t WS_WGU1 = 0, WS_WD1 = WS_WGU1 + SZ_WGU, WS_WIN = WS_WD1 + SZ_WD, WS_WOUT = WS_WIN + SZ_WIN, WS_WGU2 = WS_WOUT + SZ_WOUT, WS_WD2 = WS_WGU2 + SZ_WGU;
constexpr size_t WS_XN = WS_WD2 + SZ_WD;
constexpr size_t WS_MIX = WS_XN + (size_t)M * DM * 2;
constexpr size_t WS_BIG = WS_MIX + (size_t)M * DM * 2;
constexpr size_t WS_ATTO = WS_BIG + (size_t)M * INW * 2;
constexpr size_t WS_ST = WS_ATTO + (size_t)M * DM * 2;
constexpr size_t WS_DEC = WS_ST + (size_t)2048 * 128 * 128 * 2;
constexpr size_t WS_BAR = WS_DEC + (size_t)2048 * 128 * 4;
constexpr size_t WS_SSQ = WS_BAR + 16384;
constexpr size_t WS_END = WS_SSQ + (size_t)7 * M * 32 * 4;

__device__ __forceinline__ unsigned pk2(float lo, float hi) { typedef float f2_t __attribute__((ext_vector_type(2))); typedef __bf16 b2_t __attribute__((ext_vector_type(2))); const f2_t v = {lo, hi}; return __builtin_bit_cast(unsigned, __builtin_convertvector(v, b2_t)); }
__device__ __forceinline__ unsigned f2bf(float f) { return pk2(f, f) & 0xffffu; }
__device__ __forceinline__ float bf2f(unsigned short b) { return __builtin_bit_cast(float, (unsigned)b << 16); }
using pg8::shx;
__device__ __forceinline__ float wave_sum(float v, int lane) {
#pragma unroll
    for (int o = 1; o < 64; o <<= 1) v += shx(v, lane, o);
    return v;
}

#define RLX_AGENT __ATOMIC_RELAXED, __HIP_MEMORY_SCOPE_AGENT
#define XB_TMO      128
#define XB_XCNT(j)  (256  + 64 * (j))
#define XB_XSUB(j)  (1280 + 64 * (j))
#define XB_XGEN(j)  (2304 + 64 * (j))
#define XB_TOP      3328
#define XB_TOPGEN   3392
#define XCD_BAR_WORDS 3456
#define XB_SPIN_CAP (1u << 18)

__device__ __forceinline__ unsigned xb_ld(unsigned* p)              { return __hip_atomic_load(p, __ATOMIC_RELAXED, __HIP_MEMORY_SCOPE_AGENT); }
__device__ __forceinline__ unsigned xb_add(unsigned* p, unsigned v) { return __hip_atomic_fetch_add(p, v, __ATOMIC_RELAXED, __HIP_MEMORY_SCOPE_AGENT); }
__device__ __forceinline__ unsigned xb_xcc_id() { return (unsigned)__builtin_amdgcn_s_getreg((3 << 11) | 20) & 0xFu; }
#define XB_SPIN(cond, bar) do { unsigned _sp = 0; while (cond) { __builtin_amdgcn_s_sleep(1); \
    if ((++_sp & 255u) == 0u) { if (xb_ld(&(bar)[XB_TMO])) break; if (_sp > XB_SPIN_CAP) { atomicAdd(&(bar)[XB_TMO], 1u); break; } } } } while (0)

struct XcdBarrier {
    unsigned* bar; unsigned x;
    volatile LAS unsigned* st;
};

__device__ __forceinline__ XcdBarrier xcd_barrier_post(unsigned* bar, volatile LAS unsigned* st) {
    XcdBarrier b; b.bar = bar; b.x = xb_xcc_id(); b.st = st;
    if (threadIdx.x == 0) (void)xb_add(&bar[XB_XCNT(b.x)], 1u);
    return b;
}
__device__ __forceinline__ void xcd_barrier_complete(unsigned* bar, unsigned x, unsigned& nloc, unsigned& nx) {
    const unsigned G = gridDim.x * gridDim.y * gridDim.z;
    unsigned sum, cnt, mine, sp = 0u;
    for (;;) {
        sum = 0u; cnt = 0u; mine = 0u;
#pragma unroll
        for (unsigned j = 0; j < 16; ++j) { const unsigned c = xb_ld(&bar[XB_XCNT(j)]); sum += c; cnt += (c > 0u) ? 1u : 0u; mine = (j == x) ? c : mine; }
        if (sum == G) break;
        __builtin_amdgcn_s_sleep(1);
        if ((++sp & 255u) == 0u) { if (xb_ld(&bar[XB_TMO])) break; if (sp > XB_SPIN_CAP) { atomicAdd(&bar[XB_TMO], 1u); break; } }
    }
    nloc = mine > 0u ? mine : 1u; nx = cnt > 0u ? cnt : 1u;
}

__device__ __forceinline__ void xcd_barrier(const XcdBarrier& b) {
    asm volatile("s_waitcnt vmcnt(0)" ::: "memory");
    __syncthreads();
    if (threadIdx.x == 0) {
        unsigned* bar = b.bar;
        __builtin_amdgcn_s_waitcnt(0);
        unsigned nloc = b.st[0], nx = b.st[1];
        if (nloc == 0u) { xcd_barrier_complete(bar, b.x, nloc, nx); b.st[0] = nloc; b.st[1] = nx; }
        const unsigned old = xb_add(&bar[XB_XSUB(b.x)], 1u);
        const unsigned gen = old / nloc;
        if (old + 1u == (gen + 1u) * nloc) {
            __builtin_amdgcn_fence(__ATOMIC_RELEASE, "agent");
            asm volatile("s_waitcnt vmcnt(0)" ::: "memory");
            const unsigned og = xb_add(&bar[XB_TOP], 1u);
            const unsigned tg = og / nx;
            if (og + 1u == (tg + 1u) * nx) xb_add(&bar[XB_TOPGEN], 1u);
            else XB_SPIN(xb_ld(&bar[XB_TOPGEN]) == tg, bar);
            __builtin_amdgcn_fence(__ATOMIC_ACQUIRE, "agent");
            xb_add(&bar[XB_XGEN(b.x)], 1u);
            asm volatile("s_waitcnt vmcnt(0)" ::: "memory");
        } else {
            XB_SPIN(xb_ld(&bar[XB_XGEN(b.x)]) == gen, bar);
            __builtin_amdgcn_fence(__ATOMIC_ACQUIRE, "agent");
            asm volatile("s_waitcnt vmcnt(0)" ::: "memory");
        }
    }
    __syncthreads();
}

struct Args { const float* in[20]; float* out; unsigned char* ws; int ph_lo, ph_hi; };

__device__ __forceinline__ void transpose_item(const float* W, int K, int N, bf16* WT, int mode, const float* nw, LAS float* scr, int item, int lane) {
    const int nblk = N / 32, kb = item / nblk, nb = item % nblk, k0 = 64 * kb, n0 = 32 * nb;
    const int drow0 = (mode == 0) ? n0 : ((n0 >> 7) * 256 + (n0 & 127) + (mode == 2 ? 128 : 0));
#pragma unroll 8
    for (int i = 0; i < 32; ++i) { const int kk = 2 * i + (lane >> 5); scr[kk * 33 + (lane & 31)] = W[(size_t)(k0 + kk) * N + n0 + (lane & 31)]; }
    LDS_WAIT(); asm volatile("" ::: "memory");
    const int c = lane & 7;
    f32x4 na = {1.f, 1.f, 1.f, 1.f}, nb2 = na;
    if (nw) { na = *(const GAS f32x4*)(nw + k0 + 8 * c); nb2 = *(const GAS f32x4*)(nw + k0 + 8 * c + 4); }
#pragma unroll
    for (int j = 0; j < 4; ++j) { const int n = (lane >> 3) + 8 * j; const LAS float* s = scr + (8 * c) * 33 + n;
        v4u o; o.x = pk2(s[0 * 33] * na.x, s[1 * 33] * na.y); o.y = pk2(s[2 * 33] * na.z, s[3 * 33] * na.w); o.z = pk2(s[4 * 33] * nb2.x, s[5 * 33] * nb2.y); o.w = pk2(s[6 * 33] * nb2.z, s[7 * 33] * nb2.w);
        const int r = drow0 + n; *(GAS v4u*)(WT + ((size_t)((r >> 8) * (K >> 6) + kb) * 256 + (r & 255)) * 64 + 8 * c) = o; }
    LDS_WAIT(); asm volatile("" ::: "memory");
}
__device__ __forceinline__ void rms_row_to_bf16(const float* xrow, const float* w, bf16* orow, int lane) {
    const GAS f32x4* xr = (const GAS f32x4*)xrow + lane; const GAS f32x4* wr = (const GAS f32x4*)w + lane;
    f32x4 v[8]; float s = 0.f;
#pragma unroll
    for (int j = 0; j < 8; ++j) { v[j] = xr[64 * j]; s += (v[j].x * v[j].x + v[j].y * v[j].y) + (v[j].z * v[j].z + v[j].w * v[j].w); }
    const float rstd = 1.0f / sqrtf(wave_sum(s, lane) * (1.f / DM) + NORM_EPS);
    GAS v2u* o8 = (GAS v2u*)orow + lane;
#pragma unroll
    for (int j = 0; j < 8; ++j) { const f32x4 ww = wr[64 * j]; v2u o; o.x = pk2(v[j].x * rstd * ww.x, v[j].y * rstd * ww.y); o.y = pk2(v[j].z * rstd * ww.z, v[j].w * rstd * ww.w); o8[64 * j] = o; }
}
__device__ __forceinline__ void row_to_bf16_ssq(const float* xrow, bf16* xn, int m, float* ssq, int lane) {
    const GAS f32x4* xr = (const GAS f32x4*)xrow + lane; float s = 0.f;
#pragma unroll
    for (int j = 0; j < 8; ++j) { const f32x4 v = xr[64 * j]; s += (v.x * v.x + v.y * v.y) + (v.z * v.z + v.w * v.w); v2u o; o.x = pk2(v.x, v.y); o.y = pk2(v.z, v.w); *(GAS v2u*)(xn + pg8::toff(m, 4 * lane + 256 * j, DM / 64)) = o; }
    s = wave_sum(s, lane); if (lane < 32) ssq[lane] = (lane == 0) ? s : 0.f;
}
__device__ __forceinline__ void rms_row_bf16_to_f32(const bf16* xn, int m, float* orow, const float* w, int lane) {
    f32x4 v[4][2]; float s = 0.f;
#pragma unroll
    for (int j = 0; j < 4; ++j) { const v4u b = *(const GAS v4u*)(xn + pg8::toff(m, 8 * lane + 512 * j, DM / 64));
        v[j][0] = (f32x4){__builtin_bit_cast(float, b.x << 16), __builtin_bit_cast(float, b.x & 0xffff0000u), __builtin_bit_cast(float, b.y << 16), __builtin_bit_cast(float, b.y & 0xffff0000u)};
        v[j][1] = (f32x4){__builtin_bit_cast(float, b.z << 16), __builtin_bit_cast(float, b.z & 0xffff0000u), __builtin_bit_cast(float, b.w << 16), __builtin_bit_cast(float, b.w & 0xffff0000u)};
#pragma unroll
        for (int h = 0; h < 2; ++h) s += (v[j][h].x * v[j][h].x + v[j][h].y * v[j][h].y) + (v[j][h].z * v[j][h].z + v[j][h].w * v[j][h].w); }
    const float rstd = 1.0f / sqrtf(wave_sum(s, lane) * (1.f / DM) + NORM_EPS);
#pragma unroll
    for (int j = 0; j < 4; ++j)
#pragma unroll
        for (int h = 0; h < 2; ++h) { const int col = 512 * j + 8 * lane + 4 * h; const f32x4 ww = *(const GAS f32x4*)(w + col); *(GAS f32x4*)(orow + col) = v[j][h] * rstd * ww; }
}
__device__ __forceinline__ void rms_row_to_f32(float* xrow, const float* w, int lane) {
    GAS f32x4* xr = (GAS f32x4*)xrow + lane; const GAS f32x4* wr = (const GAS f32x4*)w + lane;
    f32x4 v[8]; float s = 0.f;
#pragma unroll
    for (int j = 0; j < 8; ++j) { v[j] = xr[64 * j]; s += (v[j].x * v[j].x + v[j].y * v[j].y) + (v[j].z * v[j].z + v[j].w * v[j].w); }
    const float rstd = 1.0f / sqrtf(wave_sum(s, lane) * (1.f / DM) + NORM_EPS);
#pragma unroll
    for (int j = 0; j < 8; ++j) { const f32x4 ww = wr[64 * j]; xr[64 * j] = v[j] * rstd * ww; }
}
__device__ __forceinline__ float lambda_init_of(int layer) { return layer == 0 ? 0.2f : 0.35550907f; }

struct PmRaw { v4u a[4]; v2u r[4], g[4]; };
__device__ __forceinline__ void pm_load(PmRaw& P, int row, const bf16* atto, const bf16* rec, const bf16* proj, int lane) {
#pragma unroll
    for (int j = 0; j < 4; ++j) { P.a[j] = *(const GAS v4u*)(atto + (size_t)row * 2048 + j * 512 + lane * 8); P.r[j] = ((const GAS v2u*)(rec + (size_t)row * HW) + lane)[64 * j];
        P.g[j] = *(const GAS v2u*)(proj + (size_t)row * INW + C_GH + 4 * lane + 256 * j); }
}
__device__ __forceinline__ void pm_compute(const PmRaw& P, int row, float lam, const float (&sw)[8], const f32x4 (&gw)[4], bf16* mix, int lane) {
    const int vb = (lane & 15) * 8;
#pragma unroll
    for (int j = 0; j < 4; ++j) {
        const v4u raw = P.a[j];
        float v[8], d[8]; float ss = 0.f;
#pragma unroll
        for (int e = 0; e < 4; ++e) { const unsigned w = raw[e]; v[2 * e] = __builtin_bit_cast(float, w << 16); v[2 * e + 1] = __builtin_bit_cast(float, w & 0xffff0000u); }
#pragma unroll
        for (int e = 0; e < 8; ++e) { const float p = shx(v[e], lane | 16, 0); d[e] = v[e] - lam * p; ss += d[e] * d[e]; }
        ss += shx(ss, lane, 1); ss += shx(ss, lane, 2); ss += shx(ss, lane, 4); ss += shx(ss, lane, 8);
        const float rstd = 1.0f / sqrtf(ss * (1.f / 128.f) + SUBLN_EPS);
        v4u o; o.x = pk2(d[0] * rstd * sw[0], d[1] * rstd * sw[1]); o.y = pk2(d[2] * rstd * sw[2], d[3] * rstd * sw[3]); o.z = pk2(d[4] * rstd * sw[4], d[5] * rstd * sw[5]); o.w = pk2(d[6] * rstd * sw[6], d[7] * rstd * sw[7]);
        const int h = 2 * j + (lane >> 5);
        if ((lane & 16) == 0) *(GAS v4u*)(mix + pg8::toff(row, h * 128 + vb, DM / 64)) = o;
    }
    f32x4 r[4]; float s = 0.f;
#pragma unroll
    for (int j = 0; j < 4; ++j) { const v2u rw = P.r[j]; r[j] = (f32x4){__builtin_bit_cast(float, rw.x << 16), __builtin_bit_cast(float, rw.x & 0xffff0000u), __builtin_bit_cast(float, rw.y << 16), __builtin_bit_cast(float, rw.y & 0xffff0000u)};
        s += (r[j].x * r[j].x + r[j].y * r[j].y) + (r[j].z * r[j].z + r[j].w * r[j].w); }
    const float rstd = 1.0f / sqrtf(wave_sum(s, lane) * (1.f / HW) + NORM_EPS);
#pragma unroll
    for (int j = 0; j < 4; ++j) { const int col = 4 * lane + 256 * j; const v2u graw = P.g[j];
        float g[4] = { __builtin_bit_cast(float, graw.x << 16), __builtin_bit_cast(float, graw.x & 0xffff0000u), __builtin_bit_cast(float, graw.y << 16), __builtin_bit_cast(float, graw.y & 0xffff0000u) };
        float o[4];
#pragma unroll
        for (int e = 0; e < 4; ++e) { const float sg = g[e] / (1.0f + __expf(-g[e])); o[e] = r[j][e] * rstd * gw[j][e] * sg; }
        v2u ov; ov.x = pk2(o[0], o[1]); ov.y = pk2(o[2], o[3]);
        *(GAS v2u*)(mix + pg8::toff(row, 1024 + col, DM / 64)) = ov; }
}

__device__ __forceinline__ float hgrn_lb(const float* lbsrc, int layer, int ch) { return layer == 0 ? 0.f : 1.0f / (1.0f + __expf(lbsrc[ch] - lbsrc[HW + ch])); }

typedef float lbraw_t __attribute__((ext_vector_type(2)));
__device__ __forceinline__ lbraw_t lb_load(const float* lbsrc, int layer, int ch) { lbraw_t r = {0.f, 0.f}; if (layer != 0) { r.x = lbsrc[ch]; r.y = lbsrc[HW + ch]; } return r; }
__device__ __forceinline__ float lb_val(int layer, lbraw_t r) { return layer == 0 ? 0.f : 1.0f / (1.0f + __expf(r.x - r.y)); }
__device__ __forceinline__ void hgrn_naive_item(int item, const bf16* proj, float* rec, const float* lbsrc, int layer, LAS unsigned char* lds, int tid) {
    typedef float f32x2 __attribute__((ext_vector_type(2)));
    LAS f32x2* tile = (LAS f32x2*)lds;
    const int b = item >> 3, h = item & 7, lane = tid & 63, wave = tid >> 6;
    const int k = tid & 127, tq = tid >> 7;
    const float lb = hgrn_lb(lbsrc, layer, h * 128 + k);
    float S[128];
#pragma unroll
    for (int i = 0; i < 128; ++i) S[i] = 0.f;
    for (int tb = 0; tb < SEQ / 64; ++tb) {
        const size_t row0 = (size_t)b * SEQ + (size_t)tb * 64;
#pragma unroll 4
        for (int j = 0; j < 16; ++j) { const int t = tq + 4 * j; const bf16* pr = proj + (row0 + t) * INW + h * 128 + k;
            const float z = bf2f(pr[C_FH]), q = bf2f(pr[C_QH]); const float f = lb + (1.0f - lb) / (1.0f + __expf(-z));
            tile[t * 128 + k] = (f32x2){f, q}; }
        __syncthreads();
        if (wave < 2) { const int v = wave * 64 + lane;
            for (int t = 0; t < 64; ++t) { const float iv = bf2f(proj[(row0 + t) * INW + C_IH + h * 128 + v]); float o = 0.f;
#pragma unroll
                for (int kk = 0; kk < 128; ++kk) { const f32x2 fq = tile[t * 128 + kk]; S[kk] = fq.x * (S[kk] - iv) + iv; o += fq.y * S[kk]; }
                rec[(row0 + t) * HW + h * 128 + v] = o; } }
        __syncthreads();
    }
}

constexpr int HG_TOT = 0, HG_A1 = 2048, HG_A2 = HG_A1 + 64 * 272, HG_B1 = HG_A2 + 64 * 272, HG_VT = HG_B1 + 64 * 272, HG_P = HG_VT + 128 * 144, HG_END = HG_P + 64 * 144;
constexpr int HG_B3T = 2048;
static_assert(HG_B3T + 128 * 144 <= HG_VT && HG_END <= RING_BYTES, "HGRN LDS map");
struct HgRaw { unsigned zq[16], vv[8]; };
template <int PASS>
__device__ __forceinline__ void hg_load(HgRaw& R, int unit, const bf16* proj, int tid) {
    const int bh = unit >> 7, c = unit & 127, b = bh >> 3, h = bh & 7; const size_t row0 = (size_t)b * SEQ + (size_t)c * 64; const int k = tid & 127, tg = tid >> 7;
    const bf16* pz = proj + (row0 + 16 * tg) * INW + h * 128 + k;
#pragma unroll
    for (int j = 0; j < 16; ++j) { const unsigned z = pz[(size_t)j * INW + C_FH]; const unsigned q = (PASS == 3) ? pz[(size_t)j * INW + C_QH] : 0u; R.zq[j] = z | (q << 16); }
#pragma unroll
    for (int j = 0; j < 8; ++j) { const unsigned a = pz[(size_t)(2 * j) * INW + C_IH], b2 = pz[(size_t)(2 * j + 1) * INW + C_IH]; R.vv[j] = a | (b2 << 16); }
}
template <int PASS>
__device__ __forceinline__ void hgrn_chunk_unit(const HgRaw& R, int unit, const bf16* proj, bf16* Lbuf, float* dec, const bf16* ST, bf16* rec, float lb, LAS unsigned char* lds, int tid) {
    const int bh = unit >> 7, c = unit & 127, b = bh >> 3, h = bh & 7;
    const size_t row0 = (size_t)b * SEQ + (size_t)c * 64;
    const int k = tid & 127, tg = tid >> 7, lane = tid & 63, w = __builtin_amdgcn_readfirstlane(tid >> 6), fr = lane & 15, fq = lane >> 4;
    LAS float* TOT = (LAS float*)(lds + HG_TOT);
    float bcum[16], kk[16], qv[16];
    {   float run = 0.f;
#pragma unroll
        for (int j = 0; j < 16; ++j) { const float z = __builtin_bit_cast(float, R.zq[j] << 16);
            if (PASS == 3) qv[j] = __builtin_bit_cast(float, R.zq[j] & 0xffff0000u);
            const float e = __expf(-z); const float sg = 1.0f / (1.0f + e);
            const float f = fmaxf(lb + (1.0f - lb) * sg, 1e-26f);
            kk[j] = (1.0f - lb) * (e * sg);
            run += __logf(f); bcum[j] = run; }
        TOT[tg * 128 + k] = run;
    }
    {   v4u o0, o1;
        o0.x = R.vv[0]; o0.y = R.vv[1]; o0.z = R.vv[2]; o0.w = R.vv[3]; o1.x = R.vv[4]; o1.y = R.vv[5]; o1.z = R.vv[6]; o1.w = R.vv[7];
        *(LAS v4u*)(lds + HG_VT + k * 144 + tg * 32) = o0; *(LAS v4u*)(lds + HG_VT + k * 144 + tg * 32 + 16) = o1;
    }
    __syncthreads();
    const float t0 = TOT[k], t1 = TOT[128 + k], t2 = TOT[256 + k], t3 = TOT[384 + k];
    const float off = (tg > 0 ? t0 : 0.f) + (tg > 1 ? t1 : 0.f) + (tg > 2 ? t2 : 0.f);
    const float blast = (t0 + t1) + (t2 + t3);
    if (PASS == 1) {
        unsigned pkd[8];
#pragma unroll
        for (int j = 0; j < 16; j += 2) pkd[j >> 1] = pk2(kk[j] * __expf(blast - (off + bcum[j])), kk[j + 1] * __expf(blast - (off + bcum[j + 1])));
        *(LAS v4u*)(lds + HG_B3T + k * 144 + tg * 32) = (v4u){pkd[0], pkd[1], pkd[2], pkd[3]};
        *(LAS v4u*)(lds + HG_B3T + k * 144 + tg * 32 + 16) = (v4u){pkd[4], pkd[5], pkd[6], pkd[7]};
        if (tg == 0) dec[(size_t)unit * 128 + k] = __expf(blast);
        __syncthreads();
        bf16x8 yv[2];
#pragma unroll
        for (int ks = 0; ks < 2; ++ks) yv[ks] = *(const LAS bf16x8*)(lds + HG_VT + (16 * w + fr) * 144 + ks * 64 + fq * 16);
        bf16* Lu = Lbuf + (size_t)unit * 16384 + (size_t)(16 * w + fr) * 128 + 4 * fq;
#pragma unroll
        for (int xb = 0; xb < 8; ++xb) { f32x4 acc = {0.f, 0.f, 0.f, 0.f};
#pragma unroll
            for (int ks = 0; ks < 2; ++ks) { const bf16x8 xv = *(const LAS bf16x8*)(lds + HG_B3T + (16 * xb + fr) * 144 + ks * 64 + fq * 16);
                acc = __builtin_amdgcn_mfma_f32_16x16x32_bf16(xv, yv[ks], acc, 0, 0, 0); }
            *(GAS v2u*)(Lu + 16 * xb) = (v2u){pk2(acc[0], acc[1]), pk2(acc[2], acc[3])}; }
    } else {
        const float r = t0 + t1;
#pragma unroll
        for (int j = 0; j < 16; ++j) { const float bj = off + bcum[j]; const int t = 16 * tg + j;
            const float a1 = qv[j] * __expf(fminf(bj - r, 80.f)), a2 = qv[j] * __expf(bj), b1 = kk[j] * __expf(fminf(r - bj, 80.f));
            const unsigned w12 = pk2(a1, a2), w3 = pk2(b1, b1);
            *(LAS unsigned short*)(lds + HG_A1 + t * 272 + k * 2) = (unsigned short)w12;
            *(LAS unsigned short*)(lds + HG_A2 + t * 272 + k * 2) = (unsigned short)(w12 >> 16);
            *(LAS unsigned short*)(lds + HG_B1 + t * 272 + k * 2) = (unsigned short)w3; }
        bf16x8 sx[4];
#pragma unroll
        for (int ks = 0; ks < 4; ++ks) sx[ks] = *(const GAS bf16x8*)(ST + (size_t)unit * 16384 + (size_t)(16 * w + fr) * 128 + 32 * ks + 8 * fq);
        __syncthreads();
#pragma unroll
        for (int rep = 0; rep < 2; ++rep) { const int id = w + 8 * rep, sb = id >> 2, tb = id & 3;
            f32x4 acc = {0.f, 0.f, 0.f, 0.f};
            if (sb <= tb) {
#pragma unroll
                for (int ks = 0; ks < 4; ++ks) { const bf16x8 xv = *(const LAS bf16x8*)(lds + HG_B1 + (16 * sb + fr) * 272 + ks * 64 + fq * 16);
                    const bf16x8 yv = *(const LAS bf16x8*)(lds + HG_A1 + (16 * tb + fr) * 272 + ks * 64 + fq * 16);
                    acc = __builtin_amdgcn_mfma_f32_16x16x32_bf16(xv, yv, acc, 0, 0, 0); }
            }
            const int t = 16 * tb + fr, s0 = 16 * sb + 4 * fq;
            float pvv[4];
#pragma unroll
            for (int i = 0; i < 4; ++i) pvv[i] = (sb <= tb && s0 + i <= t) ? acc[i] : 0.f;
            *(LAS v2u*)(lds + HG_P + t * 144 + s0 * 2) = (v2u){pk2(pvv[0], pvv[1]), pk2(pvv[2], pvv[3])}; }
        __syncthreads();
        bf16x8 vx[2];
#pragma unroll
        for (int ks = 0; ks < 2; ++ks) vx[ks] = *(const LAS bf16x8*)(lds + HG_VT + (16 * w + fr) * 144 + ks * 64 + fq * 16);
#pragma unroll
        for (int tb = 0; tb < 4; ++tb) { f32x4 acc = {0.f, 0.f, 0.f, 0.f};
#pragma unroll
            for (int ks = 0; ks < 2; ++ks) { const bf16x8 yv = *(const LAS bf16x8*)(lds + HG_P + (16 * tb + fr) * 144 + ks * 64 + fq * 16);
                acc = __builtin_amdgcn_mfma_f32_16x16x32_bf16(vx[ks], yv, acc, 0, 0, 0); }
#pragma unroll
            for (int ks = 0; ks < 4; ++ks) { const bf16x8 yv = *(const LAS bf16x8*)(lds + HG_A2 + (16 * tb + fr) * 272 + ks * 64 + fq * 16);
                acc = __builtin_amdgcn_mfma_f32_16x16x32_bf16(sx[ks], yv, acc, 0, 0, 0); }
            *(GAS v2u*)(rec + (row0 + 16 * tb + fr) * HW + h * 128 + 16 * w + 4 * fq) = (v2u){pk2(acc[0], acc[1]), pk2(acc[2], acc[3])}; }
    }
    __syncthreads();
}
__device__ __forceinline__ void hgrn_scan(int gtid, int nthreads, const bf16* Lbuf, const float* dec, bf16* ST) {
    typedef float f32x2 __attribute__((ext_vector_type(2)));
    for (int idx = gtid; idx < 16 * 8192; idx += nthreads) {
        const int bh = idx >> 13, e2 = (idx & 8191) * 2, kq = e2 & 127;
        const unsigned* Lp = (const unsigned*)(Lbuf + (size_t)bh * 128 * 16384 + e2); const float* dp = dec + (size_t)bh * 128 * 128 + kq; unsigned* sp = (unsigned*)(ST + (size_t)bh * 128 * 16384 + e2);
        f32x2 S = {0.f, 0.f};
#pragma unroll 8
        for (int c = 0; c < 128; ++c) { const unsigned lw = Lp[(size_t)c * 8192]; const f32x2 lv = {__builtin_bit_cast(float, lw << 16), __builtin_bit_cast(float, lw & 0xffff0000u)}; const f32x2 d = *(const GAS f32x2*)(dp + c * 128);
            sp[(size_t)c * 8192] = pk2(S.x, S.y); S = d * S + lv; }
    }
}

__device__ __forceinline__ void rstd_table(LAS float* tab, const float* ssq, int pm, float inv_n, float eps, int tid) {
    const int r = tid >> 1, hf = tid & 1; const f32x4* p = (const f32x4*)(ssq + (size_t)(pm * 256 + r) * 32 + hf * 16);
    const f32x4 a = p[0], b = p[1], c = p[2], d = p[3];
    const float q0 = ((a[0] + a[1]) + (a[2] + a[3])) + ((b[0] + b[1]) + (b[2] + b[3])), q1 = ((c[0] + c[1]) + (c[2] + c[3])) + ((d[0] + d[1]) + (d[2] + d[3]));
    float s = q0 + q1; s += shx(s, tid & 63, 1);
    if (hf == 0) tab[r] = __builtin_amdgcn_rsqf(s * inv_n + eps);
    __syncthreads();
}
#ifndef GEMM_ALIGN
#define GEMM_ALIGN true
#endif
#ifndef GEMM_SP2
#define GEMM_SP2 true
#endif
constexpr int PH_PER_LAYER = 13, N_PHASES = 2 * PH_PER_LAYER + 1;

__global__ void __launch_bounds__(NTHREADS, 2) hymba_fwd(Args args) {
    extern __shared__ __attribute__((aligned(16))) unsigned char lds_raw[];
    LAS unsigned char* lds = (LAS unsigned char*)lds_raw;
    cg::grid_group grid = cg::this_grid();
    const int G = gridDim.x, bx = blockIdx.x;
    const int vcu = (G % 8 == 0) ? (bx % 8) * (G / 8) + bx / 8 : bx;
    const int NGW = G * NWAVES;
    unsigned char* ws = args.ws;
    const float* x_in = args.in[0];
    float* xres = args.out;
    bf16* XN = (bf16*)(ws + WS_XN); bf16* MIX = (bf16*)(ws + WS_MIX); bf16* BIG = (bf16*)(ws + WS_BIG); bf16* ATTO = (bf16*)(ws + WS_ATTO);
    float* SSQ = (float*)(ws + WS_SSQ);
    bf16* REC = (bf16*)xres; bf16* LBUF = (bf16*)xres;     bf16* ST = (bf16*)(ws + WS_ST); float* DEC = (float*)(ws + WS_DEC);
    bf16* Wgu1 = (bf16*)(ws + WS_WGU1); bf16* Wd1 = (bf16*)(ws + WS_WD1); bf16* Win = (bf16*)(ws + WS_WIN); bf16* Wout = (bf16*)(ws + WS_WOUT); bf16* Wgu2 = (bf16*)(ws + WS_WGU2); bf16* Wd2 = (bf16*)(ws + WS_WD2);

    LAS float* RTAB = (LAS float*)(lds + RING_BYTES + 1024);
    unsigned* barw = (unsigned*)(ws + WS_BAR);
    volatile LAS unsigned* bst = (volatile LAS unsigned*)(lds + RING_BYTES);
    if (threadIdx.x < 2) bst[threadIdx.x] = 0u;
    if (bx == 0 && args.ph_lo == 0) for (int i = threadIdx.x; i < 4096; i += NTHREADS) __hip_atomic_store(barw + i, 0u, __ATOMIC_RELAXED, __HIP_MEMORY_SCOPE_AGENT);
    __syncthreads();
#ifdef PROBE_MASK
    int probe_rep = 0;
#endif
    XcdBarrier xbar; xbar.bar = barw; xbar.x = 0; xbar.st = bst;
    for (int ph = args.ph_lo; ph < args.ph_hi; ++ph) {
        const int layer = ph / PH_PER_LAYER, p = (ph == N_PHASES - 1) ? 99 : ph % PH_PER_LAYER;
        if (p == 3 || p == 10 || (p == 8 && !HGRN_NAIVE)) continue;
        int tid_o = threadIdx.x; asm volatile("" : "+v"(tid_o));
        const int tid = tid_o;
#define PHASE_IDS const int lane = tid & 63, wave = __builtin_amdgcn_readfirstlane(tid >> 6), gw = vcu * NWAVES + wave; (void)lane; (void)wave; (void)gw;
        switch (p) {
        case 0: {
            PHASE_IDS
            LAS float* scr = (LAS float*)(lds + wave * 16384);
            const float* g1 = args.in[2] + (size_t)layer * DM * DFF; const float* u1 = args.in[3] + (size_t)layer * DM * DFF; const float* d1 = args.in[4] + (size_t)layer * DFF * DM;
            const float* wi = args.in[6] + (size_t)layer * DM * INW; const float* wo = args.in[14] + (size_t)layer * DM * DM;
            const float* g2 = args.in[16] + (size_t)layer * DM * DFF; const float* u2 = args.in[17] + (size_t)layer * DM * DFF; const float* d2 = args.in[18] + (size_t)layer * DFF * DM;
            const float* nw1 = args.in[1] + (size_t)layer * DM; const float* nw2 = args.in[5] + (size_t)layer * DM; const float* nw3 = args.in[15] + (size_t)layer * DM;
            constexpr int I_F = (DM / 64) * (DFF / 32), I_IN = (DM / 64) * (INW / 32), I_OUT = (DM / 64) * (DM / 32);
            constexpr int NITEMS = 6 * I_F + I_IN + I_OUT;
            for (int it = gw; it < NITEMS; it += NGW) {
                int r = it;
                if (r < I_F) { transpose_item(g1, DM, DFF, Wgu1, 1, nw1, scr, r, lane); continue; } r -= I_F;
                if (r < I_F) { transpose_item(u1, DM, DFF, Wgu1, 2, nw1, scr, r, lane); continue; } r -= I_F;
                if (r < I_F) { transpose_item(d1, DFF, DM, Wd1, 0, nullptr, scr, r, lane); continue; } r -= I_F;
                if (r < I_IN) { transpose_item(wi, DM, INW, Win, 0, nw2, scr, r, lane); continue; } r -= I_IN;
                if (r < I_OUT) { transpose_item(wo, DM, DM, Wout, 0, nullptr, scr, r, lane); continue; } r -= I_OUT;
                if (r < I_F) { transpose_item(g2, DM, DFF, Wgu2, 1, nw3, scr, r, lane); continue; } r -= I_F;
                if (r < I_F) { transpose_item(u2, DM, DFF, Wgu2, 2, nw3, scr, r, lane); continue; } r -= I_F;
                transpose_item(d2, DFF, DM, Wd2, 0, nullptr, scr, r, lane);
            }
            if (ph == 0) for (int m = gw; m < M; m += NGW) row_to_bf16_ssq(x_in + (size_t)m * DM, XN, m, SSQ + (size_t)m * 32, lane);
        } break;
        case 1: case 11: {
            pg8::Gemm g{XN, p == 1 ? Wgu1 : Wgu2, M, 2 * DFF, DM}; pg8::StaticOrder S; S.init(M, 2 * DFF, G, bx);
            const float* sq = SSQ + (size_t)(layer * 3 + (p == 1 ? 0 : 2)) * M * 32; pg8::Unit u0; S.next(0, u0); rstd_table(RTAB, sq, u0.pm, 1.0f / DM, NORM_EPS, tid);
            pg8::EpiSwiGLU E{BIG, DFF, sq, 1.0f / DM, NORM_EPS, RTAB, u0.pm};
            pg8::gemm_phase<pg8::EpiSwiGLU, pg8::StaticOrder, GEMM_ALIGN, GEMM_SP2>(lds, g, S, E);
        } break;
        case 2: case 12: case 9: {
            const bf16* A = (p == 9) ? MIX : BIG; const bf16* Bt = (p == 2) ? Wd1 : (p == 12) ? Wd2 : Wout; const int K = (p == 9) ? DM : DFF;
            pg8::Gemm g{A, Bt, M, DM, K}; pg8::StaticOrder S; S.init(M, DM, G, bx);
            pg8::EpiResidual E{XN, SSQ + (size_t)(layer * 3 + (p == 2 ? 1 : p == 9 ? 2 : 3)) * M * 32, DM, (p == 9) ? 1.0f : 0.5f};
            pg8::gemm_phase<pg8::EpiResidual, pg8::StaticOrder, GEMM_ALIGN, GEMM_SP2>(lds, g, S, E);
        } break;
        case 4: {
            pg8::Gemm g{XN, Win, M, INW, DM}; pg8::StaticOrder S; S.init(M, INW, G, bx);
            const float* sq = SSQ + (size_t)(layer * 3 + 1) * M * 32; pg8::Unit u0; S.next(0, u0); rstd_table(RTAB, sq, u0.pm, 1.0f / DM, NORM_EPS, tid);
            pg8::EpiProj E{BIG, INW, sq, 1.0f / DM, NORM_EPS, AW, attn_body::C2, RTAB, u0.pm};
            pg8::gemm_phase<pg8::EpiProj, pg8::StaticOrder, GEMM_ALIGN, GEMM_SP2>(lds, g, S, E);
        } break;
        case 5: {
            for (int i = vcu; i < 256; i += G) {
                const int gsel = i >> 3, s = i & 7; const int b = gsel >> 4, hc = gsel & 15, h = hc >> 1;
                for (int qi = 0; qi < 4; ++qi) { const int qb = (qi == 0) ? s : (qi == 1) ? 15 - s : (qi == 2) ? 16 + s : 31 - s;
                    attn_body::attn_unit<8>(b, C_QA + hc * 64, C_KA + hc * 64, C_VA + h * 128, hc * 128, qb, (const attn_body::bf16*)BIG, (attn_body::bf16*)ATTO, (char*)lds_raw); }
            }
            {   int tid2 = tid; asm volatile("" : "+v"(tid2));
#define tid tid2
                HgRaw cur, nxt; const int u0 = vcu < 2048 ? vcu : 2047; hg_load<1>(cur, u0, BIG, tid);
                lbraw_t lbc = lb_load(args.in[12], layer, ((u0 >> 7) & 7) * 128 + (tid & 127)), lbn;
                for (int u = vcu; u < 2048; u += G) { const int un = u + G < 2048 ? u + G : u; hg_load<1>(nxt, un, BIG, tid); lbn = lb_load(args.in[12], layer, ((un >> 7) & 7) * 128 + (tid & 127));
                    hgrn_chunk_unit<1>(cur, u, BIG, LBUF, DEC, ST, REC, lb_val(layer, lbc), lds, tid); cur = nxt; lbc = lbn; } }
#undef tid
        } break;
        case 6: {
#if HGRN_NAIVE
            for (int item = bx; item < 16; item += G) hgrn_naive_item(item, BIG, REC, args.in[12], layer, lds, tid);
#else
            hgrn_scan(bx * NTHREADS + tid, G * NTHREADS, LBUF, DEC, ST);
#endif
        } break;
        case 7: {
#if !HGRN_NAIVE
            {
                PHASE_IDS
                const float sa = wave_sum(args.in[7][layer * 64 + lane] * args.in[8][layer * 64 + lane], lane), sb = wave_sum(args.in[9][layer * 64 + lane] * args.in[10][layer * 64 + lane], lane);
                const float li = lambda_init_of(layer), lam = __expf(sa) - __expf(sb) + li;
                for (int bc = vcu; bc < 256; bc += G) { const int b = bc >> 7, c = bc & 127;
                    lbraw_t lb_cur = lb_load(args.in[12], layer, (tid & 127)), lb_nxt;
                    HgRaw cur, nxt; hg_load<3>(cur, (b * 8) * 128 + c, BIG, tid);
                    for (int h = 0; h < 8; ++h) { const int u = (b * 8 + h) * 128 + c; hg_load<3>(nxt, h < 7 ? u + 128 : u, BIG, tid); lb_nxt = lb_load(args.in[12], layer, (h < 7 ? h + 1 : h) * 128 + (tid & 127));
                        hgrn_chunk_unit<3>(cur, u, BIG, LBUF, DEC, ST, REC, lb_val(layer, lb_cur), lds, tid); cur = nxt; lb_cur = lb_nxt; }
                    asm volatile("s_waitcnt vmcnt(0)" ::: "memory"); __syncthreads();
                    const int row0 = b * SEQ + c * 64 + wave * 8;
                    float sw[8]; f32x4 gw[4];
#pragma unroll
                    for (int e = 0; e < 8; ++e) sw[e] = args.in[11][layer * 128 + (lane & 15) * 8 + e] * (1.0f - li);
#pragma unroll
                    for (int j = 0; j < 4; ++j) gw[j] = *(const GAS f32x4*)(args.in[13] + (size_t)layer * HW + 4 * lane + 256 * j);
                    PmRaw pc, pn; pm_load(pc, row0, ATTO, REC, BIG, lane);
                    for (int i = 0; i < 8; ++i) { pm_load(pn, row0 + (i < 7 ? i + 1 : i), ATTO, REC, BIG, lane); pm_compute(pc, row0 + i, lam, sw, gw, MIX, lane); pc = pn; }
                }
            }
#endif
        } break;
        default: {
            PHASE_IDS
            for (int m = gw; m < M; m += NGW) rms_row_bf16_to_f32(XN, m, xres + (size_t)m * DM, args.in[19], lane);
        } break;
        }
        if (ph + 1 < args.ph_hi) {
            if (ph == args.ph_lo) { grid.sync(); xbar = xcd_barrier_post(barw, bst); }
            else xcd_barrier(xbar);
        }
#ifdef PROBE_MASK
        if (p < 32 && ((PROBE_MASK >> p) & 1) && !probe_rep && ph != args.ph_lo) { probe_rep = 1; --ph; } else probe_rep = 0;
#endif
    }
}

#ifndef HGRN_NAIVE
#define HGRN_NAIVE 0
#endif
#ifndef N_LAUNCH_MODE
#define N_LAUNCH_MODE 1
#endif
extern "C" void kernel_launch(void* const* d_in, const int* in_sizes, int n_in, void* d_out, int out_size, void* d_ws, size_t ws_size, hipStream_t stream) {
    static int grid = 0;
    if (grid == 0) {
        if (n_in != 20 || out_size != M * DM || ws_size < WS_END) { fprintf(stderr, "kernel_launch: unexpected shapes (n_in %d out %d ws %zu need %zu)\n", n_in, out_size, ws_size, (size_t)WS_END); grid = -1; return; }
        int dev = 0, cus = 0, per_cu = 0;
        (void)hipGetDevice(&dev); (void)hipDeviceGetAttribute(&cus, hipDeviceAttributeMultiprocessorCount, dev);
        if (hipFuncSetAttribute((const void*)hymba_fwd, hipFuncAttributeMaxDynamicSharedMemorySize, LDS_BYTES) != hipSuccess) { fprintf(stderr, "kernel_launch: hipFuncSetAttribute failed\n"); grid = -1; return; }
        if (hipOccupancyMaxActiveBlocksPerMultiprocessor(&per_cu, (const void*)hymba_fwd, NTHREADS, LDS_BYTES) != hipSuccess || per_cu < 1) { fprintf(stderr, "kernel_launch: occupancy query says %d\n", per_cu); per_cu = 1; }
        (void)hipGetLastError();
        grid = cus;
    }
    if (grid < 0) return;
    Args a{};
    for (int i = 0; i < 20; ++i) a.in[i] = (const float*)d_in[i];
    a.out = (float*)d_out; a.ws = (unsigned char*)d_ws;
#if N_LAUNCH_MODE == 1
    a.ph_lo = 0; a.ph_hi = N_PHASES;
    { void* kargs[] = {&a}; hipError_t e = hipLaunchCooperativeKernel((const void*)hymba_fwd, dim3(grid), dim3(NTHREADS), kargs, LDS_BYTES, stream);
      if (e != hipSuccess) fprintf(stderr, "cooperative launch failed: %s (grid %d)\n", hipGetErrorString(e), grid); }
#else
    for (int ph = 0; ph < N_PHASES; ++ph) { if (ph % PH_PER_LAYER == 7) continue; a.ph_lo = ph; a.ph_hi = ph + 1;
        void* kargs[] = {&a}; hipError_t e = hipLaunchCooperativeKernel((const void*)hymba_fwd, dim3(grid), dim3(NTHREADS), kargs, LDS_BYTES, stream);
        if (e != hipSuccess) { fprintf(stderr, "cooperative launch %d failed: %s (grid %d)\n", ph, hipGetErrorString(e), grid); break; } }
#endif
}
```

```cpp
#include <hip/hip_runtime.h>
#include <hip/hip_bf16.h>
#include <hip/hip_cooperative_groups.h>
#include <cstdio>
#include <cstdint>
#include <cmath>
namespace cg = cooperative_groups;
namespace pg8 {
#define PG8_LAS __attribute__((address_space(3)))
typedef unsigned short bf16_t;
typedef short bf16x8 __attribute__((ext_vector_type(8)));
typedef float f32x4 __attribute__((ext_vector_type(4)));
typedef unsigned u32x4 __attribute__((ext_vector_type(4)));
constexpr int BM = 256, BK = 64, HALF = 128, HTB = HALF * BK * 2  , STAGE_BYTES = 8 * HTB, NXCD = 8, WGM = 8;

__host__ __device__ __forceinline__ int lds_byte(int r, int c) { const int st = (r >> 4) * 2 + (c >> 5), rr = r & 15, cc = c & 31, ob = rr * 64 + cc * 2; return st * 1024 + (ob ^ (((ob >> 9) & 1) << 5)); }
__host__ __device__ __forceinline__ void stage_rc(int b, int& R, int& C) { const int st = b / 1024, sb = b % 1024, swz = sb ^ (((sb >> 9) & 1) << 5); R = (st >> 1) * 16 + swz / 64; C = (st & 1) * 32 + (swz % 64) / 2; }
__host__ __device__ __forceinline__ int perm32(int rho) { const int n = rho >> 4, i = rho & 15; return 8 * (i >> 2) + 4 * n + (i & 3); }

struct Unit { int pm, pn; };
__host__ __device__ __forceinline__ size_t toff(int m, int k, int nt) { return ((size_t)((m >> 8) * nt + (k >> 6)) * 256 + (m & 255)) * 64 + (k & 63); }
struct Gemm { const bf16_t* A; const bf16_t* Bt; int M, N, K; };

struct StaticOrder {
    int nM, nN, nwg, G, c;
    __host__ __device__ void init(int M, int N, int G_, int c_) { nM = M / BM; nN = N / BM; nwg = nM * nN; G = G_; c = c_; }
    __host__ __device__ bool next(int i, Unit& u) const {
        const long L = (long)i * G + c; if (L >= nwg) return false;
        int wgid = (int)L; { const int q = nwg / NXCD, r = nwg % NXCD, xcd = wgid % NXCD, off = wgid / NXCD; wgid = (xcd < r ? xcd * (q + 1) : r * (q + 1) + (xcd - r) * q) + off; }
        const int nig = WGM * nN, gid = wgid / nig, fm = gid * WGM, gsz = (nM - fm) < WGM ? (nM - fm) : WGM;
        u.pm = fm + ((wgid % nig) % gsz); u.pn = (wgid % nig) / gsz; return true;
    }
    __device__ __forceinline__ void a_ready(const Unit&) const {}
    __device__ __forceinline__ void done(const Unit&) const {}
};

__device__ __forceinline__ unsigned cvt_pk_bf16(float lo, float hi) { unsigned r; asm volatile("v_cvt_pk_bf16_f32 %0, %1, %2" : "=v"(r) : "v"(lo), "v"(hi)); return r; }
typedef float f32x2 __attribute__((ext_vector_type(2)));
__device__ __forceinline__ f32x2 gelu_pk(f32x2 v) {
    const f32x2 av = __builtin_elementwise_abs(v), d = av * 0.2316418882f + 1.0f;
    f32x2 t; t.x = __builtin_amdgcn_rcpf(d.x); t.y = __builtin_amdgcn_rcpf(d.y);
    f32x2 q = t * 0.5307027145f + (-0.7265760135f); q = q * t + 0.7107068705f; q = q * t + (-0.142248368f); q = q * t + 0.127414796f; q = q * t;
    const f32x2 s = (v * v) * (-0.72134752044f);
    f32x2 e; e.x = __builtin_amdgcn_exp2f(s.x); e.y = __builtin_amdgcn_exp2f(s.y);
    const f32x2 m = v * (q * e), r = v - m;
    f32x2 o; o.x = v.x < 0.f ? m.x : r.x; o.y = v.y < 0.f ? m.y : r.y; return o;
}

template <int ACT  > struct EpiBf16 {
    static constexpr bool PERM = true, AFTER_DRAIN = false; static_assert(ACT == 0 || ACT == 1, "EpiBf16: ACT is 0 (none) or 1 (gelu_pk)");
    bf16_t* O; int ldc; const float* bias; int split_cols; size_t split_stride; float scale0;
    __device__ __forceinline__ void operator()(const f32x4 (&acc)[2][2][4][2], const Unit& u, int wr, int wc, int fr, int fq) const {
        const int row0 = u.pm * BM + wr * 64 + fr; int colt = u.pn * BM; bf16_t* base = O;
        float sc = 1.f; if (split_cols) { const int t = colt / split_cols; base += (size_t)t * split_stride; colt -= t * split_cols; if (t == 0) sc = scale0; }
        const int col0 = colt + wc * 32 + 8 * fq, bcol0 = u.pn * BM + wc * 32 + 8 * fq;
        f32x4 bv[2][2];
#pragma unroll
        for (int bj = 0; bj < 2; ++bj)
#pragma unroll
            for (int n = 0; n < 2; ++n) bv[bj][n] = bias ? *(const f32x4*)(bias + bcol0 + bj * HALF + 4 * n) : (f32x4){0.f, 0.f, 0.f, 0.f};
#pragma unroll
        for (int ai = 0; ai < 2; ++ai)
#pragma unroll
            for (int m = 0; m < 4; ++m) { bf16_t* rowp = base + (size_t)(row0 + ai * HALF + m * 16) * ldc + col0;
#pragma unroll
                for (int bj = 0; bj < 2; ++bj) { f32x4 v0 = acc[ai][bj][m][0] + bv[bj][0], v1 = acc[ai][bj][m][1] + bv[bj][1];
                    if (ACT == 1) { f32x2 a = gelu_pk((f32x2){v0[0], v0[1]}), b = gelu_pk((f32x2){v0[2], v0[3]}), c = gelu_pk((f32x2){v1[0], v1[1]}), d = gelu_pk((f32x2){v1[2], v1[3]});
                        v0 = (f32x4){a.x, a.y, b.x, b.y}; v1 = (f32x4){c.x, c.y, d.x, d.y}; }
                    v0 = v0 * sc; v1 = v1 * sc; u32x4 w; w.x = cvt_pk_bf16(v0[0], v0[1]); w.y = cvt_pk_bf16(v0[2], v0[3]); w.z = cvt_pk_bf16(v1[0], v1[1]); w.w = cvt_pk_bf16(v1[2], v1[3]);
                    *(u32x4*)(rowp + bj * HALF) = w; } }
    }
};
__device__ __forceinline__ float shx(float v, int lane, int m) { return __builtin_bit_cast(float, __builtin_amdgcn_ds_bpermute((lane ^ m) << 2, __builtin_bit_cast(int, v))); }
__device__ __forceinline__ void row_rstd(float (&rs)[2][4], const float* ssq, int row0, int fq, float inv_n, float eps, const PG8_LAS float* tab, int tab_pm, int pm) {
    const int lane = (row0 & 15) + 16 * fq;
    if (pm == tab_pm) {
#pragma unroll
        for (int ai = 0; ai < 2; ++ai)
#pragma unroll
            for (int m = 0; m < 4; ++m) rs[ai][m] = tab[(row0 & 255) + ai * HALF + m * 16];
        return;
    }
#pragma unroll
    for (int ai = 0; ai < 2; ++ai)
#pragma unroll
        for (int m = 0; m < 4; ++m) { const f32x4* p = (const f32x4*)(ssq + (size_t)(row0 + ai * HALF + m * 16) * 32 + fq * 8); const f32x4 a = p[0], b = p[1];
            float s = ((a[0] + a[1]) + (a[2] + a[3])) + ((b[0] + b[1]) + (b[2] + b[3])); s += shx(s, lane, 16); s += shx(s, lane, 32);
            rs[ai][m] = __builtin_amdgcn_rsqf(s * inv_n + eps); }
}
struct EpiSwiGLU {
    static constexpr bool PERM = true, AFTER_DRAIN = false;
    bf16_t* O; int ldc; const float* ssq; float inv_n, eps; const PG8_LAS float* tab; int tab_pm;
    __device__ __forceinline__ void operator()(const f32x4 (&acc)[2][2][4][2], const Unit& u, int wr, int wc, int fr, int fq) const {
        const int row0 = u.pm * BM + wr * 64 + fr; const int col0 = u.pn * HALF + wc * 32 + 8 * fq;
        float rs[2][4]; row_rstd(rs, ssq, row0, fq, inv_n, eps, tab, tab_pm, u.pm);
#pragma unroll
        for (int ai = 0; ai < 2; ++ai)
#pragma unroll
            for (int m = 0; m < 4; ++m) { bf16_t* rowp = O + toff(row0 + ai * HALF + m * 16, col0, ldc >> 6);
                const float r = rs[ai][m]; const f32x2 c1 = {-1.4426950408889634f * r, -1.4426950408889634f * r}, r2 = {r * r, r * r};
                unsigned wv[4];
#pragma unroll
                for (int n = 0; n < 2; ++n)
#pragma unroll
                    for (int e = 0; e < 4; e += 2) { const f32x2 g = {acc[ai][0][m][n][e], acc[ai][0][m][n][e + 1]}, up = {acc[ai][1][m][n][e], acc[ai][1][m][n][e + 1]};
                        const f32x2 t = g * c1; f32x2 d; d.x = __builtin_amdgcn_exp2f(t.x); d.y = __builtin_amdgcn_exp2f(t.y); d = d + 1.0f;
                        f32x2 rc; rc.x = __builtin_amdgcn_rcpf(d.x); rc.y = __builtin_amdgcn_rcpf(d.y);
                        const f32x2 hv = ((g * up) * r2) * rc; wv[n * 2 + (e >> 1)] = cvt_pk_bf16(hv.x, hv.y); }
                u32x4 w; w.x = wv[0]; w.y = wv[1]; w.z = wv[2]; w.w = wv[3];
                *(u32x4*)rowp = w; }
    }
};
struct EpiProj {
    static constexpr bool PERM = true, AFTER_DRAIN = false;
    bf16_t* O; int ldc; const float* ssq; float inv_n, eps; int qcols; float qscale; const PG8_LAS float* tab; int tab_pm;
    __device__ __forceinline__ void operator()(const f32x4 (&acc)[2][2][4][2], const Unit& u, int wr, int wc, int fr, int fq) const {
        const int row0 = u.pm * BM + wr * 64 + fr; const int col0 = u.pn * BM + wc * 32 + 8 * fq;
        float rs[2][4]; row_rstd(rs, ssq, row0, fq, inv_n, eps, tab, tab_pm, u.pm);
        const float cs = (u.pn * BM < qcols) ? qscale : 1.0f;
#pragma unroll
        for (int ai = 0; ai < 2; ++ai)
#pragma unroll
            for (int m = 0; m < 4; ++m) { bf16_t* rowp = O + (size_t)(row0 + ai * HALF + m * 16) * ldc + col0; const float r = rs[ai][m] * cs;
#pragma unroll
                for (int bj = 0; bj < 2; ++bj) { const f32x4 v0 = acc[ai][bj][m][0] * r, v1 = acc[ai][bj][m][1] * r;
                    u32x4 w; w.x = cvt_pk_bf16(v0[0], v0[1]); w.y = cvt_pk_bf16(v0[2], v0[3]); w.z = cvt_pk_bf16(v1[0], v1[1]); w.w = cvt_pk_bf16(v1[2], v1[3]);
                    *(u32x4*)(rowp + bj * HALF) = w; } }
    }
};
struct EpiResidual {
    static constexpr bool PERM = true, AFTER_DRAIN = false;
    bf16_t* xb; float* ssq; int ldc; float alpha;
    __device__ __forceinline__ void operator()(const f32x4 (&acc)[2][2][4][2], const Unit& u, int wr, int wc, int fr, int fq) const {
        const int row0 = u.pm * BM + wr * 64 + fr; const int col0 = u.pn * BM + wc * 32 + 8 * fq;
#pragma unroll
        for (int ai = 0; ai < 2; ++ai) {
            u32x4 bs[4][2];
#pragma unroll
            for (int m = 0; m < 4; ++m) {
#pragma unroll
                for (int bj = 0; bj < 2; ++bj) bs[m][bj] = *(const u32x4*)(xb + toff(row0 + ai * HALF + m * 16, col0 + bj * HALF, ldc >> 6)); }
            asm volatile("" ::: "memory");
#pragma unroll
            for (int m = 0; m < 4; ++m) { const int row = row0 + ai * HALF + m * 16; float ss = 0.f;
#pragma unroll
                for (int bj = 0; bj < 2; ++bj) { const u32x4 b = bs[m][bj];
                    const f32x4 b0 = {__builtin_bit_cast(float, b.x << 16), __builtin_bit_cast(float, b.x & 0xffff0000u), __builtin_bit_cast(float, b.y << 16), __builtin_bit_cast(float, b.y & 0xffff0000u)};
                    const f32x4 b1 = {__builtin_bit_cast(float, b.z << 16), __builtin_bit_cast(float, b.z & 0xffff0000u), __builtin_bit_cast(float, b.w << 16), __builtin_bit_cast(float, b.w & 0xffff0000u)};
                    const f32x4 o0 = b0 + acc[ai][bj][m][0] * alpha, o1 = b1 + acc[ai][bj][m][1] * alpha;
                    ss += (o0[0] * o0[0] + o0[1] * o0[1]) + (o0[2] * o0[2] + o0[3] * o0[3]) + (o1[0] * o1[0] + o1[1] * o1[1]) + (o1[2] * o1[2] + o1[3] * o1[3]);
                    u32x4 w; w.x = cvt_pk_bf16(o0[0], o0[1]); w.y = cvt_pk_bf16(o0[2], o0[3]); w.z = cvt_pk_bf16(o1[0], o1[1]); w.w = cvt_pk_bf16(o1[2], o1[3]);
                    *(u32x4*)(xb + toff(row, col0 + bj * HALF, ldc >> 6)) = w; }
                ss += shx(ss, fr + 16 * fq, 16); ss += shx(ss, fr + 16 * fq, 32);
                if (fq == 0) ssq[(size_t)row * 32 + u.pn * 4 + wc] = ss; }
            asm volatile("" ::: "memory");
        }
    }
};

template <class Epi, class Sched, bool ALIGN_EPI = false, bool SP2 = false>
__device__ __forceinline__ void gemm_phase(PG8_LAS unsigned char* lds, const Gemm g, const Sched& S, const Epi& E) {
    int tid_o = threadIdx.x; asm volatile("" : "+v"(tid_o));
    const int tid = tid_o, wid = __builtin_amdgcn_readfirstlane(tid >> 6), lane = tid & 63, wr = wid >> 2, wc = wid & 3, fr = lane & 15, fq = lane >> 4;
    const int K = g.K, nt = K / BK;
    unsigned voffA[2], voffB[2];
#pragma unroll
    for (int i = 0; i < 2; ++i) { int R, C; stage_rc(tid * 16 + i * 8192, R, C); const int Rb = Epi::PERM ? ((R & ~31) + perm32(R & 31)) : R;
        voffA[i] = (unsigned)(R * BK + C) * 2u; voffB[i] = (unsigned)(Rb * BK + C) * 2u; }
    const size_t kstep = (size_t)(BK * 2), kstepB = (size_t)BM * BK * 2;
    const size_t hstep = (size_t)HALF * K * 2, hstepB = (size_t)HALF * BK * 2;
    const size_t tstep = 2 * hstep;
    const unsigned ldsw = (unsigned)wid * 1024u;
    const int aoff = lds_byte(wr * 64 + fr, fq * 8), boff = lds_byte(wc * 32 + fr, fq * 8);
#define PG8_SA(b, h) (((b) * 2 + (h)) * HTB)
#define PG8_SB(b, h) ((4 + (b) * 2 + (h)) * HTB)
#define PG8_STAGE(bufoff, gbase, voff) do { _Pragma("unroll") for (int _i = 0; _i < 2; ++_i) \
        __builtin_amdgcn_global_load_lds((const unsigned*)((const char*)(gbase) + (voff)[_i]), (PG8_LAS unsigned*)(lds + (bufoff) + ldsw + _i * 8192), 16, 0, 0); } while (0)
#define PG8_LDA(dst, b, h) do { _Pragma("unroll") for (int m = 0; m < 4; ++m) _Pragma("unroll") for (int k = 0; k < 2; ++k) dst[m][k] = *(const PG8_LAS bf16x8*)(lds + PG8_SA(b, h) + aoff + m * 2048 + k * 1024); } while (0)
#define PG8_LDB(dst, b, h) do { _Pragma("unroll") for (int n = 0; n < 2; ++n) _Pragma("unroll") for (int k = 0; k < 2; ++k) dst[n][k] = *(const PG8_LAS bf16x8*)(lds + PG8_SB(b, h) + boff + n * 2048 + k * 1024); } while (0)
#define PG8_MMA(ai, bj, At, Bt) do { __builtin_amdgcn_s_setprio(1); _Pragma("unroll") for (int m = 0; m < 4; ++m) _Pragma("unroll") for (int n = 0; n < 2; ++n) _Pragma("unroll") for (int k = 0; k < 2; ++k) \
        acc[ai][bj][m][n] = __builtin_amdgcn_mfma_f32_16x16x32_bf16(Bt[n][k], At[m][k], acc[ai][bj][m][n], 0, 0, 0); __builtin_amdgcn_s_setprio(0); } while (0)
#define PG8_WAIT_V(n) asm volatile("s_waitcnt vmcnt(" #n ")" ::: "memory")
#define PG8_WAIT_L(n) asm volatile("s_waitcnt lgkmcnt(" #n ")" ::: "memory")
#define PG8_BAR __builtin_amdgcn_s_barrier()
#define PG8_SCHED __builtin_amdgcn_sched_barrier(0)
    Unit cur, nxt; int ui = 0;
    if (!S.next(0, cur)) return;
    f32x4 acc[2][2][4][2];
#pragma unroll
    for (int a = 0; a < 2; ++a)
#pragma unroll
        for (int b = 0; b < 2; ++b)
#pragma unroll
            for (int m = 0; m < 4; ++m)
#pragma unroll
                for (int n = 0; n < 2; ++n) acc[a][b][m][n] = (f32x4){0.f, 0.f, 0.f, 0.f};
    bf16x8 At[4][2], B0[2][2], B1[2][2];
    const char* cA = (const char*)g.A + (size_t)cur.pm * tstep; const char* cB = (const char*)g.Bt + (size_t)cur.pn * tstep;
    S.a_ready(cur);
    if constexpr (SP2) {
        PG8_STAGE(PG8_SB(0, 0), cB, voffB); PG8_STAGE(PG8_SB(0, 1), cB + hstepB, voffB); PG8_STAGE(PG8_SA(0, 0), cA, voffA); PG8_STAGE(PG8_SA(0, 1), cA + hstepB, voffA);
        if (wr == 1) PG8_BAR;
        PG8_WAIT_V(2); PG8_BAR;
        PG8_STAGE(PG8_SB(1, 0), cB + kstepB, voffB); PG8_STAGE(PG8_SA(1, 0), cA + kstepB, voffA); PG8_STAGE(PG8_SB(1, 1), cB + hstepB + kstepB, voffB);
        PG8_WAIT_V(6); PG8_BAR;
    } else {
        PG8_STAGE(PG8_SB(0, 0), cB, voffB); PG8_STAGE(PG8_SA(0, 0), cA, voffA); PG8_STAGE(PG8_SB(0, 1), cB + hstepB, voffB); PG8_STAGE(PG8_SA(0, 1), cA + hstepB, voffA);
        if (wr == 1) PG8_BAR;
        PG8_WAIT_V(4); PG8_BAR;
        PG8_STAGE(PG8_SB(1, 0), cB + kstepB, voffB); PG8_STAGE(PG8_SA(1, 0), cA + kstepB, voffA); PG8_STAGE(PG8_SB(1, 1), cB + hstepB + kstepB, voffB);
        PG8_WAIT_V(6); PG8_BAR;
    }
    for (;;) {
        const bool has_next = S.next(ui + 1, nxt);
        const char* nA = has_next ? (const char*)g.A + (size_t)nxt.pm * tstep : cA; const char* nB = has_next ? (const char*)g.Bt + (size_t)nxt.pn * tstep : cB;
        for (int t = 0; t < nt; t += 2) {
            const bool last = (t == nt - 2);
            const char* a1 = cA + (size_t)(t + 1) * kstepB;
            const char* a2 = last ? nA : cA + (size_t)(t + 2) * kstepB; const char* b2 = last ? nB : cB + (size_t)(t + 2) * kstepB;
            const char* a3 = a2 + kstepB; const char* b3 = b2 + kstepB;
            if (last && has_next) S.a_ready(nxt);
            if constexpr (SP2) {
            PG8_LDB(B0, 0, 0); PG8_LDB(B1, 0, 1); PG8_SCHED; PG8_LDA(At, 0, 0); PG8_STAGE(PG8_SA(1, 1), a1 + hstepB, voffA);
            PG8_WAIT_V(8); PG8_WAIT_L(0); PG8_BAR; PG8_MMA(0, 0, At, B0); PG8_MMA(0, 1, At, B1); PG8_BAR; PG8_SCHED;
            PG8_LDA(At, 0, 1); PG8_STAGE(PG8_SB(0, 0), b2, voffB); PG8_STAGE(PG8_SB(0, 1), b2 + hstepB, voffB); PG8_STAGE(PG8_SA(0, 0), a2, voffA);
            PG8_WAIT_V(8); PG8_WAIT_L(0); PG8_BAR; PG8_MMA(1, 0, At, B0); PG8_MMA(1, 1, At, B1); PG8_BAR; PG8_SCHED;
            PG8_LDB(B0, 1, 0); PG8_LDB(B1, 1, 1); PG8_SCHED; PG8_LDA(At, 1, 0); PG8_STAGE(PG8_SA(0, 1), a2 + hstepB, voffA);
            PG8_WAIT_V(8); PG8_WAIT_L(0); PG8_BAR; PG8_MMA(0, 0, At, B0); PG8_MMA(0, 1, At, B1); PG8_BAR; PG8_SCHED;
            PG8_LDA(At, 1, 1); PG8_STAGE(PG8_SB(1, 0), b3, voffB); PG8_STAGE(PG8_SB(1, 1), b3 + hstepB, voffB); PG8_STAGE(PG8_SA(1, 0), a3, voffA);
            PG8_WAIT_V(8); PG8_WAIT_L(0); PG8_BAR; PG8_MMA(1, 0, At, B0); PG8_MMA(1, 1, At, B1); PG8_BAR; PG8_SCHED;
            } else {
            PG8_LDB(B0, 0, 0); PG8_SCHED; PG8_LDA(At, 0, 0); PG8_STAGE(PG8_SA(1, 1), a1 + hstepB, voffA);
            PG8_WAIT_L(8); PG8_BAR; PG8_WAIT_L(0); PG8_MMA(0, 0, At, B0); PG8_BAR; PG8_SCHED;
            PG8_LDB(B1, 0, 1); PG8_STAGE(PG8_SB(0, 0), b2, voffB);
            PG8_BAR; PG8_WAIT_L(0); PG8_MMA(0, 1, At, B1); PG8_BAR;
            PG8_LDA(At, 0, 1); PG8_STAGE(PG8_SA(0, 0), a2, voffA);
            PG8_BAR; PG8_WAIT_L(0); PG8_MMA(1, 0, At, B0); PG8_BAR; PG8_SCHED;
            PG8_STAGE(PG8_SB(0, 1), b2 + hstepB, voffB);
            PG8_WAIT_V(6); PG8_BAR; PG8_MMA(1, 1, At, B1); PG8_BAR;
            PG8_LDB(B0, 1, 0); PG8_SCHED; PG8_LDA(At, 1, 0); PG8_STAGE(PG8_SA(0, 1), a2 + hstepB, voffA);
            PG8_WAIT_L(8); PG8_BAR; PG8_WAIT_L(0); PG8_MMA(0, 0, At, B0); PG8_BAR; PG8_SCHED;
            PG8_LDB(B1, 1, 1); PG8_STAGE(PG8_SB(1, 0), b3, voffB);
            PG8_BAR; PG8_WAIT_L(0); PG8_MMA(0, 1, At, B1); PG8_BAR;
            PG8_LDA(At, 1, 1); PG8_STAGE(PG8_SA(1, 0), a3, voffA);
            PG8_BAR; PG8_WAIT_L(0); PG8_MMA(1, 0, At, B0); PG8_BAR; PG8_SCHED;
            PG8_STAGE(PG8_SB(1, 1), b3 + hstepB, voffB);
            PG8_WAIT_V(6); PG8_BAR; PG8_MMA(1, 1, At, B1); PG8_BAR;
            }
        }
        if constexpr (ALIGN_EPI) { if (wr == 0) PG8_BAR; }
        if constexpr (!Epi::AFTER_DRAIN) { E(acc, cur, wr, wc, fr, fq); S.done(cur); }
        if (!has_next) break;
#pragma unroll
        for (int a = 0; a < 2; ++a)
#pragma unroll
            for (int b = 0; b < 2; ++b)
#pragma unroll
                for (int m = 0; m < 4; ++m)
#pragma unroll
                    for (int n = 0; n < 2; ++n) acc[a][b][m][n] = (f32x4){0.f, 0.f, 0.f, 0.f};
        cur = nxt; cA = nA; cB = nB; ++ui;
        if constexpr (ALIGN_EPI) { if (wr == 1) PG8_BAR; }
    }
    PG8_WAIT_V(0);
    if constexpr (!ALIGN_EPI) { if (wr == 0) PG8_BAR; }
    PG8_BAR;
    if constexpr (Epi::AFTER_DRAIN) { E.fused(acc, cur, wr, wc, fr, fq, lds, wid, lane); S.done(cur); }
#undef PG8_SA
#undef PG8_SB
#undef PG8_STAGE
#undef PG8_LDA
#undef PG8_LDB
#undef PG8_MMA
#undef PG8_WAIT_V
#undef PG8_WAIT_L
#undef PG8_BAR
#undef PG8_SCHED
}
}
namespace attn_body {
using bf16=__hip_bfloat16;
using bf16x8=__attribute__((ext_vector_type(8)))short;
using s16x4=__attribute__((ext_vector_type(4)))short;
using f32x16=__attribute__((ext_vector_type(16)))float;
using u32x4=__attribute__((ext_vector_type(4)))unsigned;
constexpr int BATCH=2,SEQ=8192,D=64,PIN=7168,POUT=2048;
constexpr int NW=8,QBLK=32,QB=QBLK*NW,KVBLK=64,NQB=SEQ/QB;
constexpr int ATTN_UNIT_ROWS=QB;
__device__ __forceinline__ int crow(int r,int hi){return (r&3)+8*(r>>2)+4*hi;}
#define SBAR() __builtin_amdgcn_sched_barrier(0)
__device__ __forceinline__ void cmask(f32x16&p0,f32x16&p1,int jb,int qrel,int hi){
  const float NEG=-INFINITY; int kb=64*jb+4*hi;
  #pragma unroll
  for(int r=0;r<16;++r){int kv=kb+(r&3)+8*(r>>2); if(kv>qrel)p0[r]=NEG; if(kv+32>qrel)p1[r]=NEG;}
}

constexpr int NSLOT=3, SLOTB=8192;
constexpr int VSLOTB=2*SLOTB;
constexpr int LDS_K=0, LDS_V=NSLOT*SLOTB, LDS_WS=LDS_V+NSLOT*VSLOTB, LDS_OST=LDS_WS+NW*64*4, LDS_BYTES=LDS_OST+NW*4096;
constexpr float C2=0.125f*1.4426950408889634f;
__device__ __forceinline__ void glds16(const void*gsrc,unsigned lds_dst){unsigned keep;
  asm volatile("s_mov_b32 %0, m0\n\ts_mov_b32 m0, %2\n\ts_nop 0\n\tglobal_load_lds_dwordx4 %1, off\n\ts_mov_b32 m0, %0":"=&s"(keep):"v"(gsrc),"s"(lds_dst):"memory");}
__device__ __forceinline__ float max3f(float a,float b,float c){float r;asm("v_max3_f32 %0, %1, %2, %3":"=v"(r):"v"(a),"v"(b),"v"(c));return r;}
__device__ __forceinline__ float max2f(float a,float b){float r;asm("v_max_f32_e32 %0, %1, %2":"=v"(r):"v"(a),"v"(b));return r;}
__device__ __forceinline__ float fadd_s(float a,float b){float r;asm("v_add_f32_e32 %0, %1, %2":"=v"(r):"v"(a),"v"(b));return r;}
__device__ __forceinline__ float fsub_s(float a,float b){float r;asm("v_sub_f32_e32 %0, %1, %2":"=v"(r):"v"(a),"v"(b));return r;}
typedef float f32x2_t __attribute__((ext_vector_type(2))); typedef __bf16 bf16x2_t __attribute__((ext_vector_type(2)));
__device__ __forceinline__ unsigned cvtpk_s(float lo,float hi){f32x2_t v={lo,hi};bf16x2_t b=__builtin_convertvector(v,bf16x2_t);return __builtin_bit_cast(unsigned,b);}
#define WAIT_BAR(N) asm volatile("s_waitcnt vmcnt(" #N ") lgkmcnt(0)\n\ts_barrier":::"memory")

__device__ __forceinline__ void qkt(f32x16&p0,f32x16&p1,const char*Kslot,const bf16x8*qr,const f32x16&negm,int r32,int hi){
  const char*kb=Kslot+hi*1024+r32*16;
  #pragma unroll
  for(int d0=0;d0<4;++d0){
    const bf16x8 b0=*reinterpret_cast<const bf16x8*>(kb+d0*2048);
    const bf16x8 b1=*reinterpret_cast<const bf16x8*>(kb+d0*2048+512);
    if(d0==0){p0=__builtin_amdgcn_mfma_f32_32x32x16_bf16(b0,qr[0],negm,0,0,0);p1=__builtin_amdgcn_mfma_f32_32x32x16_bf16(b1,qr[0],negm,0,0,0);}
    else{p0=__builtin_amdgcn_mfma_f32_32x32x16_bf16(b0,qr[d0],p0,0,0,0);p1=__builtin_amdgcn_mfma_f32_32x32x16_bf16(b1,qr[d0],p1,0,0,0);}}
}
typedef __attribute__((address_space(3))) const char* lds_cptr;
typedef short v4i16_t __attribute__((ext_vector_type(4)));
__device__ __forceinline__ void kload8(bf16x8*kf,lds_cptr kp){
  kf[0]=*(const __attribute__((address_space(3))) bf16x8*)(kp);      kf[1]=*(const __attribute__((address_space(3))) bf16x8*)(kp+512);
  kf[2]=*(const __attribute__((address_space(3))) bf16x8*)(kp+2048); kf[3]=*(const __attribute__((address_space(3))) bf16x8*)(kp+2560);
  kf[4]=*(const __attribute__((address_space(3))) bf16x8*)(kp+4096); kf[5]=*(const __attribute__((address_space(3))) bf16x8*)(kp+4608);
  kf[6]=*(const __attribute__((address_space(3))) bf16x8*)(kp+6144); kf[7]=*(const __attribute__((address_space(3))) bf16x8*)(kp+6656);
}
__device__ __forceinline__ void kload2(bf16x8*kf,lds_cptr kp,int j){ kf[2*j]=*(const __attribute__((address_space(3))) bf16x8*)(kp+j*2048); kf[2*j+1]=*(const __attribute__((address_space(3))) bf16x8*)(kp+j*2048+512); }
__device__ __forceinline__ s16x4 vtr(lds_cptr p){ return __builtin_bit_cast(s16x4,__builtin_amdgcn_ds_read_tr16_b64_v4i16((__attribute__((address_space(3))) v4i16_t*)p)); }
__device__ __forceinline__ float rowmax(const f32x16&p0,const f32x16&p1){
  float a=max3f(p0[0],p0[1],p1[0]),b=max3f(p0[2],p0[3],p1[1]);a=max3f(a,p1[2],p1[3]);
  #pragma unroll
  for(int r=4;r<16;r+=4){a=max3f(a,p0[r],p0[r+1]);b=max3f(b,p0[r+2],p0[r+3]);a=max3f(a,p1[r],p1[r+1]);b=max3f(b,p1[r+2],p1[r+3]);}
  const float m=max2f(a,b);
  auto rr=__builtin_amdgcn_permlane32_swap(__float_as_uint(m),__float_as_uint(m),false,false);
  return max2f(__uint_as_float(rr[0]),__uint_as_float(rr[1]));
}
__device__ __forceinline__ void pv(f32x16*o,int vb,bf16x8 pa0,bf16x8 pa1,bf16x8 pa2,bf16x8 pa3){
  #pragma unroll
  for(int d0=0;d0<2;++d0){s16x4 lo[4],hi[4];
    #pragma unroll
    for(int ks=0;ks<4;++ks){
      asm volatile("ds_read_b64_tr_b16 %0,%1 offset:%c2":"=&v"(lo[ks]):"v"(vb),"i"(d0*4096+ks*1024):"memory");
      asm volatile("ds_read_b64_tr_b16 %0,%1 offset:%c2":"=&v"(hi[ks]):"v"(vb),"i"(d0*4096+ks*1024+512):"memory");}
    asm volatile("s_waitcnt lgkmcnt(0)":::"memory");SBAR();
    #define PK(k) (bf16x8){lo[k][0],lo[k][1],lo[k][2],lo[k][3],hi[k][0],hi[k][1],hi[k][2],hi[k][3]}
    o[d0]=__builtin_amdgcn_mfma_f32_32x32x16_bf16(pa0,PK(0),o[d0],0,0,0);
    o[d0]=__builtin_amdgcn_mfma_f32_32x32x16_bf16(pa1,PK(1),o[d0],0,0,0);
    o[d0]=__builtin_amdgcn_mfma_f32_32x32x16_bf16(pa2,PK(2),o[d0],0,0,0);
    o[d0]=__builtin_amdgcn_mfma_f32_32x32x16_bf16(pa3,PK(3),o[d0],0,0,0);
    #undef PK
  }
}

#ifndef ATTN_STORE16
#define ATTN_STORE16(p,v) (*(u32x4*)(p)=(v))
#endif
template<int THRL> __device__ __forceinline__ void attn_unit(int b,int qcol,int kcol,int vcol,int ocol,int qb,const bf16*__restrict__ P,bf16*__restrict__ O,char*shm){
  int tid_o=threadIdx.x; asm volatile("":"+v"(tid_o)); const int tid=tid_o,lane=tid&63,r32=lane&31,hi=lane>>5; const int wid=__builtin_amdgcn_readfirstlane(tid>>6);
  const long rowbase=(long)b*SEQ; const int q0=qb*QB;
  const bf16*Qw=P+(rowbase+q0+wid*QBLK)*PIN+qcol;
  const bf16*Kh=P+rowbase*PIN+kcol,*Vh=P+rowbase*PIN+vcol;
  const unsigned lds0=(unsigned)(uintptr_t)shm;
  float*wsf=(float*)(shm+LDS_WS)+wid*64;
  const bf16*ksrc=Kh+(long)lane*PIN+wid*8;
  const bf16*vsrc=Vh+(long)(16*(wid&3)+(lane>>2))*PIN+(wid>>2)*32+(lane&3)*8;
  const unsigned kdst=lds0+LDS_K+wid*1024, vdst=lds0+LDS_V+wid*1024;
  #define DMA_K(t,slot) glds16(ksrc+(long)(t)*KVBLK*PIN,(unsigned)__builtin_amdgcn_readfirstlane(kdst+(slot)))
  #define DMA_V(t,slot) do{ glds16(vsrc+(long)(t)*KVBLK*PIN,(unsigned)__builtin_amdgcn_readfirstlane(vdst+2*(slot))); glds16(vsrc+(long)(t)*KVBLK*PIN+64,(unsigned)__builtin_amdgcn_readfirstlane(vdst+2*(slot)+SLOTB)); }while(0)
  const int vb0=(int)(lds0+LDS_V)+((lane>>4)&1)*32+(lane&3)*8+(4*hi+((lane&15)>>2))*64;
  const char*Kbase=shm+LDS_K; bf16x8 kf[8];
  const lds_cptr shm3=(lds_cptr)shm; const lds_cptr kp0=shm3+LDS_K+hi*1024+r32*16; const lds_cptr vp0=shm3+LDS_V+((lane>>4)&1)*32+(lane&3)*8+(4*hi+((lane&15)>>2))*64;
  const int NT=(q0+QB)/KVBLK;
  DMA_K(0,0);DMA_V(0,0);DMA_K(1,SLOTB);
  bf16x8 qr[4];
  #pragma unroll
  for(int d0=0;d0<4;++d0)qr[d0]=*reinterpret_cast<const bf16x8*>(&Qw[(long)r32*PIN+d0*16+hi*8]);
  float mhat=0.f,l_reg=0.f;f32x16 o[4];o[0]=f32x16{};o[1]=f32x16{};o[2]=f32x16{};o[3]=f32x16{};f32x16 negm=f32x16{};asm volatile("":"+v"(negm));
  const int qrel=wid*QBLK+r32;
  #define CMASK(P0,P1,t) do{int jb_=(t)-(NT-4); if(jb_>=0)cmask(P0,P1,jb_,qrel,hi);}while(0)
  bool resc=false;
  #define START(P0,P1) do{ const float rm=rowmax(P0,P1); resc=false; \
    { const float dl=rm; mhat=fadd_s(mhat,dl); \
      _Pragma("unroll") for(int r=0;r<16;++r){P0[r]=fsub_s(P0[r],dl);P1[r]=fsub_s(P1[r],dl);} \
      _Pragma("unroll") for(int r=0;r<16;++r)negm[r]=-mhat; asm volatile("":"+v"(negm)); } \
    _Pragma("unroll") for(int r=0;r<16;++r)P0[r]=__builtin_amdgcn_exp2f(P0[r]); }while(0)
  #define RESC() do{ if(resc){ asm volatile("s_waitcnt lgkmcnt(0)":::"memory"); \
      _Pragma("unroll") for(int d_=0;d_<4;++d_) _Pragma("unroll") for(int r=0;r<16;++r)o[d_][r]*=wsf[crow(r,hi)]; } }while(0)
  f32x16 pA0,pA1,pB0,pB1;
  int sl_prev=0,sl_cur=0,sl_next=SLOTB;
  #define ROT() do{sl_prev=sl_cur;sl_cur=sl_next;sl_next=(sl_next==(NSLOT-1)*SLOTB)?0:sl_next+SLOTB;}while(0)
  DMA_K(2,2*SLOTB);
  WAIT_BAR(4);
  qkt(pA0,pA1,Kbase,qr,negm,r32,hi);asm volatile("s_nop 15\n\ts_nop 7":"+v"(pA0),"+v"(pA1));CMASK(pA0,pA1,0);
  START(pA0,pA1);
  _Pragma("unroll") for(int r=0;r<16;++r)pA1[r]=__builtin_amdgcn_exp2f(pA1[r]);
  WAIT_BAR(0);
  DMA_K(3,0);DMA_V(1,SLOTB);
  ROT();
  kload8(kf,kp0+sl_cur);
  WAIT_BAR(3);
  s16x4 vlo[8],vhi[8]; u32x4 pw0,pw1,pw2,pw3;
  #define PKW(P,B) cvtpk_s(P[B],P[B+1])
  #define PAF(k) __builtin_bit_cast(bf16x8,pw##k)
  #define VFR(i) (bf16x8){vlo[i][0],vlo[i][1],vlo[i][2],vlo[i][3],vhi[i][0],vhi[i][1],vhi[i][2],vhi[i][3]}
  #define PIN(x) asm volatile("":"+v"(x))
  #define MX3(a,b,c) __builtin_fmaxf(__builtin_fmaxf((a),(b)),(c))
  #define GAPA(MF,A0,A1,A2,A3,W0,W1,PW) do{ MF; sacc+=A0; sacc+=A1; sacc+=A2; sacc+=A3; PIN(sacc); W0; W1; PIN(PW); SBAR(); }while(0)
  #define EX(v) __builtin_amdgcn_exp2f(v)
  #define GAPB(MF,X,B) do{ MF; X[B]=EX(X[B]); X[B+1]=EX(X[B+1]); X[B+2]=EX(X[B+2]); X[B+3]=EX(X[B+3]); PIN(X); SBAR(); }while(0)
  #define VRD(i) do{ vlo[i]=vtr(vp_+(((i)>>2)*4096+((i)&3)*1024)); vhi[i]=vtr(vp_+(((i)>>2)*4096+((i)&3)*1024+512)); }while(0)
  #define VRD2(i) do{ vlo[i]=vtr(vp_+(SLOTB+((i)>>2)*4096+((i)&3)*1024)); vhi[i]=vtr(vp_+(SLOTB+((i)>>2)*4096+((i)&3)*1024+512)); SBAR(); }while(0)
  #define GAPB2(MF,X,B) do{ MF; X[B]=EX(X[B]); X[B+1]=EX(X[B+1]); PIN(X); SBAR(); }while(0)
  #define KRD(G,j) do{ if(G){ kload2(kf,kp0+sl_next,j); SBAR(); } }while(0)
  #define STEP(C0,C1,P0,P1,t,GK,GV,GL) do{ SBAR(); \
    const lds_cptr vp_=vp0+2*sl_prev; \
    VRD(0); SBAR(); float sacc=(P0[0]+P0[1]); \
    GAPA(C0=__builtin_amdgcn_mfma_f32_32x32x16_bf16(kf[0],qr[0],negm,0,0,0), P0[2],P0[3],P0[4],P0[5],     pw0[0]=PKW(P0,0), pw0[1]=PKW(P0,2), pw0); \
    VRD(4); SBAR(); GAPA(C1=__builtin_amdgcn_mfma_f32_32x32x16_bf16(kf[1],qr[0],negm,0,0,0), P0[6],P0[7],P0[8],P0[9],     pw0[2]=PKW(P0,4), pw0[3]=PKW(P0,6), pw0); \
    VRD(1); SBAR(); GAPA(C0=__builtin_amdgcn_mfma_f32_32x32x16_bf16(kf[2],qr[1],C0,0,0,0),   P0[10],P0[11],P0[12],P0[13], pw1[0]=PKW(P0,8), pw1[1]=PKW(P0,10), pw1); \
    VRD(5); SBAR(); GAPA(C1=__builtin_amdgcn_mfma_f32_32x32x16_bf16(kf[3],qr[1],C1,0,0,0),   P0[14],P0[15],P1[0],P1[1],   pw1[2]=PKW(P0,12),pw1[3]=PKW(P0,14), pw1); \
    VRD(2); SBAR(); GAPA(C0=__builtin_amdgcn_mfma_f32_32x32x16_bf16(kf[4],qr[2],C0,0,0,0),   P1[2],P1[3],P1[4],P1[5],     pw2[0]=PKW(P1,0), pw2[1]=PKW(P1,2), pw2); \
    VRD(6); SBAR(); GAPA(C1=__builtin_amdgcn_mfma_f32_32x32x16_bf16(kf[5],qr[2],C1,0,0,0),   P1[6],P1[7],P1[8],P1[9],     pw2[2]=PKW(P1,4), pw2[3]=PKW(P1,6), pw2); \
    VRD(3); SBAR(); GAPA(C0=__builtin_amdgcn_mfma_f32_32x32x16_bf16(kf[6],qr[3],C0,0,0,0),   P1[10],P1[11],P1[12],P1[13], pw3[0]=PKW(P1,8), pw3[1]=PKW(P1,10), pw3); \
    VRD(7); SBAR(); GAPA(C1=__builtin_amdgcn_mfma_f32_32x32x16_bf16(kf[7],qr[3],C1,0,0,0),   P1[14],P1[15],0.f,0.f,       pw3[2]=PKW(P1,12),pw3[3]=PKW(P1,14), pw3); \
    l_reg+=sacc; \
    if(GK){DMA_K((t)+3,sl_cur);} if(GV){DMA_V((t)+1,sl_next);} \
    CMASK(C0,C1,t); \
    { float a=MX3(C0[0],C0[1],C1[0]),b=MX3(C0[2],C0[3],C1[1]); a=MX3(a,C1[2],C1[3]); \
      _Pragma("unroll") for(int r=4;r<16;r+=4){a=MX3(a,C0[r],C0[r+1]);b=MX3(b,C0[r+2],C0[r+3]);a=MX3(a,C1[r],C1[r+1]);b=MX3(b,C1[r+2],C1[r+3]);} \
      float rm=__builtin_fmaxf(a,b); { auto rr=__builtin_amdgcn_permlane32_swap(__float_as_uint(rm),__float_as_uint(rm),false,false); rm=__builtin_fmaxf(__uint_as_float(rr[0]),__uint_as_float(rr[1])); } \
      resc=false; \
      if(__builtin_expect(__any(rm>(float)THRL),0)){ const float dl=__builtin_fmaxf(rm,0.f); mhat+=dl; \
        _Pragma("unroll") for(int r=0;r<16;++r){C0[r]-=dl;C1[r]-=dl;} \
        _Pragma("unroll") for(int r=0;r<16;++r)negm[r]=-mhat; asm volatile("":"+v"(negm)); \
        const float f=__builtin_amdgcn_exp2f(-dl); l_reg*=f; if(hi==0)wsf[r32]=f; resc=true; } } \
    SBAR(); \
    GAPB2(o[0]=__builtin_amdgcn_mfma_f32_32x32x16_bf16(PAF(0),VFR(0),o[0],0,0,0), C0,0); VRD2(0); \
    GAPB2(o[1]=__builtin_amdgcn_mfma_f32_32x32x16_bf16(PAF(0),VFR(4),o[1],0,0,0), C0,2); VRD2(4); \
    KRD(GL,0); GAPB2(o[0]=__builtin_amdgcn_mfma_f32_32x32x16_bf16(PAF(1),VFR(1),o[0],0,0,0), C0,4); VRD2(1); \
    KRD(GL,1); GAPB2(o[1]=__builtin_amdgcn_mfma_f32_32x32x16_bf16(PAF(1),VFR(5),o[1],0,0,0), C0,6); VRD2(5); \
    KRD(GL,2); GAPB2(o[0]=__builtin_amdgcn_mfma_f32_32x32x16_bf16(PAF(2),VFR(2),o[0],0,0,0), C0,8); VRD2(2); \
    KRD(GL,3); GAPB2(o[1]=__builtin_amdgcn_mfma_f32_32x32x16_bf16(PAF(2),VFR(6),o[1],0,0,0), C0,10); VRD2(6); \
    GAPB2(o[0]=__builtin_amdgcn_mfma_f32_32x32x16_bf16(PAF(3),VFR(3),o[0],0,0,0), C0,12); VRD2(3); \
    GAPB2(o[1]=__builtin_amdgcn_mfma_f32_32x32x16_bf16(PAF(3),VFR(7),o[1],0,0,0), C0,14); VRD2(7); \
    GAPB2(o[2]=__builtin_amdgcn_mfma_f32_32x32x16_bf16(PAF(0),VFR(0),o[2],0,0,0), C1,0); \
    GAPB2(o[3]=__builtin_amdgcn_mfma_f32_32x32x16_bf16(PAF(0),VFR(4),o[3],0,0,0), C1,2); \
    GAPB2(o[2]=__builtin_amdgcn_mfma_f32_32x32x16_bf16(PAF(1),VFR(1),o[2],0,0,0), C1,4); \
    GAPB2(o[3]=__builtin_amdgcn_mfma_f32_32x32x16_bf16(PAF(1),VFR(5),o[3],0,0,0), C1,6); \
    GAPB2(o[2]=__builtin_amdgcn_mfma_f32_32x32x16_bf16(PAF(2),VFR(2),o[2],0,0,0), C1,8); \
    GAPB2(o[3]=__builtin_amdgcn_mfma_f32_32x32x16_bf16(PAF(2),VFR(6),o[3],0,0,0), C1,10); \
    GAPB2(o[2]=__builtin_amdgcn_mfma_f32_32x32x16_bf16(PAF(3),VFR(3),o[2],0,0,0), C1,12); \
    GAPB2(o[3]=__builtin_amdgcn_mfma_f32_32x32x16_bf16(PAF(3),VFR(7),o[3],0,0,0), C1,14); \
    }while(0)
  int t=1;
  #undef CMASK
  #define CMASK(P0,P1,t) do{}while(0)
  for(;t+5<NT;t+=2){
    STEP(pB0,pB1,pA0,pA1,t,true,true,true);     WAIT_BAR(3); RESC(); ROT();
    STEP(pA0,pA1,pB0,pB1,t+1,true,true,true);   WAIT_BAR(3); RESC(); ROT();
  }
  #undef CMASK
  #define CMASK(P0,P1,t) do{int jb_=(t)-(NT-4); if(jb_>=0)cmask(P0,P1,jb_,qrel,hi);}while(0)
  #define ENDW(tt) do{ if((tt)+3<NT){WAIT_BAR(3);} else if((tt)+2<NT){WAIT_BAR(2);} else {WAIT_BAR(0);} }while(0)
  for(;t+1<NT;t+=2){
    STEP(pB0,pB1,pA0,pA1,t,(t+3<NT),(t+1<NT),(t+1<NT));       ENDW(t);   RESC(); ROT();
    STEP(pA0,pA1,pB0,pB1,t+1,(t+4<NT),(t+2<NT),(t+2<NT));     ENDW(t+1); RESC(); ROT();
  }
  STEP(pB0,pB1,pA0,pA1,NT-1,false,false,false); RESC();
  { float sacc=pB0[0]+pB0[1]; _Pragma("unroll") for(int r=2;r<16;++r)sacc+=pB0[r]; _Pragma("unroll") for(int r=0;r<16;++r)sacc+=pB1[r]; l_reg+=sacc;
    pw0=(u32x4){PKW(pB0,0),PKW(pB0,2),PKW(pB0,4),PKW(pB0,6)};pw1=(u32x4){PKW(pB0,8),PKW(pB0,10),PKW(pB0,12),PKW(pB0,14)};pw2=(u32x4){PKW(pB1,0),PKW(pB1,2),PKW(pB1,4),PKW(pB1,6)};pw3=(u32x4){PKW(pB1,8),PKW(pB1,10),PKW(pB1,12),PKW(pB1,14)};
    SBAR(); pv(o,vb0+2*sl_cur,PAF(0),PAF(1),PAF(2),PAF(3)); pv(o+2,vb0+2*sl_cur+SLOTB,PAF(0),PAF(1),PAF(2),PAF(3)); }
  #undef PKW
  #undef PAF
  #undef VFR
  #undef PIN
  #undef MX3
  #undef GAPA
  #undef GAPB
  #undef EX
  #undef VRD
  #undef VRD2
  #undef GAPB2
  #undef KRD
  #undef STEP
  #undef ENDW
  {auto rr=__builtin_amdgcn_permlane32_swap(__float_as_uint(l_reg),__float_as_uint(l_reg),false,false);l_reg=__uint_as_float(rr[0])+__uint_as_float(rr[1]);}
  if(hi==0)wsf[32+r32]=l_reg;asm volatile("s_waitcnt lgkmcnt(0)":::"memory");
  float rli[16];
  #pragma unroll
  for(int r=0;r<16;++r)rli[r]=__builtin_amdgcn_rcpf(wsf[32+crow(r,hi)]);
  bf16*Ow=O+(rowbase+q0+wid*QBLK)*POUT+ocol;
  { bf16*stg=(bf16*)(shm+LDS_OST)+wid*2048;
    #pragma unroll
    for(int vh=0;vh<2;++vh){
    #pragma unroll
    for(int r=0;r<16;++r){const int orow=crow(r,hi);
      #pragma unroll
      for(int d0=0;d0<2;++d0)stg[orow*64+d0*32+r32]=__float2bfloat16(o[2*vh+d0][r]*rli[r]);}
    asm volatile("s_waitcnt lgkmcnt(0)":::"memory");
    #pragma unroll
    for(int i=0;i<4;++i){const int row=i*8+(lane>>3),ch=lane&7; const u32x4 v=*(const u32x4*)(stg+row*64+ch*8); ATTN_STORE16(Ow+(long)row*POUT+vh*64+ch*8,v);}
    asm volatile("s_waitcnt lgkmcnt(0)":::"memory"); } }
  asm volatile("s_waitcnt lgkmcnt(0)\n\ts_barrier":::"memory");
  #undef DMA_K
  #undef DMA_V
  #undef CMASK
  #undef START
  #undef RESC
  #undef ROT
}
constexpr int ATTN_LDS_BYTES=LDS_BYTES;
#undef SBAR
#undef WAIT_BAR
}
#define GAS __attribute__((address_space(1)))
#define LAS __attribute__((address_space(3)))
typedef unsigned short bf16;
typedef unsigned v4u __attribute__((ext_vector_type(4)));
typedef unsigned v2u __attribute__((ext_vector_type(2)));
typedef float f32x4 __attribute__((ext_vector_type(4)));
typedef short bf16x8 __attribute__((ext_vector_type(8)));
#define LDS_WAIT() asm volatile("s_waitcnt lgkmcnt(0)" ::: "memory")

#ifndef HGRN_NAIVE
#define HGRN_NAIVE 0
#endif
constexpr int NWAVES = 8, NTHREADS = 512;
constexpr int BATCH = 2, SEQ = 8192, DM = 2048, M = BATCH * SEQ, DFF = 5632, INW = 7168, AW = 1024, HW = 1024, NH = 8;
constexpr int C_QA = 0, C_KA = 1024, C_VA = 2048, C_QH = 3072, C_FH = 4096, C_IH = 5120, C_GH = 6144;
constexpr float NORM_EPS = 1e-6f, SUBLN_EPS = 1e-5f;
constexpr int LDS_BYTES = 147456, RING_BYTES = 131072;

constexpr size_t SZ_WGU = (size_t)2 * DFF * DM * 2, SZ_WD = (size_t)DM * DFF * 2, SZ_WIN = (size_t)INW * DM * 2, SZ_WOUT = (size_t)DM * DM * 2;
constexpr size_t WS_WGU1 = 0, WS_WD1 = WS_WGU1 + SZ_WGU, WS_WIN = WS_WD1 + SZ_WD, WS_WOUT = WS_WIN + SZ_WIN, WS_WGU2 = WS_WOUT + SZ_WOUT, WS_WD2 = WS_WGU2 + SZ_WGU;
constexpr size_t WS_XN = WS_WD2 + SZ_WD;
constexpr size_t WS_MIX = WS_XN + (size_t)M * DM * 2;
constexpr size_t WS_BIG = WS_MIX + (size_t)M * DM * 2;
constexpr size_t WS_ATTO = WS_BIG + (size_t)M * INW * 2;
constexpr size_t WS_ST = WS_ATTO + (size_t)M * DM * 2;
constexpr size_t WS_DEC = WS_ST + (size_t)2048 * 128 * 128 * 2;
constexpr size_t WS_BAR = WS_DEC + (size_t)2048 * 128 * 4;
constexpr size_t WS_SSQ = WS_BAR + 16384;
constexpr size_t WS_END = WS_SSQ + (size_t)7 * M * 32 * 4;

__device__ __forceinline__ unsigned pk2(float lo, float hi) { typedef float f2_t __attribute__((ext_vector_type(2))); typedef __bf16 b2_t __attribute__((ext_vector_type(2))); const f2_t v = {lo, hi}; return __builtin_bit_cast(unsigned, __builtin_convertvector(v, b2_t)); }
__device__ __forceinline__ unsigned f2bf(float f) { return pk2(f, f) & 0xffffu; }
__device__ __forceinline__ float bf2f(unsigned short b) { return __builtin_bit_cast(float, (unsigned)b << 16); }
using pg8::shx;
__device__ __forceinline__ float wave_sum(float v, int lane) {
#pragma unroll
    for (int o = 1; o < 64; o <<= 1) v += shx(v, lane, o);
    return v;
}

#define RLX_AGENT __ATOMIC_RELAXED, __HIP_MEMORY_SCOPE_AGENT
#define XB_TMO      128
#define XB_XCNT(j)  (256  + 64 * (j))
#define XB_XSUB(j)  (1280 + 64 * (j))
#define XB_XGEN(j)  (2304 + 64 * (j))
#define XB_TOP      3328
#define XB_TOPGEN   3392
#define XCD_BAR_WORDS 3456
#define XB_SPIN_CAP (1u << 18)

__device__ __forceinline__ unsigned xb_ld(unsigned* p)              { return __hip_atomic_load(p, __ATOMIC_RELAXED, __HIP_MEMORY_SCOPE_AGENT); }
__device__ __forceinline__ unsigned xb_add(unsigned* p, unsigned v) { return __hip_atomic_fetch_add(p, v, __ATOMIC_RELAXED, __HIP_MEMORY_SCOPE_AGENT); }
__device__ __forceinline__ unsigned xb_xcc_id() { return (unsigned)__builtin_amdgcn_s_getreg((3 << 11) | 20) & 0xFu; }
#define XB_SPIN(cond, bar) do { unsigned _sp = 0; while (cond) { __builtin_amdgcn_s_sleep(1); \
    if ((++_sp & 255u) == 0u) { if (xb_ld(&(bar)[XB_TMO])) break; if (_sp > XB_SPIN_CAP) { atomicAdd(&(bar)[XB_TMO], 1u); break; } } } } while (0)

struct XcdBarrier {
    unsigned* bar; unsigned x;
    volatile LAS unsigned* st;
};

__device__ __forceinline__ XcdBarrier xcd_barrier_post(unsigned* bar, volatile LAS unsigned* st) {
    XcdBarrier b; b.bar = bar; b.x = xb_xcc_id(); b.st = st;
    if (threadIdx.x == 0) (void)xb_add(&bar[XB_XCNT(b.x)], 1u);
    return b;
}
__device__ __forceinline__ void xcd_barrier_complete(unsigned* bar, unsigned x, unsigned& nloc, unsigned& nx) {
    const unsigned G = gridDim.x * gridDim.y * gridDim.z;
    unsigned sum, cnt, mine, sp = 0u;
    for (;;) {
        sum = 0u; cnt = 0u; mine = 0u;
#pragma unroll
        for (unsigned j = 0; j < 16; ++j) { const unsigned c = xb_ld(&bar[XB_XCNT(j)]); sum += c; cnt += (c > 0u) ? 1u : 0u; mine = (j == x) ? c : mine; }
        if (sum == G) break;
        __builtin_amdgcn_s_sleep(1);
        if ((++sp & 255u) == 0u) { if (xb_ld(&bar[XB_TMO])) break; if (sp > XB_SPIN_CAP) { atomicAdd(&bar[XB_TMO], 1u); break; } }
    }
    nloc = mine > 0u ? mine : 1u; nx = cnt > 0u ? cnt : 1u;
}

__device__ __forceinline__ void xcd_barrier(const XcdBarrier& b) {
    asm volatile("s_waitcnt vmcnt(0)" ::: "memory");
    __syncthreads();
    if (threadIdx.x == 0) {
        unsigned* bar = b.bar;
        __builtin_amdgcn_s_waitcnt(0);
        unsigned nloc = b.st[0], nx = b.st[1];
        if (nloc == 0u) { xcd_barrier_complete(bar, b.x, nloc, nx); b.st[0] = nloc; b.st[1] = nx; }
        const unsigned old = xb_add(&bar[XB_XSUB(b.x)], 1u);
        const unsigned gen = old / nloc;
        if (old + 1u == (gen + 1u) * nloc) {
            __builtin_amdgcn_fence(__ATOMIC_RELEASE, "agent");
            asm volatile("s_waitcnt vmcnt(0)" ::: "memory");
            const unsigned og = xb_add(&bar[XB_TOP], 1u);
            const unsigned tg = og / nx;
            if (og + 1u == (tg + 1u) * nx) xb_add(&bar[XB_TOPGEN], 1u);
            else XB_SPIN(xb_ld(&bar[XB_TOPGEN]) == tg, bar);
            __builtin_amdgcn_fence(__ATOMIC_ACQUIRE, "agent");
            xb_add(&bar[XB_XGEN(b.x)], 1u);
            asm volatile("s_waitcnt vmcnt(0)" ::: "memory");
        } else {
            XB_SPIN(xb_ld(&bar[XB_XGEN(b.x)]) == gen, bar);
            __builtin_amdgcn_fence(__ATOMIC_ACQUIRE, "agent");
            asm volatile("s_waitcnt vmcnt(0)" ::: "memory");
        }
    }
    __syncthreads();
}

struct Args { const float* in[20]; float* out; unsigned char* ws; int ph_lo, ph_hi; };

__device__ __forceinline__ void transpose_item(const float* W, int K, int N, bf16* WT, int mode, const float* nw, LAS float* scr, int item, int lane) {
    const int nblk = N / 32, kb = item / nblk, nb = item % nblk, k0 = 64 * kb, n0 = 32 * nb;
    const int drow0 = (mode == 0) ? n0 : ((n0 >> 7) * 256 + (n0 & 127) + (mode == 2 ? 128 : 0));
#pragma unroll 8
    for (int i = 0; i < 32; ++i) { const int kk = 2 * i + (lane >> 5); scr[kk * 33 + (lane & 31)] = W[(size_t)(k0 + kk) * N + n0 + (lane & 31)]; }
    LDS_WAIT(); asm volatile("" ::: "memory");
    const int c = lane & 7;
    f32x4 na = {1.f, 1.f, 1.f, 1.f}, nb2 = na;
    if (nw) { na = *(const GAS f32x4*)(nw + k0 + 8 * c); nb2 = *(const GAS f32x4*)(nw + k0 + 8 * c + 4); }
#pragma unroll
    for (int j = 0; j < 4; ++j) { const int n = (lane >> 3) + 8 * j; const LAS float* s = scr + (8 * c) * 33 + n;
        v4u o; o.x = pk2(s[0 * 33] * na.x, s[1 * 33] * na.y); o.y = pk2(s[2 * 33] * na.z, s[3 * 33] * na.w); o.z = pk2(s[4 * 33] * nb2.x, s[5 * 33] * nb2.y); o.w = pk2(s[6 * 33] * nb2.z, s[7 * 33] * nb2.w);
        const int r = drow0 + n; *(GAS v4u*)(WT + ((size_t)((r >> 8) * (K >> 6) + kb) * 256 + (r & 255)) * 64 + 8 * c) = o; }
    LDS_WAIT(); asm volatile("" ::: "memory");
}
__device__ __forceinline__ void rms_row_to_bf16(const float* xrow, const float* w, bf16* orow, int lane) {
    const GAS f32x4* xr = (const GAS f32x4*)xrow + lane; const GAS f32x4* wr = (const GAS f32x4*)w + lane;
    f32x4 v[8]; float s = 0.f;
#pragma unroll
    for (int j = 0; j < 8; ++j) { v[j] = xr[64 * j]; s += (v[j].x * v[j].x + v[j].y * v[j].y) + (v[j].z * v[j].z + v[j].w * v[j].w); }
    const float rstd = 1.0f / sqrtf(wave_sum(s, lane) * (1.f / DM) + NORM_EPS);
    GAS v2u* o8 = (GAS v2u*)orow + lane;
#pragma unroll
    for (int j = 0; j < 8; ++j) { const f32x4 ww = wr[64 * j]; v2u o; o.x = pk2(v[j].x * rstd * ww.x, v[j].y * rstd * ww.y); o.y = pk2(v[j].z * rstd * ww.z, v[j].w * rstd * ww.w); o8[64 * j] = o; }
}
__device__ __forceinline__ void row_to_bf16_ssq(const float* xrow, bf16* xn, int m, float* ssq, int lane) {
    const GAS f32x4* xr = (const GAS f32x4*)xrow + lane; float s = 0.f;
#pragma unroll
    for (int j = 0; j < 8; ++j) { const f32x4 v = xr[64 * j]; s += (v.x * v.x + v.y * v.y) + (v.z * v.z + v.w * v.w); v2u o; o.x = pk2(v.x, v.y); o.y = pk2(v.z, v.w); *(GAS v2u*)(xn + pg8::toff(m, 4 * lane + 256 * j, DM / 64)) = o; }
    s = wave_sum(s, lane); if (lane < 32) ssq[lane] = (lane == 0) ? s : 0.f;
}
__device__ __forceinline__ void rms_row_bf16_to_f32(const bf16* xn, int m, float* orow, const float* w, int lane) {
    f32x4 v[4][2]; float s = 0.f;
#pragma unroll
    for (int j = 0; j < 4; ++j) { const v4u b = *(const GAS v4u*)(xn + pg8::toff(m, 8 * lane + 512 * j, DM / 64));
        v[j][0] = (f32x4){__builtin_bit_cast(float, b.x << 16), __builtin_bit_cast(float, b.x & 0xffff0000u), __builtin_bit_cast(float, b.y << 16), __builtin_bit_cast(float, b.y & 0xffff0000u)};
        v[j][1] = (f32x4){__builtin_bit_cast(float, b.z << 16), __builtin_bit_cast(float, b.z & 0xffff0000u), __builtin_bit_cast(float, b.w << 16), __builtin_bit_cast(float, b.w & 0xffff0000u)};
#pragma unroll
        for (int h = 0; h < 2; ++h) s += (v[j][h].x * v[j][h].x + v[j][h].y * v[j][h].y) + (v[j][h].z * v[j][h].z + v[j][h].w * v[j][h].w); }
    const float rstd = 1.0f / sqrtf(wave_sum(s, lane) * (1.f / DM) + NORM_EPS);
#pragma unroll
    for (int j = 0; j < 4; ++j)
#pragma unroll
        for (int h = 0; h < 2; ++h) { const int col = 512 * j + 8 * lane + 4 * h; const f32x4 ww = *(const GAS f32x4*)(w + col); *(GAS f32x4*)(orow + col) = v[j][h] * rstd * ww; }
}
__device__ __forceinline__ void rms_row_to_f32(float* xrow, const float* w, int lane) {
    GAS f32x4* xr = (GAS f32x4*)xrow + lane; const GAS f32x4* wr = (const GAS f32x4*)w + lane;
    f32x4 v[8]; float s = 0.f;
#pragma unroll
    for (int j = 0; j < 8; ++j) { v[j] = xr[64 * j]; s += (v[j].x * v[j].x + v[j].y * v[j].y) + (v[j].z * v[j].z + v[j].w * v[j].w); }
    const float rstd = 1.0f / sqrtf(wave_sum(s, lane) * (1.f / DM) + NORM_EPS);
#pragma unroll
    for (int j = 0; j < 8; ++j) { const f32x4 ww = wr[64 * j]; xr[64 * j] = v[j] * rstd * ww; }
}
__device__ __forceinline__ float lambda_init_of(int layer) { return layer == 0 ? 0.2f : 0.35550907f; }

struct PmRaw { v4u a[4]; v2u r[4], g[4]; };
__device__ __forceinline__ void pm_load(PmRaw& P, int row, const bf16* atto, const bf16* rec, const bf16* proj, int lane) {
#pragma unroll
    for (int j = 0; j < 4; ++j) { P.a[j] = *(const GAS v4u*)(atto + (size_t)row * 2048 + j * 512 + lane * 8); P.r[j] = ((const GAS v2u*)(rec + (size_t)row * HW) + lane)[64 * j];
        P.g[j] = *(const GAS v2u*)(proj + (size_t)row * INW + C_GH + 4 * lane + 256 * j); }
}
__device__ __forceinline__ void pm_compute(const PmRaw& P, int row, float lam, const float (&sw)[8], const f32x4 (&gw)[4], bf16* mix, int lane) {
    const int vb = (lane & 15) * 8;
#pragma unroll
    for (int j = 0; j < 4; ++j) {
        const v4u raw = P.a[j];
        float v[8], d[8]; float ss = 0.f;
#pragma unroll
        for (int e = 0; e < 4; ++e) { const unsigned w = raw[e]; v[2 * e] = __builtin_bit_cast(float, w << 16); v[2 * e + 1] = __builtin_bit_cast(float, w & 0xffff0000u); }
#pragma unroll
        for (int e = 0; e < 8; ++e) { const float p = shx(v[e], lane | 16, 0); d[e] = v[e] - lam * p; ss += d[e] * d[e]; }
        ss += shx(ss, lane, 1); ss += shx(ss, lane, 2); ss += shx(ss, lane, 4); ss += shx(ss, lane, 8);
        const float rstd = __builtin_amdgcn_rsqf(ss * (1.f / 128.f) + SUBLN_EPS);
        v4u o; o.x = pk2(d[0] * rstd * sw[0], d[1] * rstd * sw[1]); o.y = pk2(d[2] * rstd * sw[2], d[3] * rstd * sw[3]); o.z = pk2(d[4] * rstd * sw[4], d[5] * rstd * sw[5]); o.w = pk2(d[6] * rstd * sw[6], d[7] * rstd * sw[7]);
        const int h = 2 * j + (lane >> 5);
        if ((lane & 16) == 0) *(GAS v4u*)(mix + pg8::toff(row, h * 128 + vb, DM / 64)) = o;
    }
    f32x4 r[4]; float s = 0.f;
#pragma unroll
    for (int j = 0; j < 4; ++j) { const v2u rw = P.r[j]; r[j] = (f32x4){__builtin_bit_cast(float, rw.x << 16), __builtin_bit_cast(float, rw.x & 0xffff0000u), __builtin_bit_cast(float, rw.y << 16), __builtin_bit_cast(float, rw.y & 0xffff0000u)};
        s += (r[j].x * r[j].x + r[j].y * r[j].y) + (r[j].z * r[j].z + r[j].w * r[j].w); }
    const float rstd = __builtin_amdgcn_rsqf(wave_sum(s, lane) * (1.f / HW) + NORM_EPS);
#pragma unroll
    for (int j = 0; j < 4; ++j) { const int col = 4 * lane + 256 * j; const v2u graw = P.g[j];
        float g[4] = { __builtin_bit_cast(float, graw.x << 16), __builtin_bit_cast(float, graw.x & 0xffff0000u), __builtin_bit_cast(float, graw.y << 16), __builtin_bit_cast(float, graw.y & 0xffff0000u) };
        float o[4];
#pragma unroll
        for (int e = 0; e < 4; ++e) { const float sg = g[e] * __builtin_amdgcn_rcpf(1.0f + __expf(-g[e])); o[e] = r[j][e] * rstd * gw[j][e] * sg; }
        v2u ov; ov.x = pk2(o[0], o[1]); ov.y = pk2(o[2], o[3]);
        *(GAS v2u*)(mix + pg8::toff(row, 1024 + col, DM / 64)) = ov; }
}

__device__ __forceinline__ float hgrn_lb(const float* lbsrc, int layer, int ch) { return layer == 0 ? 0.f : 1.0f / (1.0f + __expf(lbsrc[ch] - lbsrc[HW + ch])); }

typedef float lbraw_t __attribute__((ext_vector_type(2)));
__device__ __forceinline__ lbraw_t lb_load(const float* lbsrc, int layer, int ch) { lbraw_t r = {0.f, 0.f}; if (layer != 0) { r.x = lbsrc[ch]; r.y = lbsrc[HW + ch]; } return r; }
__device__ __forceinline__ float lb_val(int layer, lbraw_t r) { return layer == 0 ? 0.f : 1.0f / (1.0f + __expf(r.x - r.y)); }
__device__ __forceinline__ void hgrn_naive_item(int item, const bf16* proj, float* rec, const float* lbsrc, int layer, LAS unsigned char* lds, int tid) {
    typedef float f32x2 __attribute__((ext_vector_type(2)));
    LAS f32x2* tile = (LAS f32x2*)lds;
    const int b = item >> 3, h = item & 7, lane = tid & 63, wave = tid >> 6;
    const int k = tid & 127, tq = tid >> 7;
    const float lb = hgrn_lb(lbsrc, layer, h * 128 + k);
    float S[128];
#pragma unroll
    for (int i = 0; i < 128; ++i) S[i] = 0.f;
    for (int tb = 0; tb < SEQ / 64; ++tb) {
        const size_t row0 = (size_t)b * SEQ + (size_t)tb * 64;
#pragma unroll 4
        for (int j = 0; j < 16; ++j) { const int t = tq + 4 * j; const bf16* pr = proj + (row0 + t) * INW + h * 128 + k;
            const float z = bf2f(pr[C_FH]), q = bf2f(pr[C_QH]); const float f = lb + (1.0f - lb) / (1.0f + __expf(-z));
            tile[t * 128 + k] = (f32x2){f, q}; }
        __syncthreads();
        if (wave < 2) { const int v = wave * 64 + lane;
            for (int t = 0; t < 64; ++t) { const float iv = bf2f(proj[(row0 + t) * INW + C_IH + h * 128 + v]); float o = 0.f;
#pragma unroll
                for (int kk = 0; kk < 128; ++kk) { const f32x2 fq = tile[t * 128 + kk]; S[kk] = fq.x * (S[kk] - iv) + iv; o += fq.y * S[kk]; }
                rec[(row0 + t) * HW + h * 128 + v] = o; } }
        __syncthreads();
    }
}

constexpr int HG_TOT = 0, HG_A1 = 2048, HG_A2 = HG_A1 + 64 * 272, HG_B1 = HG_A2 + 64 * 272, HG_VT = HG_B1 + 64 * 272, HG_P = HG_VT + 128 * 144, HG_END = HG_P + 64 * 144;
constexpr int HG_B3T = 2048;
static_assert(HG_B3T + 128 * 144 <= HG_VT && HG_END <= RING_BYTES, "HGRN LDS map");
struct HgRaw { unsigned zq[16], vv[8]; };
template <int PASS>
__device__ __forceinline__ void hg_load(HgRaw& R, int unit, const bf16* proj, int tid) {
    const int bh = unit >> 7, c = unit & 127, b = bh >> 3, h = bh & 7; const size_t row0 = (size_t)b * SEQ + (size_t)c * 64; const int k = tid & 127, tg = tid >> 7;
    const bf16* pz = proj + (row0 + 16 * tg) * INW + h * 128 + k;
#pragma unroll
    for (int j = 0; j < 16; ++j) { const unsigned z = pz[(size_t)j * INW + C_FH]; const unsigned q = (PASS == 3) ? pz[(size_t)j * INW + C_QH] : 0u; R.zq[j] = z | (q << 16); }
#pragma unroll
    for (int j = 0; j < 8; ++j) { const unsigned a = pz[(size_t)(2 * j) * INW + C_IH], b2 = pz[(size_t)(2 * j + 1) * INW + C_IH]; R.vv[j] = a | (b2 << 16); }
}
template <int PASS>
__device__ __forceinline__ void hgrn_chunk_unit(const HgRaw& R, int unit, const bf16* proj, bf16* Lbuf, float* dec, const bf16* ST, bf16* rec, float lb, LAS unsigned char* lds, int tid) {
    const int bh = unit >> 7, c = unit & 127, b = bh >> 3, h = bh & 7;
    const size_t row0 = (size_t)b * SEQ + (size_t)c * 64;
    const int k = tid & 127, tg = tid >> 7, lane = tid & 63, w = __builtin_amdgcn_readfirstlane(tid >> 6), fr = lane & 15, fq = lane >> 4;
    LAS float* TOT = (LAS float*)(lds + HG_TOT);
    float bcum[16], kk[16], qv[16];
    {   float run = 0.f;
#pragma unroll
        for (int j = 0; j < 16; ++j) { const float z = __builtin_bit_cast(float, R.zq[j] << 16);
            if (PASS == 3) qv[j] = __builtin_bit_cast(float, R.zq[j] & 0xffff0000u);
            const float e = __expf(-z); const float sg = __builtin_amdgcn_rcpf(1.0f + e);
            const float f = fmaxf(lb + (1.0f - lb) * sg, 1e-26f);
            kk[j] = (1.0f - lb) * (e * sg);
            run += 0.69314718056f * __builtin_amdgcn_logf(f); bcum[j] = run; }
        TOT[tg * 128 + k] = run;
    }
    {   v4u o0, o1;
        o0.x = R.vv[0]; o0.y = R.vv[1]; o0.z = R.vv[2]; o0.w = R.vv[3]; o1.x = R.vv[4]; o1.y = R.vv[5]; o1.z = R.vv[6]; o1.w = R.vv[7];
        *(LAS v4u*)(lds + HG_VT + k * 144 + tg * 32) = o0; *(LAS v4u*)(lds + HG_VT + k * 144 + tg * 32 + 16) = o1;
    }
    __syncthreads();
    const float t0 = TOT[k], t1 = TOT[128 + k], t2 = TOT[256 + k], t3 = TOT[384 + k];
    const float off = (tg > 0 ? t0 : 0.f) + (tg > 1 ? t1 : 0.f) + (tg > 2 ? t2 : 0.f);
    const float blast = (t0 + t1) + (t2 + t3);
    if (PASS == 1) {
        unsigned pkd[8];
#pragma unroll
        for (int j = 0; j < 16; j += 2) pkd[j >> 1] = pk2(kk[j] * __expf(blast - (off + bcum[j])), kk[j + 1] * __expf(blast - (off + bcum[j + 1])));
        *(LAS v4u*)(lds + HG_B3T + k * 144 + tg * 32) = (v4u){pkd[0], pkd[1], pkd[2], pkd[3]};
        *(LAS v4u*)(lds + HG_B3T + k * 144 + tg * 32 + 16) = (v4u){pkd[4], pkd[5], pkd[6], pkd[7]};
        if (tg == 0) dec[(size_t)unit * 128 + k] = __expf(blast);
        __syncthreads();
        bf16x8 yv[2];
#pragma unroll
        for (int ks = 0; ks < 2; ++ks) yv[ks] = *(const LAS bf16x8*)(lds + HG_VT + (16 * w + fr) * 144 + ks * 64 + fq * 16);
        bf16* Lu = Lbuf + (size_t)unit * 16384 + (size_t)(16 * w + fr) * 128 + 4 * fq;
#pragma unroll
        for (int xb = 0; xb < 8; ++xb) { f32x4 acc = {0.f, 0.f, 0.f, 0.f};
#pragma unroll
            for (int ks = 0; ks < 2; ++ks) { const bf16x8 xv = *(const LAS bf16x8*)(lds + HG_B3T + (16 * xb + fr) * 144 + ks * 64 + fq * 16);
                acc = __builtin_amdgcn_mfma_f32_16x16x32_bf16(xv, yv[ks], acc, 0, 0, 0); }
            *(GAS v2u*)(Lu + 16 * xb) = (v2u){pk2(acc[0], acc[1]), pk2(acc[2], acc[3])}; }
    } else {
        const float r = t0 + t1;
#pragma unroll
        for (int j = 0; j < 16; ++j) { const float bj = off + bcum[j]; const int t = 16 * tg + j;
            const float a1 = qv[j] * __expf(fminf(bj - r, 80.f)), a2 = qv[j] * __expf(bj), b1 = kk[j] * __expf(fminf(r - bj, 80.f));
            const unsigned w12 = pk2(a1, a2), w3 = pk2(b1, b1);
            *(LAS unsigned short*)(lds + HG_A1 + t * 272 + k * 2) = (unsigned short)w12;
            *(LAS unsigned short*)(lds + HG_A2 + t * 272 + k * 2) = (unsigned short)(w12 >> 16);
            *(LAS unsigned short*)(lds + HG_B1 + t * 272 + k * 2) = (unsigned short)w3; }
        bf16x8 sx[4];
#pragma unroll
        for (int ks = 0; ks < 4; ++ks) sx[ks] = *(const GAS bf16x8*)(ST + (size_t)unit * 16384 + (size_t)(16 * w + fr) * 128 + 32 * ks + 8 * fq);
        __syncthreads();
#pragma unroll
        for (int rep = 0; rep < 2; ++rep) { const int id = w + 8 * rep, sb = id >> 2, tb = id & 3;
            f32x4 acc = {0.f, 0.f, 0.f, 0.f};
            if (sb <= tb) {
#pragma unroll
                for (int ks = 0; ks < 4; ++ks) { const bf16x8 xv = *(const LAS bf16x8*)(lds + HG_B1 + (16 * sb + fr) * 272 + ks * 64 + fq * 16);
                    const bf16x8 yv = *(const LAS bf16x8*)(lds + HG_A1 + (16 * tb + fr) * 272 + ks * 64 + fq * 16);
                    acc = __builtin_amdgcn_mfma_f32_16x16x32_bf16(xv, yv, acc, 0, 0, 0); }
            }
            const int t = 16 * tb + fr, s0 = 16 * sb + 4 * fq;
            float pvv[4];
#pragma unroll
            for (int i = 0; i < 4; ++i) pvv[i] = (sb <= tb && s0 + i <= t) ? acc[i] : 0.f;
            *(LAS v2u*)(lds + HG_P + t * 144 + s0 * 2) = (v2u){pk2(pvv[0], pvv[1]), pk2(pvv[2], pvv[3])}; }
        __syncthreads();
        bf16x8 vx[2];
#pragma unroll
        for (int ks = 0; ks < 2; ++ks) vx[ks] = *(const LAS bf16x8*)(lds + HG_VT + (16 * w + fr) * 144 + ks * 64 + fq * 16);
#pragma unroll
        for (int tb = 0; tb < 4; ++tb) { f32x4 acc = {0.f, 0.f, 0.f, 0.f};
#pragma unroll
            for (int ks = 0; ks < 2; ++ks) { const bf16x8 yv = *(const LAS bf16x8*)(lds + HG_P + (16 * tb + fr) * 144 + ks * 64 + fq * 16);
                acc = __builtin_amdgcn_mfma_f32_16x16x32_bf16(vx[ks], yv, acc, 0, 0, 0); }
#pragma unroll
            for (int ks = 0; ks < 4; ++ks) { const bf16x8 yv = *(const LAS bf16x8*)(lds + HG_A2 + (16 * tb + fr) * 272 + ks * 64 + fq * 16);
                acc = __builtin_amdgcn_mfma_f32_16x16x32_bf16(sx[ks], yv, acc, 0, 0, 0); }
            *(GAS v2u*)(rec + (row0 + 16 * tb + fr) * HW + h * 128 + 16 * w + 4 * fq) = (v2u){pk2(acc[0], acc[1]), pk2(acc[2], acc[3])}; }
    }
    __syncthreads();
}
__device__ __forceinline__ void hgrn_scan(int gtid, int nthreads, const bf16* Lbuf, const float* dec, bf16* ST) {
    typedef float f32x2 __attribute__((ext_vector_type(2)));
    for (int idx = gtid; idx < 16 * 8192; idx += nthreads) {
        const int bh = idx >> 13, e2 = (idx & 8191) * 2, kq = e2 & 127;
        const unsigned* Lp = (const unsigned*)(Lbuf + (size_t)bh * 128 * 16384 + e2); const float* dp = dec + (size_t)bh * 128 * 128 + kq; unsigned* sp = (unsigned*)(ST + (size_t)bh * 128 * 16384 + e2);
        f32x2 S = {0.f, 0.f};
#pragma unroll 8
        for (int c = 0; c < 128; ++c) { const unsigned lw = Lp[(size_t)c * 8192]; const f32x2 lv = {__builtin_bit_cast(float, lw << 16), __builtin_bit_cast(float, lw & 0xffff0000u)}; const f32x2 d = *(const GAS f32x2*)(dp + c * 128);
            sp[(size_t)c * 8192] = pk2(S.x, S.y); S = d * S + lv; }
    }
}

__device__ __forceinline__ void rstd_table(LAS float* tab, const float* ssq, int pm, float inv_n, float eps, int tid) {
    const int r = tid >> 1, hf = tid & 1; const f32x4* p = (const f32x4*)(ssq + (size_t)(pm * 256 + r) * 32 + hf * 16);
    const f32x4 a = p[0], b = p[1], c = p[2], d = p[3];
    const float q0 = ((a[0] + a[1]) + (a[2] + a[3])) + ((b[0] + b[1]) + (b[2] + b[3])), q1 = ((c[0] + c[1]) + (c[2] + c[3])) + ((d[0] + d[1]) + (d[2] + d[3]));
    float s = q0 + q1; s += shx(s, tid & 63, 1);
    if (hf == 0) tab[r] = __builtin_amdgcn_rsqf(s * inv_n + eps);
    __syncthreads();
}
#ifndef GEMM_ALIGN
#define GEMM_ALIGN true
#endif
#ifndef GEMM_SP2
#define GEMM_SP2 true
#endif
constexpr int PH_PER_LAYER = 13, N_PHASES = 2 * PH_PER_LAYER + 1;

__global__ void __launch_bounds__(NTHREADS, 2) hymba_fwd(Args args) {
    extern __shared__ __attribute__((aligned(16))) unsigned char lds_raw[];
    LAS unsigned char* lds = (LAS unsigned char*)lds_raw;
    cg::grid_group grid = cg::this_grid();
    const int G = gridDim.x, bx = blockIdx.x;
    const int vcu = (G % 8 == 0) ? (bx % 8) * (G / 8) + bx / 8 : bx;
    const int NGW = G * NWAVES;
    unsigned char* ws = args.ws;
    const float* x_in = args.in[0];
    float* xres = args.out;
    bf16* XN = (bf16*)(ws + WS_XN); bf16* MIX = (bf16*)(ws + WS_MIX); bf16* BIG = (bf16*)(ws + WS_BIG); bf16* ATTO = (bf16*)(ws + WS_ATTO);
    float* SSQ = (float*)(ws + WS_SSQ);
    bf16* REC = (bf16*)xres; bf16* LBUF = (bf16*)xres;     bf16* ST = (bf16*)(ws + WS_ST); float* DEC = (float*)(ws + WS_DEC);
    bf16* Wgu1 = (bf16*)(ws + WS_WGU1); bf16* Wd1 = (bf16*)(ws + WS_WD1); bf16* Win = (bf16*)(ws + WS_WIN); bf16* Wout = (bf16*)(ws + WS_WOUT); bf16* Wgu2 = (bf16*)(ws + WS_WGU2); bf16* Wd2 = (bf16*)(ws + WS_WD2);

    LAS float* RTAB = (LAS float*)(lds + RING_BYTES + 1024);
    unsigned* barw = (unsigned*)(ws + WS_BAR);
    volatile LAS unsigned* bst = (volatile LAS unsigned*)(lds + RING_BYTES);
    if (threadIdx.x < 2) bst[threadIdx.x] = 0u;
    if (bx == 0 && args.ph_lo == 0) for (int i = threadIdx.x; i < 4096; i += NTHREADS) __hip_atomic_store(barw + i, 0u, __ATOMIC_RELAXED, __HIP_MEMORY_SCOPE_AGENT);
    __syncthreads();
#ifdef PROBE_MASK
    int probe_rep = 0;
#endif
    XcdBarrier xbar; xbar.bar = barw; xbar.x = 0; xbar.st = bst;
    for (int ph = args.ph_lo; ph < args.ph_hi; ++ph) {
        const int layer = ph / PH_PER_LAYER, p = (ph == N_PHASES - 1) ? 99 : ph % PH_PER_LAYER;
        if (p == 3 || p == 10 || (p == 8 && !HGRN_NAIVE)) continue;
        int tid_o = threadIdx.x; asm volatile("" : "+v"(tid_o));
        const int tid = tid_o;
#define PHASE_IDS const int lane = tid & 63, wave = __builtin_amdgcn_readfirstlane(tid >> 6), gw = vcu * NWAVES + wave; (void)lane; (void)wave; (void)gw;
        switch (p) {
        case 0: {
            PHASE_IDS
            LAS float* scr = (LAS float*)(lds + wave * 16384);
            const float* g1 = args.in[2] + (size_t)layer * DM * DFF; const float* u1 = args.in[3] + (size_t)layer * DM * DFF; const float* d1 = args.in[4] + (size_t)layer * DFF * DM;
            const float* wi = args.in[6] + (size_t)layer * DM * INW; const float* wo = args.in[14] + (size_t)layer * DM * DM;
            const float* g2 = args.in[16] + (size_t)layer * DM * DFF; const float* u2 = args.in[17] + (size_t)layer * DM * DFF; const float* d2 = args.in[18] + (size_t)layer * DFF * DM;
            const float* nw1 = args.in[1] + (size_t)layer * DM; const float* nw2 = args.in[5] + (size_t)layer * DM; const float* nw3 = args.in[15] + (size_t)layer * DM;
            constexpr int I_F = (DM / 64) * (DFF / 32), I_IN = (DM / 64) * (INW / 32), I_OUT = (DM / 64) * (DM / 32);
            constexpr int NITEMS = 6 * I_F + I_IN + I_OUT;
            for (int it = gw; it < NITEMS; it += NGW) {
                int r = it;
                if (r < I_F) { transpose_item(g1, DM, DFF, Wgu1, 1, nw1, scr, r, lane); continue; } r -= I_F;
                if (r < I_F) { transpose_item(u1, DM, DFF, Wgu1, 2, nw1, scr, r, lane); continue; } r -= I_F;
                if (r < I_F) { transpose_item(d1, DFF, DM, Wd1, 0, nullptr, scr, r, lane); continue; } r -= I_F;
                if (r < I_IN) { transpose_item(wi, DM, INW, Win, 0, nw2, scr, r, lane); continue; } r -= I_IN;
                if (r < I_OUT) { transpose_item(wo, DM, DM, Wout, 0, nullptr, scr, r, lane); continue; } r -= I_OUT;
                if (r < I_F) { transpose_item(g2, DM, DFF, Wgu2, 1, nw3, scr, r, lane); continue; } r -= I_F;
                if (r < I_F) { transpose_item(u2, DM, DFF, Wgu2, 2, nw3, scr, r, lane); continue; } r -= I_F;
                transpose_item(d2, DFF, DM, Wd2, 0, nullptr, scr, r, lane);
            }
            if (ph == 0) for (int m = gw; m < M; m += NGW) row_to_bf16_ssq(x_in + (size_t)m * DM, XN, m, SSQ + (size_t)m * 32, lane);
        } break;
        case 1: case 11: {
            pg8::Gemm g{XN, p == 1 ? Wgu1 : Wgu2, M, 2 * DFF, DM}; pg8::StaticOrder S; S.init(M, 2 * DFF, G, bx);
            const float* sq = SSQ + (size_t)(layer * 3 + (p == 1 ? 0 : 2)) * M * 32; pg8::Unit u0; S.next(0, u0); rstd_table(RTAB, sq, u0.pm, 1.0f / DM, NORM_EPS, tid);
            pg8::EpiSwiGLU E{BIG, DFF, sq, 1.0f / DM, NORM_EPS, RTAB, u0.pm};
            pg8::gemm_phase<pg8::EpiSwiGLU, pg8::StaticOrder, GEMM_ALIGN, GEMM_SP2>(lds, g, S, E);
        } break;
        case 2: case 12: case 9: {
            const bf16* A = (p == 9) ? MIX : BIG; const bf16* Bt = (p == 2) ? Wd1 : (p == 12) ? Wd2 : Wout; const int K = (p == 9) ? DM : DFF;
            pg8::Gemm g{A, Bt, M, DM, K}; pg8::StaticOrder S; S.init(M, DM, G, bx);
            pg8::EpiResidual E{XN, SSQ + (size_t)(layer * 3 + (p == 2 ? 1 : p == 9 ? 2 : 3)) * M * 32, DM, (p == 9) ? 1.0f : 0.5f};
            pg8::gemm_phase<pg8::EpiResidual, pg8::StaticOrder, GEMM_ALIGN, GEMM_SP2>(lds, g, S, E);
        } break;
        case 4: {
            pg8::Gemm g{XN, Win, M, INW, DM}; pg8::StaticOrder S; S.init(M, INW, G, bx);
            const float* sq = SSQ + (size_t)(layer * 3 + 1) * M * 32; pg8::Unit u0; S.next(0, u0); rstd_table(RTAB, sq, u0.pm, 1.0f / DM, NORM_EPS, tid);
            pg8::EpiProj E{BIG, INW, sq, 1.0f / DM, NORM_EPS, AW, attn_body::C2, RTAB, u0.pm};
            pg8::gemm_phase<pg8::EpiProj, pg8::StaticOrder, GEMM_ALIGN, GEMM_SP2>(lds, g, S, E);
        } break;
        case 5: {
            for (int i = vcu; i < 256; i += G) {
                const int gsel = i >> 3, s = i & 7; const int b = gsel >> 4, hc = gsel & 15, h = hc >> 1;
                for (int qi = 0; qi < 4; ++qi) { const int qb = (qi == 0) ? s : (qi == 1) ? 15 - s : (qi == 2) ? 16 + s : 31 - s;
                    attn_body::attn_unit<8>(b, C_QA + hc * 64, C_KA + hc * 64, C_VA + h * 128, hc * 128, qb, (const attn_body::bf16*)BIG, (attn_body::bf16*)ATTO, (char*)lds_raw); }
            }
            {   int tid2 = tid; asm volatile("" : "+v"(tid2));
#define tid tid2
                HgRaw cur, nxt; const int u0 = vcu < 2048 ? vcu : 2047; hg_load<1>(cur, u0, BIG, tid);
                lbraw_t lbc = lb_load(args.in[12], layer, ((u0 >> 7) & 7) * 128 + (tid & 127)), lbn;
                for (int u = vcu; u < 2048; u += G) { const int un = u + G < 2048 ? u + G : u; hg_load<1>(nxt, un, BIG, tid); lbn = lb_load(args.in[12], layer, ((un >> 7) & 7) * 128 + (tid & 127));
                    hgrn_chunk_unit<1>(cur, u, BIG, LBUF, DEC, ST, REC, lb_val(layer, lbc), lds, tid); cur = nxt; lbc = lbn; } }
#undef tid
        } break;
        case 6: {
#if HGRN_NAIVE
            for (int item = bx; item < 16; item += G) hgrn_naive_item(item, BIG, REC, args.in[12], layer, lds, tid);
#else
            hgrn_scan(bx * NTHREADS + tid, G * NTHREADS, LBUF, DEC, ST);
#endif
        } break;
        case 7: {
#if !HGRN_NAIVE
            {
                PHASE_IDS
                const float sa = wave_sum(args.in[7][layer * 64 + lane] * args.in[8][layer * 64 + lane], lane), sb = wave_sum(args.in[9][layer * 64 + lane] * args.in[10][layer * 64 + lane], lane);
                const float li = lambda_init_of(layer), lam = __expf(sa) - __expf(sb) + li;
                for (int bc = vcu; bc < 256; bc += G) { const int b = bc >> 7, c = bc & 127;
                    lbraw_t lb_cur = lb_load(args.in[12], layer, (tid & 127)), lb_nxt;
                    HgRaw cur, nxt; hg_load<3>(cur, (b * 8) * 128 + c, BIG, tid);
                    for (int h = 0; h < 8; ++h) { const int u = (b * 8 + h) * 128 + c; hg_load<3>(nxt, h < 7 ? u + 128 : u, BIG, tid); lb_nxt = lb_load(args.in[12], layer, (h < 7 ? h + 1 : h) * 128 + (tid & 127));
                        hgrn_chunk_unit<3>(cur, u, BIG, LBUF, DEC, ST, REC, lb_val(layer, lb_cur), lds, tid); cur = nxt; lb_cur = lb_nxt; }
                    asm volatile("s_waitcnt vmcnt(0)" ::: "memory"); __syncthreads();
                    const int row0 = b * SEQ + c * 64 + wave * 8;
                    float sw[8]; f32x4 gw[4];
#pragma unroll
                    for (int e = 0; e < 8; ++e) sw[e] = args.in[11][layer * 128 + (lane & 15) * 8 + e] * (1.0f - li);
#pragma unroll
                    for (int j = 0; j < 4; ++j) gw[j] = *(const GAS f32x4*)(args.in[13] + (size_t)layer * HW + 4 * lane + 256 * j);
                    PmRaw pc, pn; pm_load(pc, row0, ATTO, REC, BIG, lane);
                    for (int i = 0; i < 8; ++i) { pm_load(pn, row0 + (i < 7 ? i + 1 : i), ATTO, REC, BIG, lane); pm_compute(pc, row0 + i, lam, sw, gw, MIX, lane); pc = pn; }
                }
            }
#endif
        } break;
        default: {
            PHASE_IDS
            for (int m = gw; m < M; m += NGW) rms_row_bf16_to_f32(XN, m, xres + (size_t)m * DM, args.in[19], lane);
        } break;
        }
        if (ph + 1 < args.ph_hi) {
            if (ph == args.ph_lo) { grid.sync(); xbar = xcd_barrier_post(barw, bst); }
            else xcd_barrier(xbar);
        }
#ifdef PROBE_MASK
        if (p < 32 && ((PROBE_MASK >> p) & 1) && !probe_rep && ph != args.ph_lo) { probe_rep = 1; --ph; } else probe_rep = 0;
#endif
    }
}

#ifndef HGRN_NAIVE
#define HGRN_NAIVE 0
#endif
#ifndef N_LAUNCH_MODE
#define N_LAUNCH_MODE 1
#endif
extern "C" void kernel_launch(void* const* d_in, const int* in_sizes, int n_in, void* d_out, int out_size, void* d_ws, size_t ws_size, hipStream_t stream) {
    static int grid = 0;
    if (grid == 0) {
        if (n_in != 20 || out_size != M * DM || ws_size < WS_END) { fprintf(stderr, "kernel_launch: unexpected shapes (n_in %d out %d ws %zu need %zu)\n", n_in, out_size, ws_size, (size_t)WS_END); grid = -1; return; }
        int dev = 0, cus = 0, per_cu = 0;
        (void)hipGetDevice(&dev); (void)hipDeviceGetAttribute(&cus, hipDeviceAttributeMultiprocessorCount, dev);
        if (hipFuncSetAttribute((const void*)hymba_fwd, hipFuncAttributeMaxDynamicSharedMemorySize, LDS_BYTES) != hipSuccess) { fprintf(stderr, "kernel_launch: hipFuncSetAttribute failed\n"); grid = -1; return; }
        if (hipOccupancyMaxActiveBlocksPerMultiprocessor(&per_cu, (const void*)hymba_fwd, NTHREADS, LDS_BYTES) != hipSuccess || per_cu < 1) { fprintf(stderr, "kernel_launch: occupancy query says %d\n", per_cu); per_cu = 1; }
        (void)hipGetLastError();
        grid = cus;
    }
    if (grid < 0) return;
    Args a{};
    for (int i = 0; i < 20; ++i) a.in[i] = (const float*)d_in[i];
    a.out = (float*)d_out; a.ws = (unsigned char*)d_ws;
#if N_LAUNCH_MODE == 1
    a.ph_lo = 0; a.ph_hi = N_PHASES;
    { void* kargs[] = {&a}; hipError_t e = hipLaunchCooperativeKernel((const void*)hymba_fwd, dim3(grid), dim3(NTHREADS), kargs, LDS_BYTES, stream);
      if (e != hipSuccess) fprintf(stderr, "cooperative launch failed: %s (grid %d)\n", hipGetErrorString(e), grid); }
#else
    for (int ph = 0; ph < N_PHASES; ++ph) { if (ph % PH_PER_LAYER == 7) continue; a.ph_lo = ph; a.ph_hi = ph + 1;
        void* kargs[] = {&a}; hipError_t e = hipLaunchCooperativeKernel((const void*)hymba_fwd, dim3(grid), dim3(NTHREADS), kargs, LDS_BYTES, stream);
        if (e != hipSuccess) { fprintf(stderr, "cooperative launch %d failed: %s (grid %d)\n", ph, hipGetErrorString(e), grid); break; } }
#endif
}
```

```cpp
#include <hip/hip_runtime.h>
#include <hip/hip_bf16.h>
#include <hip/hip_cooperative_groups.h>
#include <cstdio>
#include <cstdint>
#include <cmath>
namespace cg = cooperative_groups;
namespace pg8 {
#define PG8_LAS __attribute__((address_space(3)))
typedef unsigned short bf16_t;
typedef short bf16x8 __attribute__((ext_vector_type(8)));
typedef float f32x4 __attribute__((ext_vector_type(4)));
typedef unsigned u32x4 __attribute__((ext_vector_type(4)));
constexpr int BM = 256, BK = 64, HALF = 128, HTB = HALF * BK * 2  , STAGE_BYTES = 8 * HTB, NXCD = 8, WGM = 8;

__host__ __device__ __forceinline__ int lds_byte(int r, int c) { const int st = (r >> 4) * 2 + (c >> 5), rr = r & 15, cc = c & 31, ob = rr * 64 + cc * 2; return st * 1024 + (ob ^ (((ob >> 9) & 1) << 5)); }
__host__ __device__ __forceinline__ void stage_rc(int b, int& R, int& C) { const int st = b / 1024, sb = b % 1024, swz = sb ^ (((sb >> 9) & 1) << 5); R = (st >> 1) * 16 + swz / 64; C = (st & 1) * 32 + (swz % 64) / 2; }
__host__ __device__ __forceinline__ int perm32(int rho) { const int n = rho >> 4, i = rho & 15; return 8 * (i >> 2) + 4 * n + (i & 3); }

struct Unit { int pm, pn; };
__host__ __device__ __forceinline__ size_t toff(int m, int k, int nt) { return ((size_t)((m >> 8) * nt + (k >> 6)) * 256 + (m & 255)) * 64 + (k & 63); }
struct Gemm { const bf16_t* A; const bf16_t* Bt; int M, N, K; };

struct StaticOrder {
    int nM, nN, nwg, G, c;
    __host__ __device__ void init(int M, int N, int G_, int c_) { nM = M / BM; nN = N / BM; nwg = nM * nN; G = G_; c = c_; }
    __host__ __device__ bool next(int i, Unit& u) const {
        const long L = (long)i * G + c; if (L >= nwg) return false;
        int wgid = (int)L; { const int q = nwg / NXCD, r = nwg % NXCD, xcd = wgid % NXCD, off = wgid / NXCD; wgid = (xcd < r ? xcd * (q + 1) : r * (q + 1) + (xcd - r) * q) + off; }
        const int nig = WGM * nN, gid = wgid / nig, fm = gid * WGM, gsz = (nM - fm) < WGM ? (nM - fm) : WGM;
        u.pm = fm + ((wgid % nig) % gsz); u.pn = (wgid % nig) / gsz; return true;
    }
    __device__ __forceinline__ void a_ready(const Unit&) const {}
    __device__ __forceinline__ void done(const Unit&) const {}
};

__device__ __forceinline__ unsigned cvt_pk_bf16(float lo, float hi) { unsigned r; asm volatile("v_cvt_pk_bf16_f32 %0, %1, %2" : "=v"(r) : "v"(lo), "v"(hi)); return r; }
typedef float f32x2 __attribute__((ext_vector_type(2)));
__device__ __forceinline__ f32x2 gelu_pk(f32x2 v) {
    const f32x2 av = __builtin_elementwise_abs(v), d = av * 0.2316418882f + 1.0f;
    f32x2 t; t.x = __builtin_amdgcn_rcpf(d.x); t.y = __builtin_amdgcn_rcpf(d.y);
    f32x2 q = t * 0.5307027145f + (-0.7265760135f); q = q * t + 0.7107068705f; q = q * t + (-0.142248368f); q = q * t + 0.127414796f; q = q * t;
    const f32x2 s = (v * v) * (-0.72134752044f);
    f32x2 e; e.x = __builtin_amdgcn_exp2f(s.x); e.y = __builtin_amdgcn_exp2f(s.y);
    const f32x2 m = v * (q * e), r = v - m;
    f32x2 o; o.x = v.x < 0.f ? m.x : r.x; o.y = v.y < 0.f ? m.y : r.y; return o;
}

template <int ACT  > struct EpiBf16 {
    static constexpr bool PERM = true, AFTER_DRAIN = false; static_assert(ACT == 0 || ACT == 1, "EpiBf16: ACT is 0 (none) or 1 (gelu_pk)");
    bf16_t* O; int ldc; const float* bias; int split_cols; size_t split_stride; float scale0;
    __device__ __forceinline__ void operator()(const f32x4 (&acc)[2][2][4][2], const Unit& u, int wr, int wc, int fr, int fq) const {
        const int row0 = u.pm * BM + wr * 64 + fr; int colt = u.pn * BM; bf16_t* base = O;
        float sc = 1.f; if (split_cols) { const int t = colt / split_cols; base += (size_t)t * split_stride; colt -= t * split_cols; if (t == 0) sc = scale0; }
        const int col0 = colt + wc * 32 + 8 * fq, bcol0 = u.pn * BM + wc * 32 + 8 * fq;
        f32x4 bv[2][2];
#pragma unroll
        for (int bj = 0; bj < 2; ++bj)
#pragma unroll
            for (int n = 0; n < 2; ++n) bv[bj][n] = bias ? *(const f32x4*)(bias + bcol0 + bj * HALF + 4 * n) : (f32x4){0.f, 0.f, 0.f, 0.f};
#pragma unroll
        for (int ai = 0; ai < 2; ++ai)
#pragma unroll
            for (int m = 0; m < 4; ++m) { bf16_t* rowp = base + (size_t)(row0 + ai * HALF + m * 16) * ldc + col0;
#pragma unroll
                for (int bj = 0; bj < 2; ++bj) { f32x4 v0 = acc[ai][bj][m][0] + bv[bj][0], v1 = acc[ai][bj][m][1] + bv[bj][1];
                    if (ACT == 1) { f32x2 a = gelu_pk((f32x2){v0[0], v0[1]}), b = gelu_pk((f32x2){v0[2], v0[3]}), c = gelu_pk((f32x2){v1[0], v1[1]}), d = gelu_pk((f32x2){v1[2], v1[3]});
                        v0 = (f32x4){a.x, a.y, b.x, b.y}; v1 = (f32x4){c.x, c.y, d.x, d.y}; }
                    v0 = v0 * sc; v1 = v1 * sc; u32x4 w; w.x = cvt_pk_bf16(v0[0], v0[1]); w.y = cvt_pk_bf16(v0[2], v0[3]); w.z = cvt_pk_bf16(v1[0], v1[1]); w.w = cvt_pk_bf16(v1[2], v1[3]);
                    *(u32x4*)(rowp + bj * HALF) = w; } }
    }
};
__device__ __forceinline__ float shx(float v, int lane, int m) { return __builtin_bit_cast(float, __builtin_amdgcn_ds_bpermute((lane ^ m) << 2, __builtin_bit_cast(int, v))); }
__device__ __forceinline__ void row_rstd(float (&rs)[2][4], const float* ssq, int row0, int fq, float inv_n, float eps, const PG8_LAS float* tab, int tab_pm, int pm) {
    const int lane = (row0 & 15) + 16 * fq;
    if (pm == tab_pm) {
#pragma unroll
        for (int ai = 0; ai < 2; ++ai)
#pragma unroll
            for (int m = 0; m < 4; ++m) rs[ai][m] = tab[(row0 & 255) + ai * HALF + m * 16];
        return;
    }
#pragma unroll
    for (int ai = 0; ai < 2; ++ai)
#pragma unroll
        for (int m = 0; m < 4; ++m) { const f32x4* p = (const f32x4*)(ssq + (size_t)(row0 + ai * HALF + m * 16) * 32 + fq * 8); const f32x4 a = p[0], b = p[1];
            float s = ((a[0] + a[1]) + (a[2] + a[3])) + ((b[0] + b[1]) + (b[2] + b[3])); s += shx(s, lane, 16); s += shx(s, lane, 32);
            rs[ai][m] = __builtin_amdgcn_rsqf(s * inv_n + eps); }
}
struct EpiSwiGLU {
    static constexpr bool PERM = true, AFTER_DRAIN = false;
    bf16_t* O; int ldc; const float* ssq; float inv_n, eps; const PG8_LAS float* tab; int tab_pm;
    __device__ __forceinline__ void operator()(const f32x4 (&acc)[2][2][4][2], const Unit& u, int wr, int wc, int fr, int fq) const {
        const int row0 = u.pm * BM + wr * 64 + fr; const int col0 = u.pn * HALF + wc * 32 + 8 * fq;
        float rs[2][4]; row_rstd(rs, ssq, row0, fq, inv_n, eps, tab, tab_pm, u.pm);
#pragma unroll
        for (int ai = 0; ai < 2; ++ai)
#pragma unroll
            for (int m = 0; m < 4; ++m) { bf16_t* rowp = O + toff(row0 + ai * HALF + m * 16, col0, ldc >> 6);
                const float r = rs[ai][m]; const f32x2 c1 = {-1.4426950408889634f * r, -1.4426950408889634f * r}, r2 = {r * r, r * r};
                unsigned wv[4];
#pragma unroll
                for (int n = 0; n < 2; ++n)
#pragma unroll
                    for (int e = 0; e < 4; e += 2) { const f32x2 g = {acc[ai][0][m][n][e], acc[ai][0][m][n][e + 1]}, up = {acc[ai][1][m][n][e], acc[ai][1][m][n][e + 1]};
                        const f32x2 t = g * c1; f32x2 d; d.x = __builtin_amdgcn_exp2f(t.x); d.y = __builtin_amdgcn_exp2f(t.y); d = d + 1.0f;
                        f32x2 rc; rc.x = __builtin_amdgcn_rcpf(d.x); rc.y = __builtin_amdgcn_rcpf(d.y);
                        const f32x2 hv = ((g * up) * r2) * rc; wv[n * 2 + (e >> 1)] = cvt_pk_bf16(hv.x, hv.y); }
                u32x4 w; w.x = wv[0]; w.y = wv[1]; w.z = wv[2]; w.w = wv[3];
                *(u32x4*)rowp = w; }
    }
};
struct EpiProj {
    static constexpr bool PERM = true, AFTER_DRAIN = false;
    bf16_t* O; int ldc; const float* ssq; float inv_n, eps; int qcols; float qscale; const PG8_LAS float* tab; int tab_pm;
    __device__ __forceinline__ void operator()(const f32x4 (&acc)[2][2][4][2], const Unit& u, int wr, int wc, int fr, int fq) const {
        const int row0 = u.pm * BM + wr * 64 + fr; const int col0 = u.pn * BM + wc * 32 + 8 * fq;
        float rs[2][4]; row_rstd(rs, ssq, row0, fq, inv_n, eps, tab, tab_pm, u.pm);
        const float cs = (u.pn * BM < qcols) ? qscale : 1.0f;
#pragma unroll
        for (int ai = 0; ai < 2; ++ai)
#pragma unroll
            for (int m = 0; m < 4; ++m) { bf16_t* rowp = O + (size_t)(row0 + ai * HALF + m * 16) * ldc + col0; const float r = rs[ai][m] * cs;
#pragma unroll
                for (int bj = 0; bj < 2; ++bj) { const f32x4 v0 = acc[ai][bj][m][0] * r, v1 = acc[ai][bj][m][1] * r;
                    u32x4 w; w.x = cvt_pk_bf16(v0[0], v0[1]); w.y = cvt_pk_bf16(v0[2], v0[3]); w.z = cvt_pk_bf16(v1[0], v1[1]); w.w = cvt_pk_bf16(v1[2], v1[3]);
                    *(u32x4*)(rowp + bj * HALF) = w; } }
    }
};
struct EpiResidual {
    static constexpr bool PERM = true, AFTER_DRAIN = false;
    bf16_t* xb; float* ssq; int ldc; float alpha;
    __device__ __forceinline__ void operator()(const f32x4 (&acc)[2][2][4][2], const Unit& u, int wr, int wc, int fr, int fq) const {
        const int row0 = u.pm * BM + wr * 64 + fr; const int col0 = u.pn * BM + wc * 32 + 8 * fq;
#pragma unroll
        for (int ai = 0; ai < 2; ++ai) {
            u32x4 bs[4][2];
#pragma unroll
            for (int m = 0; m < 4; ++m) {
#pragma unroll
                for (int bj = 0; bj < 2; ++bj) bs[m][bj] = *(const u32x4*)(xb + toff(row0 + ai * HALF + m * 16, col0 + bj * HALF, ldc >> 6)); }
            asm volatile("" ::: "memory");
#pragma unroll
            for (int m = 0; m < 4; ++m) { const int row = row0 + ai * HALF + m * 16; float ss = 0.f;
#pragma unroll
                for (int bj = 0; bj < 2; ++bj) { const u32x4 b = bs[m][bj];
                    const f32x4 b0 = {__builtin_bit_cast(float, b.x << 16), __builtin_bit_cast(float, b.x & 0xffff0000u), __builtin_bit_cast(float, b.y << 16), __builtin_bit_cast(float, b.y & 0xffff0000u)};
                    const f32x4 b1 = {__builtin_bit_cast(float, b.z << 16), __builtin_bit_cast(float, b.z & 0xffff0000u), __builtin_bit_cast(float, b.w << 16), __builtin_bit_cast(float, b.w & 0xffff0000u)};
                    const f32x4 o0 = b0 + acc[ai][bj][m][0] * alpha, o1 = b1 + acc[ai][bj][m][1] * alpha;
                    ss += (o0[0] * o0[0] + o0[1] * o0[1]) + (o0[2] * o0[2] + o0[3] * o0[3]) + (o1[0] * o1[0] + o1[1] * o1[1]) + (o1[2] * o1[2] + o1[3] * o1[3]);
                    u32x4 w; w.x = cvt_pk_bf16(o0[0], o0[1]); w.y = cvt_pk_bf16(o0[2], o0[3]); w.z = cvt_pk_bf16(o1[0], o1[1]); w.w = cvt_pk_bf16(o1[2], o1[3]);
                    *(u32x4*)(xb + toff(row, col0 + bj * HALF, ldc >> 6)) = w; }
                ss += shx(ss, fr + 16 * fq, 16); ss += shx(ss, fr + 16 * fq, 32);
                if (fq == 0) ssq[(size_t)row * 32 + u.pn * 4 + wc] = ss; }
            asm volatile("" ::: "memory");
        }
    }
};

template <class Epi, class Sched, bool ALIGN_EPI = false, bool SP2 = false>
__device__ __forceinline__ void gemm_phase(PG8_LAS unsigned char* lds, const Gemm g, const Sched& S, const Epi& E) {
    int tid_o = threadIdx.x; asm volatile("" : "+v"(tid_o));
    const int tid = tid_o, wid = __builtin_amdgcn_readfirstlane(tid >> 6), lane = tid & 63, wr = wid >> 2, wc = wid & 3, fr = lane & 15, fq = lane >> 4;
    const int K = g.K, nt = K / BK;
    unsigned voffA[2], voffB[2];
#pragma unroll
    for (int i = 0; i < 2; ++i) { int R, C; stage_rc(tid * 16 + i * 8192, R, C); const int Rb = Epi::PERM ? ((R & ~31) + perm32(R & 31)) : R;
        voffA[i] = (unsigned)(R * BK + C) * 2u; voffB[i] = (unsigned)(Rb * BK + C) * 2u; }
    const size_t kstep = (size_t)(BK * 2), kstepB = (size_t)BM * BK * 2;
    const size_t hstep = (size_t)HALF * K * 2, hstepB = (size_t)HALF * BK * 2;
    const size_t tstep = 2 * hstep;
    const unsigned ldsw = (unsigned)wid * 1024u;
    const int aoff = lds_byte(wr * 64 + fr, fq * 8), boff = lds_byte(wc * 32 + fr, fq * 8);
#define PG8_SA(b, h) (((b) * 2 + (h)) * HTB)
#define PG8_SB(b, h) ((4 + (b) * 2 + (h)) * HTB)
#define PG8_STAGE(bufoff, gbase, voff) do { _Pragma("unroll") for (int _i = 0; _i < 2; ++_i) \
        __builtin_amdgcn_global_load_lds((const unsigned*)((const char*)(gbase) + (voff)[_i]), (PG8_LAS unsigned*)(lds + (bufoff) + ldsw + _i * 8192), 16, 0, 0); } while (0)
#define PG8_LDA(dst, b, h) do { _Pragma("unroll") for (int m = 0; m < 4; ++m) _Pragma("unroll") for (int k = 0; k < 2; ++k) dst[m][k] = *(const PG8_LAS bf16x8*)(lds + PG8_SA(b, h) + aoff + m * 2048 + k * 1024); } while (0)
#define PG8_LDB(dst, b, h) do { _Pragma("unroll") for (int n = 0; n < 2; ++n) _Pragma("unroll") for (int k = 0; k < 2; ++k) dst[n][k] = *(const PG8_LAS bf16x8*)(lds + PG8_SB(b, h) + boff + n * 2048 + k * 1024); } while (0)
#define PG8_MMA(ai, bj, At, Bt) do { __builtin_amdgcn_s_setprio(1); _Pragma("unroll") for (int m = 0; m < 4; ++m) _Pragma("unroll") for (int n = 0; n < 2; ++n) _Pragma("unroll") for (int k = 0; k < 2; ++k) \
        acc[ai][bj][m][n] = __builtin_amdgcn_mfma_f32_16x16x32_bf16(Bt[n][k], At[m][k], acc[ai][bj][m][n], 0, 0, 0); __builtin_amdgcn_s_setprio(0); } while (0)
#define PG8_WAIT_V(n) asm volatile("s_waitcnt vmcnt(" #n ")" ::: "memory")
#define PG8_WAIT_L(n) asm volatile("s_waitcnt lgkmcnt(" #n ")" ::: "memory")
#define PG8_BAR __builtin_amdgcn_s_barrier()
#define PG8_SCHED __builtin_amdgcn_sched_barrier(0)
    Unit cur, nxt; int ui = 0;
    if (!S.next(0, cur)) return;
    f32x4 acc[2][2][4][2];
#pragma unroll
    for (int a = 0; a < 2; ++a)
#pragma unroll
        for (int b = 0; b < 2; ++b)
#pragma unroll
            for (int m = 0; m < 4; ++m)
#pragma unroll
                for (int n = 0; n < 2; ++n) acc[a][b][m][n] = (f32x4){0.f, 0.f, 0.f, 0.f};
    bf16x8 At[4][2], B0[2][2], B1[2][2];
    const char* cA = (const char*)g.A + (size_t)cur.pm * tstep; const char* cB = (const char*)g.Bt + (size_t)cur.pn * tstep;
    S.a_ready(cur);
    if constexpr (SP2) {
        PG8_STAGE(PG8_SB(0, 0), cB, voffB); PG8_STAGE(PG8_SB(0, 1), cB + hstepB, voffB); PG8_STAGE(PG8_SA(0, 0), cA, voffA); PG8_STAGE(PG8_SA(0, 1), cA + hstepB, voffA);
        if (wr == 1) PG8_BAR;
        PG8_WAIT_V(2); PG8_BAR;
        PG8_STAGE(PG8_SB(1, 0), cB + kstepB, voffB); PG8_STAGE(PG8_SA(1, 0), cA + kstepB, voffA); PG8_STAGE(PG8_SB(1, 1), cB + hstepB + kstepB, voffB);
        PG8_WAIT_V(6); PG8_BAR;
    } else {
        PG8_STAGE(PG8_SB(0, 0), cB, voffB); PG8_STAGE(PG8_SA(0, 0), cA, voffA); PG8_STAGE(PG8_SB(0, 1), cB + hstepB, voffB); PG8_STAGE(PG8_SA(0, 1), cA + hstepB, voffA);
        if (wr == 1) PG8_BAR;
        PG8_WAIT_V(4); PG8_BAR;
        PG8_STAGE(PG8_SB(1, 0), cB + kstepB, voffB); PG8_STAGE(PG8_SA(1, 0), cA + kstepB, voffA); PG8_STAGE(PG8_SB(1, 1), cB + hstepB + kstepB, voffB);
        PG8_WAIT_V(6); PG8_BAR;
    }
    for (;;) {
        const bool has_next = S.next(ui + 1, nxt);
        const char* nA = has_next ? (const char*)g.A + (size_t)nxt.pm * tstep : cA; const char* nB = has_next ? (const char*)g.Bt + (size_t)nxt.pn * tstep : cB;
        for (int t = 0; t < nt; t += 2) {
            const bool last = (t == nt - 2);
            const char* a1 = cA + (size_t)(t + 1) * kstepB;
            const char* a2 = last ? nA : cA + (size_t)(t + 2) * kstepB; const char* b2 = last ? nB : cB + (size_t)(t + 2) * kstepB;
            const char* a3 = a2 + kstepB; const char* b3 = b2 + kstepB;
            if (last && has_next) S.a_ready(nxt);
            if constexpr (SP2) {
            PG8_LDB(B0, 0, 0); PG8_LDB(B1, 0, 1); PG8_SCHED; PG8_LDA(At, 0, 0); PG8_STAGE(PG8_SA(1, 1), a1 + hstepB, voffA);
            PG8_WAIT_V(8); PG8_WAIT_L(0); PG8_BAR; PG8_MMA(0, 0, At, B0); PG8_MMA(0, 1, At, B1); PG8_BAR; PG8_SCHED;
            PG8_LDA(At, 0, 1); PG8_STAGE(PG8_SB(0, 0), b2, voffB); PG8_STAGE(PG8_SB(0, 1), b2 + hstepB, voffB); PG8_STAGE(PG8_SA(0, 0), a2, voffA);
            PG8_WAIT_V(8); PG8_WAIT_L(0); PG8_BAR; PG8_MMA(1, 0, At, B0); PG8_MMA(1, 1, At, B1); PG8_BAR; PG8_SCHED;
            PG8_LDB(B0, 1, 0); PG8_LDB(B1, 1, 1); PG8_SCHED; PG8_LDA(At, 1, 0); PG8_STAGE(PG8_SA(0, 1), a2 + hstepB, voffA);
            PG8_WAIT_V(8); PG8_WAIT_L(0); PG8_BAR; PG8_MMA(0, 0, At, B0); PG8_MMA(0, 1, At, B1); PG8_BAR; PG8_SCHED;
            PG8_LDA(At, 1, 1); PG8_STAGE(PG8_SB(1, 0), b3, voffB); PG8_STAGE(PG8_SB(1, 1), b3 + hstepB, voffB); PG8_STAGE(PG8_SA(1, 0), a3, voffA);
            PG8_WAIT_V(8); PG8_WAIT_L(0); PG8_BAR; PG8_MMA(1, 0, At, B0); PG8_MMA(1, 1, At, B1); PG8_BAR; PG8_SCHED;
            } else {
            PG8_LDB(B0, 0, 0); PG8_SCHED; PG8_LDA(At, 0, 0); PG8_STAGE(PG8_SA(1, 1), a1 + hstepB, voffA);
            PG8_WAIT_L(8); PG8_BAR; PG8_WAIT_L(0); PG8_MMA(0, 0, At, B0); PG8_BAR; PG8_SCHED;
            PG8_LDB(B1, 0, 1); PG8_STAGE(PG8_SB(0, 0), b2, voffB);
            PG8_BAR; PG8_WAIT_L(0); PG8_MMA(0, 1, At, B1); PG8_BAR;
            PG8_LDA(At, 0, 1); PG8_STAGE(PG8_SA(0, 0), a2, voffA);
            PG8_BAR; PG8_WAIT_L(0); PG8_MMA(1, 0, At, B0); PG8_BAR; PG8_SCHED;
            PG8_STAGE(PG8_SB(0, 1), b2 + hstepB, voffB);
            PG8_WAIT_V(6); PG8_BAR; PG8_MMA(1, 1, At, B1); PG8_BAR;
            PG8_LDB(B0, 1, 0); PG8_SCHED; PG8_LDA(At, 1, 0); PG8_STAGE(PG8_SA(0, 1), a2 + hstepB, voffA);
            PG8_WAIT_L(8); PG8_BAR; PG8_WAIT_L(0); PG8_MMA(0, 0, At, B0); PG8_BAR; PG8_SCHED;
            PG8_LDB(B1, 1, 1); PG8_STAGE(PG8_SB(1, 0), b3, voffB);
            PG8_BAR; PG8_WAIT_L(0); PG8_MMA(0, 1, At, B1); PG8_BAR;
            PG8_LDA(At, 1, 1); PG8_STAGE(PG8_SA(1, 0), a3, voffA);
            PG8_BAR; PG8_WAIT_L(0); PG8_MMA(1, 0, At, B0); PG8_BAR; PG8_SCHED;
            PG8_STAGE(PG8_SB(1, 1), b3 + hstepB, voffB);
            PG8_WAIT_V(6); PG8_BAR; PG8_MMA(1, 1, At, B1); PG8_BAR;
            }
        }
        if constexpr (ALIGN_EPI) { if (wr == 0) PG8_BAR; }
        if constexpr (!Epi::AFTER_DRAIN) { E(acc, cur, wr, wc, fr, fq); S.done(cur); }
        if (!has_next) break;
#pragma unroll
        for (int a = 0; a < 2; ++a)
#pragma unroll
            for (int b = 0; b < 2; ++b)
#pragma unroll
                for (int m = 0; m < 4; ++m)
#pragma unroll
                    for (int n = 0; n < 2; ++n) acc[a][b][m][n] = (f32x4){0.f, 0.f, 0.f, 0.f};
        cur = nxt; cA = nA; cB = nB; ++ui;
        if constexpr (ALIGN_EPI) { if (wr == 1) PG8_BAR; }
    }
    PG8_WAIT_V(0);
    if constexpr (!ALIGN_EPI) { if (wr == 0) PG8_BAR; }
    PG8_BAR;
    if constexpr (Epi::AFTER_DRAIN) { E.fused(acc, cur, wr, wc, fr, fq, lds, wid, lane); S.done(cur); }
#undef PG8_SA
#undef PG8_SB
#undef PG8_STAGE
#undef PG8_LDA
#undef PG8_LDB
#undef PG8_MMA
#undef PG8_WAIT_V
#undef PG8_WAIT_L
#undef PG8_BAR
#undef PG8_SCHED
}
}
namespace attn_body {
using bf16=__hip_bfloat16;
using bf16x8=__attribute__((ext_vector_type(8)))short;
using s16x4=__attribute__((ext_vector_type(4)))short;
using f32x16=__attribute__((ext_vector_type(16)))float;
using u32x4=__attribute__((ext_vector_type(4)))unsigned;
constexpr int BATCH=2,SEQ=8192,D=64,PIN=7168,POUT=2048;
constexpr int NW=8,QBLK=32,QB=QBLK*NW,KVBLK=64,NQB=SEQ/QB;
constexpr int ATTN_UNIT_ROWS=QB;
__device__ __forceinline__ int crow(int r,int hi){return (r&3)+8*(r>>2)+4*hi;}
#define SBAR() __builtin_amdgcn_sched_barrier(0)
__device__ __forceinline__ void cmask(f32x16&p0,f32x16&p1,int jb,int qrel,int hi){
  const float NEG=-INFINITY; int kb=64*jb+4*hi;
  #pragma unroll
  for(int r=0;r<16;++r){int kv=kb+(r&3)+8*(r>>2); if(kv>qrel)p0[r]=NEG; if(kv+32>qrel)p1[r]=NEG;}
}

constexpr int NSLOT=3, SLOTB=8192;
constexpr int VSLOTB=2*SLOTB;
constexpr int LDS_K=0, LDS_V=NSLOT*SLOTB, LDS_WS=LDS_V+NSLOT*VSLOTB, LDS_OST=LDS_WS+NW*64*4, LDS_BYTES=LDS_OST+NW*4096;
constexpr float C2=0.125f*1.4426950408889634f;
__device__ __forceinline__ void glds16(const void*gsrc,unsigned lds_dst){unsigned keep;
  asm volatile("s_mov_b32 %0, m0\n\ts_mov_b32 m0, %2\n\ts_nop 0\n\tglobal_load_lds_dwordx4 %1, off\n\ts_mov_b32 m0, %0":"=&s"(keep):"v"(gsrc),"s"(lds_dst):"memory");}
__device__ __forceinline__ float max3f(float a,float b,float c){float r;asm("v_max3_f32 %0, %1, %2, %3":"=v"(r):"v"(a),"v"(b),"v"(c));return r;}
__device__ __forceinline__ float max2f(float a,float b){float r;asm("v_max_f32_e32 %0, %1, %2":"=v"(r):"v"(a),"v"(b));return r;}
__device__ __forceinline__ float fadd_s(float a,float b){float r;asm("v_add_f32_e32 %0, %1, %2":"=v"(r):"v"(a),"v"(b));return r;}
__device__ __forceinline__ float fsub_s(float a,float b){float r;asm("v_sub_f32_e32 %0, %1, %2":"=v"(r):"v"(a),"v"(b));return r;}
typedef float f32x2_t __attribute__((ext_vector_type(2))); typedef __bf16 bf16x2_t __attribute__((ext_vector_type(2)));
__device__ __forceinline__ unsigned cvtpk_s(float lo,float hi){f32x2_t v={lo,hi};bf16x2_t b=__builtin_convertvector(v,bf16x2_t);return __builtin_bit_cast(unsigned,b);}
#define WAIT_BAR(N) asm volatile("s_waitcnt vmcnt(" #N ") lgkmcnt(0)\n\ts_barrier":::"memory")

__device__ __forceinline__ void qkt(f32x16&p0,f32x16&p1,const char*Kslot,const bf16x8*qr,const f32x16&negm,int r32,int hi){
  const char*kb=Kslot+hi*1024+r32*16;
  #pragma unroll
  for(int d0=0;d0<4;++d0){
    const bf16x8 b0=*reinterpret_cast<const bf16x8*>(kb+d0*2048);
    const bf16x8 b1=*reinterpret_cast<const bf16x8*>(kb+d0*2048+512);
    if(d0==0){p0=__builtin_amdgcn_mfma_f32_32x32x16_bf16(b0,qr[0],negm,0,0,0);p1=__builtin_amdgcn_mfma_f32_32x32x16_bf16(b1,qr[0],negm,0,0,0);}
    else{p0=__builtin_amdgcn_mfma_f32_32x32x16_bf16(b0,qr[d0],p0,0,0,0);p1=__builtin_amdgcn_mfma_f32_32x32x16_bf16(b1,qr[d0],p1,0,0,0);}}
}
typedef __attribute__((address_space(3))) const char* lds_cptr;
typedef short v4i16_t __attribute__((ext_vector_type(4)));
__device__ __forceinline__ void kload8(bf16x8*kf,lds_cptr kp){
  kf[0]=*(const __attribute__((address_space(3))) bf16x8*)(kp);      kf[1]=*(const __attribute__((address_space(3))) bf16x8*)(kp+512);
  kf[2]=*(const __attribute__((address_space(3))) bf16x8*)(kp+2048); kf[3]=*(const __attribute__((address_space(3))) bf16x8*)(kp+2560);
  kf[4]=*(const __attribute__((address_space(3))) bf16x8*)(kp+4096); kf[5]=*(const __attribute__((address_space(3))) bf16x8*)(kp+4608);
  kf[6]=*(const __attribute__((address_space(3))) bf16x8*)(kp+6144); kf[7]=*(const __attribute__((address_space(3))) bf16x8*)(kp+6656);
}
__device__ __forceinline__ void kload2(bf16x8*kf,lds_cptr kp,int j){ kf[2*j]=*(const __attribute__((address_space(3))) bf16x8*)(kp+j*2048); kf[2*j+1]=*(const __attribute__((address_space(3))) bf16x8*)(kp+j*2048+512); }
__device__ __forceinline__ s16x4 vtr(lds_cptr p){ return __builtin_bit_cast(s16x4,__builtin_amdgcn_ds_read_tr16_b64_v4i16((__attribute__((address_space(3))) v4i16_t*)p)); }
__device__ __forceinline__ float rowmax(const f32x16&p0,const f32x16&p1){
  float a=max3f(p0[0],p0[1],p1[0]),b=max3f(p0[2],p0[3],p1[1]);a=max3f(a,p1[2],p1[3]);
  #pragma unroll
  for(int r=4;r<16;r+=4){a=max3f(a,p0[r],p0[r+1]);b=max3f(b,p0[r+2],p0[r+3]);a=max3f(a,p1[r],p1[r+1]);b=max3f(b,p1[r+2],p1[r+3]);}
  const float m=max2f(a,b);
  auto rr=__builtin_amdgcn_permlane32_swap(__float_as_uint(m),__float_as_uint(m),false,false);
  return max2f(__uint_as_float(rr[0]),__uint_as_float(rr[1]));
}
__device__ __forceinline__ void pv(f32x16*o,int vb,bf16x8 pa0,bf16x8 pa1,bf16x8 pa2,bf16x8 pa3){
  #pragma unroll
  for(int d0=0;d0<2;++d0){s16x4 lo[4],hi[4];
    #pragma unroll
    for(int ks=0;ks<4;++ks){
      asm volatile("ds_read_b64_tr_b16 %0,%1 offset:%c2":"=&v"(lo[ks]):"v"(vb),"i"(d0*4096+ks*1024):"memory");
      asm volatile("ds_read_b64_tr_b16 %0,%1 offset:%c2":"=&v"(hi[ks]):"v"(vb),"i"(d0*4096+ks*1024+512):"memory");}
    asm volatile("s_waitcnt lgkmcnt(0)":::"memory");SBAR();
    #define PK(k) (bf16x8){lo[k][0],lo[k][1],lo[k][2],lo[k][3],hi[k][0],hi[k][1],hi[k][2],hi[k][3]}
    o[d0]=__builtin_amdgcn_mfma_f32_32x32x16_bf16(pa0,PK(0),o[d0],0,0,0);
    o[d0]=__builtin_amdgcn_mfma_f32_32x32x16_bf16(pa1,PK(1),o[d0],0,0,0);
    o[d0]=__builtin_amdgcn_mfma_f32_32x32x16_bf16(pa2,PK(2),o[d0],0,0,0);
    o[d0]=__builtin_amdgcn_mfma_f32_32x32x16_bf16(pa3,PK(3),o[d0],0,0,0);
    #undef PK
  }
}

#ifndef ATTN_STORE16
#define ATTN_STORE16(p,v) (*(u32x4*)(p)=(v))
#endif
template<int THRL> __device__ __forceinline__ void attn_unit(int b,int qcol,int kcol,int vcol,int ocol,int qb,const bf16*__restrict__ P,bf16*__restrict__ O,char*shm){
  int tid_o=threadIdx.x; asm volatile("":"+v"(tid_o)); const int tid=tid_o,lane=tid&63,r32=lane&31,hi=lane>>5; const int wid=__builtin_amdgcn_readfirstlane(tid>>6);
  const long rowbase=(long)b*SEQ; const int q0=qb*QB;
  const bf16*Qw=P+(rowbase+q0+wid*QBLK)*PIN+qcol;
  const bf16*Kh=P+rowbase*PIN+kcol,*Vh=P+rowbase*PIN+vcol;
  const unsigned lds0=(unsigned)(uintptr_t)shm;
  float*wsf=(float*)(shm+LDS_WS)+wid*64;
  const bf16*ksrc=Kh+(long)lane*PIN+wid*8;
  const bf16*vsrc=Vh+(long)(16*(wid&3)+(lane>>2))*PIN+(wid>>2)*32+(lane&3)*8;
  const unsigned kdst=lds0+LDS_K+wid*1024, vdst=lds0+LDS_V+wid*1024;
  #define DMA_K(t,slot) glds16(ksrc+(long)(t)*KVBLK*PIN,(unsigned)__builtin_amdgcn_readfirstlane(kdst+(slot)))
  #define DMA_V(t,slot) do{ glds16(vsrc+(long)(t)*KVBLK*PIN,(unsigned)__builtin_amdgcn_readfirstlane(vdst+2*(slot))); glds16(vsrc+(long)(t)*KVBLK*PIN+64,(unsigned)__builtin_amdgcn_readfirstlane(vdst+2*(slot)+SLOTB)); }while(0)
  const int vb0=(int)(lds0+LDS_V)+((lane>>4)&1)*32+(lane&3)*8+(4*hi+((lane&15)>>2))*64;
  const char*Kbase=shm+LDS_K; bf16x8 kf[8];
  const lds_cptr shm3=(lds_cptr)shm; const lds_cptr kp0=shm3+LDS_K+hi*1024+r32*16; const lds_cptr vp0=shm3+LDS_V+((lane>>4)&1)*32+(lane&3)*8+(4*hi+((lane&15)>>2))*64;
  const int NT=(q0+QB)/KVBLK;
  DMA_K(0,0);DMA_V(0,0);DMA_K(1,SLOTB);
  bf16x8 qr[4];
  #pragma unroll
  for(int d0=0;d0<4;++d0)qr[d0]=*reinterpret_cast<const bf16x8*>(&Qw[(long)r32*PIN+d0*16+hi*8]);
  float mhat=0.f,l_reg=0.f;f32x16 o[4];o[0]=f32x16{};o[1]=f32x16{};o[2]=f32x16{};o[3]=f32x16{};f32x16 negm=f32x16{};asm volatile("":"+v"(negm));
  const int qrel=wid*QBLK+r32;
  #define CMASK(P0,P1,t) do{int jb_=(t)-(NT-4); if(jb_>=0)cmask(P0,P1,jb_,qrel,hi);}while(0)
  bool resc=false;
  #define START(P0,P1) do{ const float rm=rowmax(P0,P1); resc=false; \
    { const float dl=rm; mhat=fadd_s(mhat,dl); \
      _Pragma("unroll") for(int r=0;r<16;++r){P0[r]=fsub_s(P0[r],dl);P1[r]=fsub_s(P1[r],dl);} \
      _Pragma("unroll") for(int r=0;r<16;++r)negm[r]=-mhat; asm volatile("":"+v"(negm)); } \
    _Pragma("unroll") for(int r=0;r<16;++r)P0[r]=__builtin_amdgcn_exp2f(P0[r]); }while(0)
  #define RESC() do{ if(resc){ asm volatile("s_waitcnt lgkmcnt(0)":::"memory"); \
      _Pragma("unroll") for(int d_=0;d_<4;++d_) _Pragma("unroll") for(int r=0;r<16;++r)o[d_][r]*=wsf[crow(r,hi)]; } }while(0)
  f32x16 pA0,pA1,pB0,pB1;
  int sl_prev=0,sl_cur=0,sl_next=SLOTB;
  #define ROT() do{sl_prev=sl_cur;sl_cur=sl_next;sl_next=(sl_next==(NSLOT-1)*SLOTB)?0:sl_next+SLOTB;}while(0)
  DMA_K(2,2*SLOTB);
  WAIT_BAR(4);
  qkt(pA0,pA1,Kbase,qr,negm,r32,hi);asm volatile("s_nop 15\n\ts_nop 7":"+v"(pA0),"+v"(pA1));CMASK(pA0,pA1,0);
  START(pA0,pA1);
  _Pragma("unroll") for(int r=0;r<16;++r)pA1[r]=__builtin_amdgcn_exp2f(pA1[r]);
  WAIT_BAR(0);
  DMA_K(3,0);DMA_V(1,SLOTB);
  ROT();
  kload8(kf,kp0+sl_cur);
  WAIT_BAR(3);
  s16x4 vlo[8],vhi[8]; u32x4 pw0,pw1,pw2,pw3;
  #define PKW(P,B) cvtpk_s(P[B],P[B+1])
  #define PAF(k) __builtin_bit_cast(bf16x8,pw##k)
  #define VFR(i) (bf16x8){vlo[i][0],vlo[i][1],vlo[i][2],vlo[i][3],vhi[i][0],vhi[i][1],vhi[i][2],vhi[i][3]}
  #define PIN(x) asm volatile("":"+v"(x))
  #define MX3(a,b,c) __builtin_fmaxf(__builtin_fmaxf((a),(b)),(c))
  #define GAPA(MF,A0,A1,A2,A3,W0,W1,PW) do{ MF; sacc+=A0; sacc+=A1; sacc+=A2; sacc+=A3; PIN(sacc); W0; W1; PIN(PW); SBAR(); }while(0)
  #define EX(v) __builtin_amdgcn_exp2f(v)
  #define GAPB(MF,X,B) do{ MF; X[B]=EX(X[B]); X[B+1]=EX(X[B+1]); X[B+2]=EX(X[B+2]); X[B+3]=EX(X[B+3]); PIN(X); SBAR(); }while(0)
  #define VRD(i) do{ vlo[i]=vtr(vp_+(((i)>>2)*4096+((i)&3)*1024)); vhi[i]=vtr(vp_+(((i)>>2)*4096+((i)&3)*1024+512)); }while(0)
  #define VRD2(i) do{ vlo[i]=vtr(vp_+(SLOTB+((i)>>2)*4096+((i)&3)*1024)); vhi[i]=vtr(vp_+(SLOTB+((i)>>2)*4096+((i)&3)*1024+512)); SBAR(); }while(0)
  #define GAPB2(MF,X,B) do{ MF; X[B]=EX(X[B]); X[B+1]=EX(X[B+1]); PIN(X); SBAR(); }while(0)
  #define KRD(G,j) do{ if(G){ kload2(kf,kp0+sl_next,j); SBAR(); } }while(0)
  #define STEP(C0,C1,P0,P1,t,GK,GV,GL) do{ SBAR(); \
    const lds_cptr vp_=vp0+2*sl_prev; \
    VRD(0); SBAR(); float sacc=(P0[0]+P0[1]); \
    GAPA(C0=__builtin_amdgcn_mfma_f32_32x32x16_bf16(kf[0],qr[0],negm,0,0,0), P0[2],P0[3],P0[4],P0[5],     pw0[0]=PKW(P0,0), pw0[1]=PKW(P0,2), pw0); \
    VRD(4); SBAR(); GAPA(C1=__builtin_amdgcn_mfma_f32_32x32x16_bf16(kf[1],qr[0],negm,0,0,0), P0[6],P0[7],P0[8],P0[9],     pw0[2]=PKW(P0,4), pw0[3]=PKW(P0,6), pw0); \
    VRD(1); SBAR(); GAPA(C0=__builtin_amdgcn_mfma_f32_32x32x16_bf16(kf[2],qr[1],C0,0,0,0),   P0[10],P0[11],P0[12],P0[13], pw1[0]=PKW(P0,8), pw1[1]=PKW(P0,10), pw1); \
    VRD(5); SBAR(); GAPA(C1=__builtin_amdgcn_mfma_f32_32x32x16_bf16(kf[3],qr[1],C1,0,0,0),   P0[14],P0[15],P1[0],P1[1],   pw1[2]=PKW(P0,12),pw1[3]=PKW(P0,14), pw1); \
    VRD(2); SBAR(); GAPA(C0=__builtin_amdgcn_mfma_f32_32x32x16_bf16(kf[4],qr[2],C0,0,0,0),   P1[2],P1[3],P1[4],P1[5],     pw2[0]=PKW(P1,0), pw2[1]=PKW(P1,2), pw2); \
    VRD(6); SBAR(); GAPA(C1=__builtin_amdgcn_mfma_f32_32x32x16_bf16(kf[5],qr[2],C1,0,0,0),   P1[6],P1[7],P1[8],P1[9],     pw2[2]=PKW(P1,4), pw2[3]=PKW(P1,6), pw2); \
    VRD(3); SBAR(); GAPA(C0=__builtin_amdgcn_mfma_f32_32x32x16_bf16(kf[6],qr[3],C0,0,0,0),   P1[10],P1[11],P1[12],P1[13], pw3[0]=PKW(P1,8), pw3[1]=PKW(P1,10), pw3); \
    VRD(7); SBAR(); GAPA(C1=__builtin_amdgcn_mfma_f32_32x32x16_bf16(kf[7],qr[3],C1,0,0,0),   P1[14],P1[15],0.f,0.f,       pw3[2]=PKW(P1,12),pw3[3]=PKW(P1,14), pw3); \
    l_reg+=sacc; \
    if(GK){DMA_K((t)+3,sl_cur);} if(GV){DMA_V((t)+1,sl_next);} \
    CMASK(C0,C1,t); \
    { float a=MX3(C0[0],C0[1],C1[0]),b=MX3(C0[2],C0[3],C1[1]); a=MX3(a,C1[2],C1[3]); \
      _Pragma("unroll") for(int r=4;r<16;r+=4){a=MX3(a,C0[r],C0[r+1]);b=MX3(b,C0[r+2],C0[r+3]);a=MX3(a,C1[r],C1[r+1]);b=MX3(b,C1[r+2],C1[r+3]);} \
      float rm=__builtin_fmaxf(a,b); { auto rr=__builtin_amdgcn_permlane32_swap(__float_as_uint(rm),__float_as_uint(rm),false,false); rm=__builtin_fmaxf(__uint_as_float(rr[0]),__uint_as_float(rr[1])); } \
      resc=false; \
      if(__builtin_expect(__any(rm>(float)THRL),0)){ const float dl=__builtin_fmaxf(rm,0.f); mhat+=dl; \
        _Pragma("unroll") for(int r=0;r<16;++r){C0[r]-=dl;C1[r]-=dl;} \
        _Pragma("unroll") for(int r=0;r<16;++r)negm[r]=-mhat; asm volatile("":"+v"(negm)); \
        const float f=__builtin_amdgcn_exp2f(-dl); l_reg*=f; if(hi==0)wsf[r32]=f; resc=true; } } \
    SBAR(); \
    GAPB2(o[0]=__builtin_amdgcn_mfma_f32_32x32x16_bf16(PAF(0),VFR(0),o[0],0,0,0), C0,0); VRD2(0); \
    GAPB2(o[1]=__builtin_amdgcn_mfma_f32_32x32x16_bf16(PAF(0),VFR(4),o[1],0,0,0), C0,2); VRD2(4); \
    KRD(GL,0); GAPB2(o[0]=__builtin_amdgcn_mfma_f32_32x32x16_bf16(PAF(1),VFR(1),o[0],0,0,0), C0,4); VRD2(1); \
    KRD(GL,1); GAPB2(o[1]=__builtin_amdgcn_mfma_f32_32x32x16_bf16(PAF(1),VFR(5),o[1],0,0,0), C0,6); VRD2(5); \
    KRD(GL,2); GAPB2(o[0]=__builtin_amdgcn_mfma_f32_32x32x16_bf16(PAF(2),VFR(2),o[0],0,0,0), C0,8); VRD2(2); \
    KRD(GL,3); GAPB2(o[1]=__builtin_amdgcn_mfma_f32_32x32x16_bf16(PAF(2),VFR(6),o[1],0,0,0), C0,10); VRD2(6); \
    GAPB2(o[0]=__builtin_amdgcn_mfma_f32_32x32x16_bf16(PAF(3),VFR(3),o[0],0,0,0), C0,12); VRD2(3); \
    GAPB2(o[1]=__builtin_amdgcn_mfma_f32_32x32x16_bf16(PAF(3),VFR(7),o[1],0,0,0), C0,14); VRD2(7); \
    GAPB2(o[2]=__builtin_amdgcn_mfma_f32_32x32x16_bf16(PAF(0),VFR(0),o[2],0,0,0), C1,0); \
    GAPB2(o[3]=__builtin_amdgcn_mfma_f32_32x32x16_bf16(PAF(0),VFR(4),o[3],0,0,0), C1,2); \
    GAPB2(o[2]=__builtin_amdgcn_mfma_f32_32x32x16_bf16(PAF(1),VFR(1),o[2],0,0,0), C1,4); \
    GAPB2(o[3]=__builtin_amdgcn_mfma_f32_32x32x16_bf16(PAF(1),VFR(5),o[3],0,0,0), C1,6); \
    GAPB2(o[2]=__builtin_amdgcn_mfma_f32_32x32x16_bf16(PAF(2),VFR(2),o[2],0,0,0), C1,8); \
    GAPB2(o[3]=__builtin_amdgcn_mfma_f32_32x32x16_bf16(PAF(2),VFR(6),o[3],0,0,0), C1,10); \
    GAPB2(o[2]=__builtin_amdgcn_mfma_f32_32x32x16_bf16(PAF(3),VFR(3),o[2],0,0,0), C1,12); \
    GAPB2(o[3]=__builtin_amdgcn_mfma_f32_32x32x16_bf16(PAF(3),VFR(7),o[3],0,0,0), C1,14); \
    }while(0)
  int t=1;
  #undef CMASK
  #define CMASK(P0,P1,t) do{}while(0)
  for(;t+5<NT;t+=2){
    STEP(pB0,pB1,pA0,pA1,t,true,true,true);     WAIT_BAR(3); RESC(); ROT();
    STEP(pA0,pA1,pB0,pB1,t+1,true,true,true);   WAIT_BAR(3); RESC(); ROT();
  }
  #undef CMASK
  #define CMASK(P0,P1,t) do{int jb_=(t)-(NT-4); if(jb_>=0)cmask(P0,P1,jb_,qrel,hi);}while(0)
  #define ENDW(tt) do{ if((tt)+3<NT){WAIT_BAR(3);} else if((tt)+2<NT){WAIT_BAR(2);} else {WAIT_BAR(0);} }while(0)
  for(;t+1<NT;t+=2){
    STEP(pB0,pB1,pA0,pA1,t,(t+3<NT),(t+1<NT),(t+1<NT));       ENDW(t);   RESC(); ROT();
    STEP(pA0,pA1,pB0,pB1,t+1,(t+4<NT),(t+2<NT),(t+2<NT));     ENDW(t+1); RESC(); ROT();
  }
  STEP(pB0,pB1,pA0,pA1,NT-1,false,false,false); RESC();
  { float sacc=pB0[0]+pB0[1]; _Pragma("unroll") for(int r=2;r<16;++r)sacc+=pB0[r]; _Pragma("unroll") for(int r=0;r<16;++r)sacc+=pB1[r]; l_reg+=sacc;
    pw0=(u32x4){PKW(pB0,0),PKW(pB0,2),PKW(pB0,4),PKW(pB0,6)};pw1=(u32x4){PKW(pB0,8),PKW(pB0,10),PKW(pB0,12),PKW(pB0,14)};pw2=(u32x4){PKW(pB1,0),PKW(pB1,2),PKW(pB1,4),PKW(pB1,6)};pw3=(u32x4){PKW(pB1,8),PKW(pB1,10),PKW(pB1,12),PKW(pB1,14)};
    SBAR(); pv(o,vb0+2*sl_cur,PAF(0),PAF(1),PAF(2),PAF(3)); pv(o+2,vb0+2*sl_cur+SLOTB,PAF(0),PAF(1),PAF(2),PAF(3)); }
  #undef PKW
  #undef PAF
  #undef VFR
  #undef PIN
  #undef MX3
  #undef GAPA
  #undef GAPB
  #undef EX
  #undef VRD
  #undef VRD2
  #undef GAPB2
  #undef KRD
  #undef STEP
  #undef ENDW
  {auto rr=__builtin_amdgcn_permlane32_swap(__float_as_uint(l_reg),__float_as_uint(l_reg),false,false);l_reg=__uint_as_float(rr[0])+__uint_as_float(rr[1]);}
  if(hi==0)wsf[32+r32]=l_reg;asm volatile("s_waitcnt lgkmcnt(0)":::"memory");
  float rli[16];
  #pragma unroll
  for(int r=0;r<16;++r)rli[r]=__builtin_amdgcn_rcpf(wsf[32+crow(r,hi)]);
  bf16*Ow=O+(rowbase+q0+wid*QBLK)*POUT+ocol;
  { bf16*stg=(bf16*)(shm+LDS_OST)+wid*2048;
    #pragma unroll
    for(int vh=0;vh<2;++vh){
    #pragma unroll
    for(int r=0;r<16;++r){const int orow=crow(r,hi);
      #pragma unroll
      for(int d0=0;d0<2;++d0)stg[orow*64+d0*32+r32]=__float2bfloat16(o[2*vh+d0][r]*rli[r]);}
    asm volatile("s_waitcnt lgkmcnt(0)":::"memory");
    #pragma unroll
    for(int i=0;i<4;++i){const int row=i*8+(lane>>3),ch=lane&7; const u32x4 v=*(const u32x4*)(stg+row*64+ch*8); ATTN_STORE16(Ow+(long)row*POUT+vh*64+ch*8,v);}
    asm volatile("s_waitcnt lgkmcnt(0)":::"memory"); } }
  asm volatile("s_waitcnt lgkmcnt(0)\n\ts_barrier":::"memory");
  #undef DMA_K
  #undef DMA_V
  #undef CMASK
  #undef START
  #undef RESC
  #undef ROT
}
constexpr int ATTN_LDS_BYTES=LDS_BYTES;
#undef SBAR
#undef WAIT_BAR
}
#define GAS __attribute__((address_space(1)))
#define LAS __attribute__((address_space(3)))
typedef unsigned short bf16;
typedef unsigned v4u __attribute__((ext_vector_type(4)));
typedef unsigned v2u __attribute__((ext_vector_type(2)));
typedef float f32x4 __attribute__((ext_vector_type(4)));
typedef short bf16x8 __attribute__((ext_vector_type(8)));
#define LDS_WAIT() asm volatile("s_waitcnt lgkmcnt(0)" ::: "memory")

#ifndef HGRN_NAIVE
#define HGRN_NAIVE 0
#endif
constexpr int NWAVES = 8, NTHREADS = 512;
constexpr int BATCH = 2, SEQ = 8192, DM = 2048, M = BATCH * SEQ, DFF = 5632, INW = 7168, AW = 1024, HW = 1024, NH = 8;
constexpr int C_QA = 0, C_KA = 1024, C_VA = 2048, C_QH = 3072, C_FH = 4096, C_IH = 5120, C_GH = 6144;
constexpr float NORM_EPS = 1e-6f, SUBLN_EPS = 1e-5f;
constexpr int LDS_BYTES = 147456, RING_BYTES = 131072;

constexpr size_t SZ_WGU = (size_t)2 * DFF * DM * 2, SZ_WD = (size_t)DM * DFF * 2, SZ_WIN = (size_t)INW * DM * 2, SZ_WOUT = (size_t)DM * DM * 2;
constexpr size_t WS_WGU1 = 0, WS_WD1 = WS_WGU1 + SZ_WGU, WS_WIN = WS_WD1 + SZ_WD, WS_WOUT = WS_WIN + SZ_WIN, WS_WGU2 = WS_WOUT + SZ_WOUT, WS_WD2 = WS_WGU2 + SZ_WGU;
constexpr size_t WS_XN = WS_WD2 + SZ_WD;
constexpr size_t WS_MIX = WS_XN + (size_t)M * DM * 2;
constexpr size_t WS_BIG = WS_MIX + (size_t)M * DM * 2;
constexpr size_t WS_ATTO = WS_BIG + (size_t)M * INW * 2;
constexpr size_t WS_ST = WS_ATTO + (size_t)M * DM * 2;
constexpr size_t WS_DEC = WS_ST + (size_t)2048 * 128 * 128 * 2;
constexpr size_t WS_BAR = WS_DEC + (size_t)2048 * 128 * 4;
constexpr size_t WS_SSQ = WS_BAR + 16384;
constexpr size_t WS_END = WS_SSQ + (size_t)7 * M * 32 * 4;

__device__ __forceinline__ unsigned pk2(float lo, float hi) { typedef float f2_t __attribute__((ext_vector_type(2))); typedef __bf16 b2_t __attribute__((ext_vector_type(2))); const f2_t v = {lo, hi}; return __builtin_bit_cast(unsigned, __builtin_convertvector(v, b2_t)); }
__device__ __forceinline__ unsigned f2bf(float f) { return pk2(f, f) & 0xffffu; }
__device__ __forceinline__ float bf2f(unsigned short b) { return __builtin_bit_cast(float, (unsigned)b << 16); }
using pg8::shx;
__device__ __forceinline__ float wave_sum(float v, int lane) {
#pragma unroll
    for (int o = 1; o < 64; o <<= 1) v += shx(v, lane, o);
    return v;
}

#define RLX_AGENT __ATOMIC_RELAXED, __HIP_MEMORY_SCOPE_AGENT
#define XB_TMO      128
#define XB_XCNT(j)  (256  + 64 * (j))
#define XB_XSUB(j)  (1280 + 64 * (j))
#define XB_XGEN(j)  (2304 + 64 * (j))
#define XB_TOP      3328
#define XB_TOPGEN   3392
#define XCD_BAR_WORDS 3456
#define XB_SPIN_CAP (1u << 18)

__device__ __forceinline__ unsigned xb_ld(unsigned* p)              { return __hip_atomic_load(p, __ATOMIC_RELAXED, __HIP_MEMORY_SCOPE_AGENT); }
__device__ __forceinline__ unsigned xb_add(unsigned* p, unsigned v) { return __hip_atomic_fetch_add(p, v, __ATOMIC_RELAXED, __HIP_MEMORY_SCOPE_AGENT); }
__device__ __forceinline__ unsigned xb_xcc_id() { return (unsigned)__builtin_amdgcn_s_getreg((3 << 11) | 20) & 0xFu; }
#define XB_SPIN(cond, bar) do { unsigned _sp = 0; while (cond) { __builtin_amdgcn_s_sleep(1); \
    if ((++_sp & 255u) == 0u) { if (xb_ld(&(bar)[XB_TMO])) break; if (_sp > XB_SPIN_CAP) { atomicAdd(&(bar)[XB_TMO], 1u); break; } } } } while (0)

struct XcdBarrier {
    unsigned* bar; unsigned x;
    volatile LAS unsigned* st;
};

__device__ __forceinline__ XcdBarrier xcd_barrier_post(unsigned* bar, volatile LAS unsigned* st) {
    XcdBarrier b; b.bar = bar; b.x = xb_xcc_id(); b.st = st;
    if (threadIdx.x == 0) (void)xb_add(&bar[XB_XCNT(b.x)], 1u);
    return b;
}
__device__ __forceinline__ void xcd_barrier_complete(unsigned* bar, unsigned x, unsigned& nloc, unsigned& nx) {
    const unsigned G = gridDim.x * gridDim.y * gridDim.z;
    unsigned sum, cnt, mine, sp = 0u;
    for (;;) {
        sum = 0u; cnt = 0u; mine = 0u;
#pragma unroll
        for (unsigned j = 0; j < 16; ++j) { const unsigned c = xb_ld(&bar[XB_XCNT(j)]); sum += c; cnt += (c > 0u) ? 1u : 0u; mine = (j == x) ? c : mine; }
        if (sum == G) break;
        __builtin_amdgcn_s_sleep(1);
        if ((++sp & 255u) == 0u) { if (xb_ld(&bar[XB_TMO])) break; if (sp > XB_SPIN_CAP) { atomicAdd(&bar[XB_TMO], 1u); break; } }
    }
    nloc = mine > 0u ? mine : 1u; nx = cnt > 0u ? cnt : 1u;
}

__device__ __forceinline__ void xcd_barrier(const XcdBarrier& b) {
    asm volatile("s_waitcnt vmcnt(0)" ::: "memory");
    __syncthreads();
    if (threadIdx.x == 0) {
        unsigned* bar = b.bar;
        __builtin_amdgcn_s_waitcnt(0);
        unsigned nloc = b.st[0], nx = b.st[1];
        if (nloc == 0u) { xcd_barrier_complete(bar, b.x, nloc, nx); b.st[0] = nloc; b.st[1] = nx; }
        const unsigned old = xb_add(&bar[XB_XSUB(b.x)], 1u);
        const unsigned gen = old / nloc;
        if (old + 1u == (gen + 1u) * nloc) {
            __builtin_amdgcn_fence(__ATOMIC_RELEASE, "agent");
            asm volatile("s_waitcnt vmcnt(0)" ::: "memory");
            const unsigned og = xb_add(&bar[XB_TOP], 1u);
            const unsigned tg = og / nx;
            if (og + 1u == (tg + 1u) * nx) xb_add(&bar[XB_TOPGEN], 1u);
            else XB_SPIN(xb_ld(&bar[XB_TOPGEN]) == tg, bar);
            __builtin_amdgcn_fence(__ATOMIC_ACQUIRE, "agent");
            xb_add(&bar[XB_XGEN(b.x)], 1u);
            asm volatile("s_waitcnt vmcnt(0)" ::: "memory");
        } else {
            XB_SPIN(xb_ld(&bar[XB_XGEN(b.x)]) == gen, bar);
            __builtin_amdgcn_fence(__ATOMIC_ACQUIRE, "agent");
            asm volatile("s_waitcnt vmcnt(0)" ::: "memory");
        }
    }
    __syncthreads();
}

struct Args { const float* in[20]; float* out; unsigned char* ws; int ph_lo, ph_hi; };

__device__ __forceinline__ void transpose_item(const float* W, int K, int N, bf16* WT, int mode, const float* nw, LAS float* scr, int item, int lane) {
    const int nblk = N / 32, kb = item / nblk, nb = item % nblk, k0 = 64 * kb, n0 = 32 * nb;
    const int drow0 = (mode == 0) ? n0 : ((n0 >> 7) * 256 + (n0 & 127) + (mode == 2 ? 128 : 0));
#pragma unroll 8
    for (int i = 0; i < 32; ++i) { const int kk = 2 * i + (lane >> 5); scr[kk * 33 + (lane & 31)] = W[(size_t)(k0 + kk) * N + n0 + (lane & 31)]; }
    LDS_WAIT(); asm volatile("" ::: "memory");
    const int c = lane & 7;
    f32x4 na = {1.f, 1.f, 1.f, 1.f}, nb2 = na;
    if (nw) { na = *(const GAS f32x4*)(nw + k0 + 8 * c); nb2 = *(const GAS f32x4*)(nw + k0 + 8 * c + 4); }
#pragma unroll
    for (int j = 0; j < 4; ++j) { const int n = (lane >> 3) + 8 * j; const LAS float* s = scr + (8 * c) * 33 + n;
        v4u o; o.x = pk2(s[0 * 33] * na.x, s[1 * 33] * na.y); o.y = pk2(s[2 * 33] * na.z, s[3 * 33] * na.w); o.z = pk2(s[4 * 33] * nb2.x, s[5 * 33] * nb2.y); o.w = pk2(s[6 * 33] * nb2.z, s[7 * 33] * nb2.w);
        const int r = drow0 + n; *(GAS v4u*)(WT + ((size_t)((r >> 8) * (K >> 6) + kb) * 256 + (r & 255)) * 64 + 8 * c) = o; }
    LDS_WAIT(); asm volatile("" ::: "memory");
}
__device__ __forceinline__ void rms_row_to_bf16(const float* xrow, const float* w, bf16* orow, int lane) {
    const GAS f32x4* xr = (const GAS f32x4*)xrow + lane; const GAS f32x4* wr = (const GAS f32x4*)w + lane;
    f32x4 v[8]; float s = 0.f;
#pragma unroll
    for (int j = 0; j < 8; ++j) { v[j] = xr[64 * j]; s += (v[j].x * v[j].x + v[j].y * v[j].y) + (v[j].z * v[j].z + v[j].w * v[j].w); }
    const float rstd = 1.0f / sqrtf(wave_sum(s, lane) * (1.f / DM) + NORM_EPS);
    GAS v2u* o8 = (GAS v2u*)orow + lane;
#pragma unroll
    for (int j = 0; j < 8; ++j) { const f32x4 ww = wr[64 * j]; v2u o; o.x = pk2(v[j].x * rstd * ww.x, v[j].y * rstd * ww.y); o.y = pk2(v[j].z * rstd * ww.z, v[j].w * rstd * ww.w); o8[64 * j] = o; }
}
__device__ __forceinline__ void row_to_bf16_ssq(const float* xrow, bf16* xn, int m, float* ssq, int lane) {
    const GAS f32x4* xr = (const GAS f32x4*)xrow + lane; float s = 0.f;
#pragma unroll
    for (int j = 0; j < 8; ++j) { const f32x4 v = xr[64 * j]; s += (v.x * v.x + v.y * v.y) + (v.z * v.z + v.w * v.w); v2u o; o.x = pk2(v.x, v.y); o.y = pk2(v.z, v.w); *(GAS v2u*)(xn + pg8::toff(m, 4 * lane + 256 * j, DM / 64)) = o; }
    s = wave_sum(s, lane); if (lane < 32) ssq[lane] = (lane == 0) ? s : 0.f;
}
__device__ __forceinline__ void fn_load(v4u (&b)[4], const bf16* xn, int m, int lane) {
#pragma unroll
    for (int j = 0; j < 4; ++j) b[j] = *(const GAS v4u*)(xn + pg8::toff(m, 8 * lane + 512 * j, DM / 64));
}
__device__ __forceinline__ void fn_finish(const v4u (&bb)[4], float* orow, const f32x4 (&ww)[4][2], int lane) {
    f32x4 v[4][2]; float s = 0.f;
#pragma unroll
    for (int j = 0; j < 4; ++j) { const v4u b = bb[j];
        v[j][0] = (f32x4){__builtin_bit_cast(float, b.x << 16), __builtin_bit_cast(float, b.x & 0xffff0000u), __builtin_bit_cast(float, b.y << 16), __builtin_bit_cast(float, b.y & 0xffff0000u)};
        v[j][1] = (f32x4){__builtin_bit_cast(float, b.z << 16), __builtin_bit_cast(float, b.z & 0xffff0000u), __builtin_bit_cast(float, b.w << 16), __builtin_bit_cast(float, b.w & 0xffff0000u)};
#pragma unroll
        for (int h = 0; h < 2; ++h) s += (v[j][h].x * v[j][h].x + v[j][h].y * v[j][h].y) + (v[j][h].z * v[j][h].z + v[j][h].w * v[j][h].w); }
    const float rstd = 1.0f / sqrtf(wave_sum(s, lane) * (1.f / DM) + NORM_EPS);
#pragma unroll
    for (int j = 0; j < 4; ++j)
#pragma unroll
        for (int h = 0; h < 2; ++h) { const int col = 512 * j + 8 * lane + 4 * h; *(GAS f32x4*)(orow + col) = v[j][h] * rstd * ww[j][h]; }
}
__device__ __forceinline__ void xr_load(f32x4 (&v)[8], const float* xrow, int lane) {
#pragma unroll
    for (int j = 0; j < 8; ++j) v[j] = ((const GAS f32x4*)xrow + lane)[64 * j];
}
__device__ __forceinline__ void xr_finish(const f32x4 (&vv)[8], bf16* xn, int m, float* ssq, int lane) {
    float s = 0.f;
#pragma unroll
    for (int j = 0; j < 8; ++j) { const f32x4 v = vv[j]; s += (v.x * v.x + v.y * v.y) + (v.z * v.z + v.w * v.w); v2u o; o.x = pk2(v.x, v.y); o.y = pk2(v.z, v.w); *(GAS v2u*)(xn + pg8::toff(m, 4 * lane + 256 * j, DM / 64)) = o; }
    s = wave_sum(s, lane); if (lane < 32) ssq[lane] = (lane == 0) ? s : 0.f;
}
__device__ __forceinline__ void rms_row_bf16_to_f32(const bf16* xn, int m, float* orow, const float* w, int lane) {
    f32x4 v[4][2]; float s = 0.f;
#pragma unroll
    for (int j = 0; j < 4; ++j) { const v4u b = *(const GAS v4u*)(xn + pg8::toff(m, 8 * lane + 512 * j, DM / 64));
        v[j][0] = (f32x4){__builtin_bit_cast(float, b.x << 16), __builtin_bit_cast(float, b.x & 0xffff0000u), __builtin_bit_cast(float, b.y << 16), __builtin_bit_cast(float, b.y & 0xffff0000u)};
        v[j][1] = (f32x4){__builtin_bit_cast(float, b.z << 16), __builtin_bit_cast(float, b.z & 0xffff0000u), __builtin_bit_cast(float, b.w << 16), __builtin_bit_cast(float, b.w & 0xffff0000u)};
#pragma unroll
        for (int h = 0; h < 2; ++h) s += (v[j][h].x * v[j][h].x + v[j][h].y * v[j][h].y) + (v[j][h].z * v[j][h].z + v[j][h].w * v[j][h].w); }
    const float rstd = 1.0f / sqrtf(wave_sum(s, lane) * (1.f / DM) + NORM_EPS);
#pragma unroll
    for (int j = 0; j < 4; ++j)
#pragma unroll
        for (int h = 0; h < 2; ++h) { const int col = 512 * j + 8 * lane + 4 * h; const f32x4 ww = *(const GAS f32x4*)(w + col); *(GAS f32x4*)(orow + col) = v[j][h] * rstd * ww; }
}
__device__ __forceinline__ void rms_row_to_f32(float* xrow, const float* w, int lane) {
    GAS f32x4* xr = (GAS f32x4*)xrow + lane; const GAS f32x4* wr = (const GAS f32x4*)w + lane;
    f32x4 v[8]; float s = 0.f;
#pragma unroll
    for (int j = 0; j < 8; ++j) { v[j] = xr[64 * j]; s += (v[j].x * v[j].x + v[j].y * v[j].y) + (v[j].z * v[j].z + v[j].w * v[j].w); }
    const float rstd = 1.0f / sqrtf(wave_sum(s, lane) * (1.f / DM) + NORM_EPS);
#pragma unroll
    for (int j = 0; j < 8; ++j) { const f32x4 ww = wr[64 * j]; xr[64 * j] = v[j] * rstd * ww; }
}
__device__ __forceinline__ float lambda_init_of(int layer) { return layer == 0 ? 0.2f : 0.35550907f; }

struct PmRaw { v4u a[4]; v2u r[4], g[4]; };
__device__ __forceinline__ void pm_load(PmRaw& P, int row, const bf16* atto, const bf16* rec, const bf16* proj, int lane) {
#pragma unroll
    for (int j = 0; j < 4; ++j) { P.a[j] = *(const GAS v4u*)(atto + (size_t)row * 2048 + j * 512 + lane * 8); P.r[j] = ((const GAS v2u*)(rec + (size_t)row * HW) + lane)[64 * j];
        P.g[j] = *(const GAS v2u*)(proj + (size_t)row * INW + C_GH + 4 * lane + 256 * j); }
}
__device__ __forceinline__ void pm_compute(const PmRaw& P, int row, float lam, const float (&sw)[8], const f32x4 (&gw)[4], bf16* mix, int lane) {
    const int vb = (lane & 15) * 8;
#pragma unroll
    for (int j = 0; j < 4; ++j) {
        const v4u raw = P.a[j];
        float v[8], d[8]; float ss = 0.f;
#pragma unroll
        for (int e = 0; e < 4; ++e) { const unsigned w = raw[e]; v[2 * e] = __builtin_bit_cast(float, w << 16); v[2 * e + 1] = __builtin_bit_cast(float, w & 0xffff0000u); }
#pragma unroll
        for (int e = 0; e < 8; ++e) { const float p = shx(v[e], lane | 16, 0); d[e] = v[e] - lam * p; ss += d[e] * d[e]; }
        ss += shx(ss, lane, 1); ss += shx(ss, lane, 2); ss += shx(ss, lane, 4); ss += shx(ss, lane, 8);
        const float rstd = __builtin_amdgcn_rsqf(ss * (1.f / 128.f) + SUBLN_EPS);
        v4u o; o.x = pk2(d[0] * rstd * sw[0], d[1] * rstd * sw[1]); o.y = pk2(d[2] * rstd * sw[2], d[3] * rstd * sw[3]); o.z = pk2(d[4] * rstd * sw[4], d[5] * rstd * sw[5]); o.w = pk2(d[6] * rstd * sw[6], d[7] * rstd * sw[7]);
        const int h = 2 * j + (lane >> 5);
        if ((lane & 16) == 0) *(GAS v4u*)(mix + pg8::toff(row, h * 128 + vb, DM / 64)) = o;
    }
    f32x4 r[4]; float s = 0.f;
#pragma unroll
    for (int j = 0; j < 4; ++j) { const v2u rw = P.r[j]; r[j] = (f32x4){__builtin_bit_cast(float, rw.x << 16), __builtin_bit_cast(float, rw.x & 0xffff0000u), __builtin_bit_cast(float, rw.y << 16), __builtin_bit_cast(float, rw.y & 0xffff0000u)};
        s += (r[j].x * r[j].x + r[j].y * r[j].y) + (r[j].z * r[j].z + r[j].w * r[j].w); }
    const float rstd = __builtin_amdgcn_rsqf(wave_sum(s, lane) * (1.f / HW) + NORM_EPS);
#pragma unroll
    for (int j = 0; j < 4; ++j) { const int col = 4 * lane + 256 * j; const v2u graw = P.g[j];
        float g[4] = { __builtin_bit_cast(float, graw.x << 16), __builtin_bit_cast(float, graw.x & 0xffff0000u), __builtin_bit_cast(float, graw.y << 16), __builtin_bit_cast(float, graw.y & 0xffff0000u) };
        float o[4];
#pragma unroll
        for (int e = 0; e < 4; ++e) { const float sg = g[e] * __builtin_amdgcn_rcpf(1.0f + __expf(-g[e])); o[e] = r[j][e] * rstd * gw[j][e] * sg; }
        v2u ov; ov.x = pk2(o[0], o[1]); ov.y = pk2(o[2], o[3]);
        *(GAS v2u*)(mix + pg8::toff(row, 1024 + col, DM / 64)) = ov; }
}

__device__ __forceinline__ float hgrn_lb(const float* lbsrc, int layer, int ch) { return layer == 0 ? 0.f : 1.0f / (1.0f + __expf(lbsrc[ch] - lbsrc[HW + ch])); }

typedef float lbraw_t __attribute__((ext_vector_type(2)));
__device__ __forceinline__ lbraw_t lb_load(const float* lbsrc, int layer, int ch) { lbraw_t r = {0.f, 0.f}; if (layer != 0) { r.x = lbsrc[ch]; r.y = lbsrc[HW + ch]; } return r; }
__device__ __forceinline__ float lb_val(int layer, lbraw_t r) { return layer == 0 ? 0.f : 1.0f / (1.0f + __expf(r.x - r.y)); }
__device__ __forceinline__ void hgrn_naive_item(int item, const bf16* proj, float* rec, const float* lbsrc, int layer, LAS unsigned char* lds, int tid) {
    typedef float f32x2 __attribute__((ext_vector_type(2)));
    LAS f32x2* tile = (LAS f32x2*)lds;
    const int b = item >> 3, h = item & 7, lane = tid & 63, wave = tid >> 6;
    const int k = tid & 127, tq = tid >> 7;
    const float lb = hgrn_lb(lbsrc, layer, h * 128 + k);
    float S[128];
#pragma unroll
    for (int i = 0; i < 128; ++i) S[i] = 0.f;
    for (int tb = 0; tb < SEQ / 64; ++tb) {
        const size_t row0 = (size_t)b * SEQ + (size_t)tb * 64;
#pragma unroll 4
        for (int j = 0; j < 16; ++j) { const int t = tq + 4 * j; const bf16* pr = proj + (row0 + t) * INW + h * 128 + k;
            const float z = bf2f(pr[C_FH]), q = bf2f(pr[C_QH]); const float f = lb + (1.0f - lb) / (1.0f + __expf(-z));
            tile[t * 128 + k] = (f32x2){f, q}; }
        __syncthreads();
        if (wave < 2) { const int v = wave * 64 + lane;
            for (int t = 0; t < 64; ++t) { const float iv = bf2f(proj[(row0 + t) * INW + C_IH + h * 128 + v]); float o = 0.f;
#pragma unroll
                for (int kk = 0; kk < 128; ++kk) { const f32x2 fq = tile[t * 128 + kk]; S[kk] = fq.x * (S[kk] - iv) + iv; o += fq.y * S[kk]; }
                rec[(row0 + t) * HW + h * 128 + v] = o; } }
        __syncthreads();
    }
}

constexpr int HG_TOT = 0, HG_A1 = 2048, HG_A2 = HG_A1 + 64 * 272, HG_B1 = HG_A2 + 64 * 272, HG_VT = HG_B1 + 64 * 272, HG_P = HG_VT + 128 * 144, HG_END = HG_P + 64 * 144;
constexpr int HG_B3T = 2048;
static_assert(HG_B3T + 128 * 144 <= HG_VT && HG_END <= RING_BYTES, "HGRN LDS map");
struct HgRaw { unsigned zq[16], vv[8]; };
template <int PASS>
__device__ __forceinline__ void hg_load(HgRaw& R, int unit, const bf16* proj, int tid) {
    const int bh = unit >> 7, c = unit & 127, b = bh >> 3, h = bh & 7; const size_t row0 = (size_t)b * SEQ + (size_t)c * 64; const int k = tid & 127, tg = tid >> 7;
    const bf16* pz = proj + (row0 + 16 * tg) * INW + h * 128 + k;
#pragma unroll
    for (int j = 0; j < 16; ++j) { const unsigned z = pz[(size_t)j * INW + C_FH]; const unsigned q = (PASS == 3) ? pz[(size_t)j * INW + C_QH] : 0u; R.zq[j] = z | (q << 16); }
#pragma unroll
    for (int j = 0; j < 8; ++j) { const unsigned a = pz[(size_t)(2 * j) * INW + C_IH], b2 = pz[(size_t)(2 * j + 1) * INW + C_IH]; R.vv[j] = a | (b2 << 16); }
}
template <int PASS>
__device__ __forceinline__ void hgrn_chunk_unit(const HgRaw& R, int unit, const bf16* proj, bf16* Lbuf, float* dec, const bf16* ST, bf16* rec, float lb, LAS unsigned char* lds, int tid) {
    const int bh = unit >> 7, c = unit & 127, b = bh >> 3, h = bh & 7;
    const size_t row0 = (size_t)b * SEQ + (size_t)c * 64;
    const int k = tid & 127, tg = tid >> 7, lane = tid & 63, w = __builtin_amdgcn_readfirstlane(tid >> 6), fr = lane & 15, fq = lane >> 4;
    LAS float* TOT = (LAS float*)(lds + HG_TOT);
    float bcum[16], kk[16], qv[16];
    {   float run = 0.f;
#pragma unroll
        for (int j = 0; j < 16; ++j) { const float z = __builtin_bit_cast(float, R.zq[j] << 16);
            if (PASS == 3) qv[j] = __builtin_bit_cast(float, R.zq[j] & 0xffff0000u);
            const float e = __expf(-z); const float sg = __builtin_amdgcn_rcpf(1.0f + e);
            const float f = fmaxf(lb + (1.0f - lb) * sg, 1e-26f);
            kk[j] = (1.0f - lb) * (e * sg);
            run += 0.69314718056f * __builtin_amdgcn_logf(f); bcum[j] = run; }
        TOT[tg * 128 + k] = run;
    }
    {   v4u o0, o1;
        o0.x = R.vv[0]; o0.y = R.vv[1]; o0.z = R.vv[2]; o0.w = R.vv[3]; o1.x = R.vv[4]; o1.y = R.vv[5]; o1.z = R.vv[6]; o1.w = R.vv[7];
        *(LAS v4u*)(lds + HG_VT + k * 144 + tg * 32) = o0; *(LAS v4u*)(lds + HG_VT + k * 144 + tg * 32 + 16) = o1;
    }
    __syncthreads();
    const float t0 = TOT[k], t1 = TOT[128 + k], t2 = TOT[256 + k], t3 = TOT[384 + k];
    const float off = (tg > 0 ? t0 : 0.f) + (tg > 1 ? t1 : 0.f) + (tg > 2 ? t2 : 0.f);
    const float blast = (t0 + t1) + (t2 + t3);
    if (PASS == 1) {
        unsigned pkd[8];
#pragma unroll
        for (int j = 0; j < 16; j += 2) pkd[j >> 1] = pk2(kk[j] * __expf(blast - (off + bcum[j])), kk[j + 1] * __expf(blast - (off + bcum[j + 1])));
        *(LAS v4u*)(lds + HG_B3T + k * 144 + tg * 32) = (v4u){pkd[0], pkd[1], pkd[2], pkd[3]};
        *(LAS v4u*)(lds + HG_B3T + k * 144 + tg * 32 + 16) = (v4u){pkd[4], pkd[5], pkd[6], pkd[7]};
        if (tg == 0) dec[(size_t)unit * 128 + k] = __expf(blast);
        __syncthreads();
        bf16x8 yv[2];
#pragma unroll
        for (int ks = 0; ks < 2; ++ks) yv[ks] = *(const LAS bf16x8*)(lds + HG_VT + (16 * w + fr) * 144 + ks * 64 + fq * 16);
        bf16* Lu = Lbuf + (size_t)unit * 16384 + (size_t)(16 * w + fr) * 128 + 4 * fq;
#pragma unroll
        for (int xb = 0; xb < 8; ++xb) { f32x4 acc = {0.f, 0.f, 0.f, 0.f};
#pragma unroll
            for (int ks = 0; ks < 2; ++ks) { const bf16x8 xv = *(const LAS bf16x8*)(lds + HG_B3T + (16 * xb + fr) * 144 + ks * 64 + fq * 16);
                acc = __builtin_amdgcn_mfma_f32_16x16x32_bf16(xv, yv[ks], acc, 0, 0, 0); }
            *(GAS v2u*)(Lu + 16 * xb) = (v2u){pk2(acc[0], acc[1]), pk2(acc[2], acc[3])}; }
    } else {
        const float r = t0 + t1;
#pragma unroll
        for (int j = 0; j < 16; ++j) { const float bj = off + bcum[j]; const int t = 16 * tg + j;
            const float a1 = qv[j] * __expf(fminf(bj - r, 80.f)), a2 = qv[j] * __expf(bj), b1 = kk[j] * __expf(fminf(r - bj, 80.f));
            const unsigned w12 = pk2(a1, a2), w3 = pk2(b1, b1);
            *(LAS unsigned short*)(lds + HG_A1 + t * 272 + k * 2) = (unsigned short)w12;
            *(LAS unsigned short*)(lds + HG_A2 + t * 272 + k * 2) = (unsigned short)(w12 >> 16);
            *(LAS unsigned short*)(lds + HG_B1 + t * 272 + k * 2) = (unsigned short)w3; }
        bf16x8 sx[4];
#pragma unroll
        for (int ks = 0; ks < 4; ++ks) sx[ks] = *(const GAS bf16x8*)(ST + (size_t)unit * 16384 + (size_t)(16 * w + fr) * 128 + 32 * ks + 8 * fq);
        __syncthreads();
#pragma unroll
        for (int rep = 0; rep < 2; ++rep) { const int id = w + 8 * rep, sb = id >> 2, tb = id & 3;
            f32x4 acc = {0.f, 0.f, 0.f, 0.f};
            if (sb <= tb) {
#pragma unroll
                for (int ks = 0; ks < 4; ++ks) { const bf16x8 xv = *(const LAS bf16x8*)(lds + HG_B1 + (16 * sb + fr) * 272 + ks * 64 + fq * 16);
                    const bf16x8 yv = *(const LAS bf16x8*)(lds + HG_A1 + (16 * tb + fr) * 272 + ks * 64 + fq * 16);
                    acc = __builtin_amdgcn_mfma_f32_16x16x32_bf16(xv, yv, acc, 0, 0, 0); }
            }
            const int t = 16 * tb + fr, s0 = 16 * sb + 4 * fq;
            float pvv[4];
#pragma unroll
            for (int i = 0; i < 4; ++i) pvv[i] = (sb <= tb && s0 + i <= t) ? acc[i] : 0.f;
            *(LAS v2u*)(lds + HG_P + t * 144 + s0 * 2) = (v2u){pk2(pvv[0], pvv[1]), pk2(pvv[2], pvv[3])}; }
        __syncthreads();
        bf16x8 vx[2];
#pragma unroll
        for (int ks = 0; ks < 2; ++ks) vx[ks] = *(const LAS bf16x8*)(lds + HG_VT + (16 * w + fr) * 144 + ks * 64 + fq * 16);
#pragma unroll
        for (int tb = 0; tb < 4; ++tb) { f32x4 acc = {0.f, 0.f, 0.f, 0.f};
#pragma unroll
            for (int ks = 0; ks < 2; ++ks) { const bf16x8 yv = *(const LAS bf16x8*)(lds + HG_P + (16 * tb + fr) * 144 + ks * 64 + fq * 16);
                acc = __builtin_amdgcn_mfma_f32_16x16x32_bf16(vx[ks], yv, acc, 0, 0, 0); }
#pragma unroll
            for (int ks = 0; ks < 4; ++ks) { const bf16x8 yv = *(const LAS bf16x8*)(lds + HG_A2 + (16 * tb + fr) * 272 + ks * 64 + fq * 16);
                acc = __builtin_amdgcn_mfma_f32_16x16x32_bf16(sx[ks], yv, acc, 0, 0, 0); }
            *(GAS v2u*)(rec + (row0 + 16 * tb + fr) * HW + h * 128 + 16 * w + 4 * fq) = (v2u){pk2(acc[0], acc[1]), pk2(acc[2], acc[3])}; }
    }
    __syncthreads();
}
__device__ __forceinline__ void hgrn_scan(int gtid, int nthreads, const bf16* Lbuf, const float* dec, bf16* ST) {
    typedef float f32x2 __attribute__((ext_vector_type(2)));
    for (int idx = gtid; idx < 16 * 8192; idx += nthreads) {
        const int bh = idx >> 13, e2 = (idx & 8191) * 2, kq = e2 & 127;
        const unsigned* Lp = (const unsigned*)(Lbuf + (size_t)bh * 128 * 16384 + e2); const float* dp = dec + (size_t)bh * 128 * 128 + kq; unsigned* sp = (unsigned*)(ST + (size_t)bh * 128 * 16384 + e2);
        f32x2 S = {0.f, 0.f};
#pragma unroll 8
        for (int c = 0; c < 128; ++c) { const unsigned lw = Lp[(size_t)c * 8192]; const f32x2 lv = {__builtin_bit_cast(float, lw << 16), __builtin_bit_cast(float, lw & 0xffff0000u)}; const f32x2 d = *(const GAS f32x2*)(dp + c * 128);
            sp[(size_t)c * 8192] = pk2(S.x, S.y); S = d * S + lv; }
    }
}

__device__ __forceinline__ void rstd_table(LAS float* tab, const float* ssq, int pm, float inv_n, float eps, int tid) {
    const int r = tid >> 1, hf = tid & 1; const f32x4* p = (const f32x4*)(ssq + (size_t)(pm * 256 + r) * 32 + hf * 16);
    const f32x4 a = p[0], b = p[1], c = p[2], d = p[3];
    const float q0 = ((a[0] + a[1]) + (a[2] + a[3])) + ((b[0] + b[1]) + (b[2] + b[3])), q1 = ((c[0] + c[1]) + (c[2] + c[3])) + ((d[0] + d[1]) + (d[2] + d[3]));
    float s = q0 + q1; s += shx(s, tid & 63, 1);
    if (hf == 0) tab[r] = __builtin_amdgcn_rsqf(s * inv_n + eps);
    __syncthreads();
}
#ifndef GEMM_ALIGN
#define GEMM_ALIGN true
#endif
#ifndef GEMM_SP2
#define GEMM_SP2 true
#endif
constexpr int PH_PER_LAYER = 13, N_PHASES = 2 * PH_PER_LAYER + 1;

__global__ void __launch_bounds__(NTHREADS, 2) hymba_fwd(Args args) {
    extern __shared__ __attribute__((aligned(16))) unsigned char lds_raw[];
    LAS unsigned char* lds = (LAS unsigned char*)lds_raw;
    cg::grid_group grid = cg::this_grid();
    const int G = gridDim.x, bx = blockIdx.x;
    const int vcu = (G % 8 == 0) ? (bx % 8) * (G / 8) + bx / 8 : bx;
    const int NGW = G * NWAVES;
    unsigned char* ws = args.ws;
    const float* x_in = args.in[0];
    float* xres = args.out;
    bf16* XN = (bf16*)(ws + WS_XN); bf16* MIX = (bf16*)(ws + WS_MIX); bf16* BIG = (bf16*)(ws + WS_BIG); bf16* ATTO = (bf16*)(ws + WS_ATTO);
    float* SSQ = (float*)(ws + WS_SSQ);
    bf16* REC = (bf16*)xres; bf16* LBUF = (bf16*)xres;     bf16* ST = (bf16*)(ws + WS_ST); float* DEC = (float*)(ws + WS_DEC);
    bf16* Wgu1 = (bf16*)(ws + WS_WGU1); bf16* Wd1 = (bf16*)(ws + WS_WD1); bf16* Win = (bf16*)(ws + WS_WIN); bf16* Wout = (bf16*)(ws + WS_WOUT); bf16* Wgu2 = (bf16*)(ws + WS_WGU2); bf16* Wd2 = (bf16*)(ws + WS_WD2);

    LAS float* RTAB = (LAS float*)(lds + RING_BYTES + 1024);
    unsigned* barw = (unsigned*)(ws + WS_BAR);
    volatile LAS unsigned* bst = (volatile LAS unsigned*)(lds + RING_BYTES);
    if (threadIdx.x < 2) bst[threadIdx.x] = 0u;
    if (bx == 0 && args.ph_lo == 0) for (int i = threadIdx.x; i < 4096; i += NTHREADS) __hip_atomic_store(barw + i, 0u, __ATOMIC_RELAXED, __HIP_MEMORY_SCOPE_AGENT);
    __syncthreads();
#ifdef PROBE_MASK
    int probe_rep = 0;
#endif
    XcdBarrier xbar; xbar.bar = barw; xbar.x = 0; xbar.st = bst;
    for (int ph = args.ph_lo; ph < args.ph_hi; ++ph) {
        const int layer = ph / PH_PER_LAYER, p = (ph == N_PHASES - 1) ? 99 : ph % PH_PER_LAYER;
        if (p == 3 || p == 10 || (p == 8 && !HGRN_NAIVE)) continue;
        int tid_o = threadIdx.x; asm volatile("" : "+v"(tid_o));
        const int tid = tid_o;
#define PHASE_IDS const int lane = tid & 63, wave = __builtin_amdgcn_readfirstlane(tid >> 6), gw = vcu * NWAVES + wave; (void)lane; (void)wave; (void)gw;
        switch (p) {
        case 0: {
            PHASE_IDS
            LAS float* scr = (LAS float*)(lds + wave * 16384);
            const float* g1 = args.in[2] + (size_t)layer * DM * DFF; const float* u1 = args.in[3] + (size_t)layer * DM * DFF; const float* d1 = args.in[4] + (size_t)layer * DFF * DM;
            const float* wi = args.in[6] + (size_t)layer * DM * INW; const float* wo = args.in[14] + (size_t)layer * DM * DM;
            const float* g2 = args.in[16] + (size_t)layer * DM * DFF; const float* u2 = args.in[17] + (size_t)layer * DM * DFF; const float* d2 = args.in[18] + (size_t)layer * DFF * DM;
            const float* nw1 = args.in[1] + (size_t)layer * DM; const float* nw2 = args.in[5] + (size_t)layer * DM; const float* nw3 = args.in[15] + (size_t)layer * DM;
            constexpr int I_F = (DM / 64) * (DFF / 32), I_IN = (DM / 64) * (INW / 32), I_OUT = (DM / 64) * (DM / 32);
            constexpr int NITEMS = 6 * I_F + I_IN + I_OUT;
            for (int it = gw; it < NITEMS; it += NGW) {
                int r = it;
                if (r < I_F) { transpose_item(g1, DM, DFF, Wgu1, 1, nw1, scr, r, lane); continue; } r -= I_F;
                if (r < I_F) { transpose_item(u1, DM, DFF, Wgu1, 2, nw1, scr, r, lane); continue; } r -= I_F;
                if (r < I_F) { transpose_item(d1, DFF, DM, Wd1, 0, nullptr, scr, r, lane); continue; } r -= I_F;
                if (r < I_IN) { transpose_item(wi, DM, INW, Win, 0, nw2, scr, r, lane); continue; } r -= I_IN;
                if (r < I_OUT) { transpose_item(wo, DM, DM, Wout, 0, nullptr, scr, r, lane); continue; } r -= I_OUT;
                if (r < I_F) { transpose_item(g2, DM, DFF, Wgu2, 1, nw3, scr, r, lane); continue; } r -= I_F;
                if (r < I_F) { transpose_item(u2, DM, DFF, Wgu2, 2, nw3, scr, r, lane); continue; } r -= I_F;
                transpose_item(d2, DFF, DM, Wd2, 0, nullptr, scr, r, lane);
            }
            if (ph == 0 && gw < M) { f32x4 xc[8], xn2[8]; xr_load(xc, x_in + (size_t)gw * DM, lane);
                for (int m = gw; m < M; m += NGW) { const int mn = (m + NGW < M) ? m + NGW : m; xr_load(xn2, x_in + (size_t)mn * DM, lane); xr_finish(xc, XN, m, SSQ + (size_t)m * 32, lane);
#pragma unroll
                    for (int j = 0; j < 8; ++j) xc[j] = xn2[j]; } }
        } break;
        case 1: case 11: {
            pg8::Gemm g{XN, p == 1 ? Wgu1 : Wgu2, M, 2 * DFF, DM}; pg8::StaticOrder S; S.init(M, 2 * DFF, G, bx);
            const float* sq = SSQ + (size_t)(layer * 3 + (p == 1 ? 0 : 2)) * M * 32; pg8::Unit u0; S.next(0, u0); rstd_table(RTAB, sq, u0.pm, 1.0f / DM, NORM_EPS, tid);
            pg8::EpiSwiGLU E{BIG, DFF, sq, 1.0f / DM, NORM_EPS, RTAB, u0.pm};
            pg8::gemm_phase<pg8::EpiSwiGLU, pg8::StaticOrder, GEMM_ALIGN, GEMM_SP2>(lds, g, S, E);
        } break;
        case 2: case 12: case 9: {
            const bf16* A = (p == 9) ? MIX : BIG; const bf16* Bt = (p == 2) ? Wd1 : (p == 12) ? Wd2 : Wout; const int K = (p == 9) ? DM : DFF;
            pg8::Gemm g{A, Bt, M, DM, K}; pg8::StaticOrder S; S.init(M, DM, G, bx);
            pg8::EpiResidual E{XN, SSQ + (size_t)(layer * 3 + (p == 2 ? 1 : p == 9 ? 2 : 3)) * M * 32, DM, (p == 9) ? 1.0f : 0.5f};
            pg8::gemm_phase<pg8::EpiResidual, pg8::StaticOrder, GEMM_ALIGN, GEMM_SP2>(lds, g, S, E);
        } break;
        case 4: {
            pg8::Gemm g{XN, Win, M, INW, DM}; pg8::StaticOrder S; S.init(M, INW, G, bx);
            const float* sq = SSQ + (size_t)(layer * 3 + 1) * M * 32; pg8::Unit u0; S.next(0, u0); rstd_table(RTAB, sq, u0.pm, 1.0f / DM, NORM_EPS, tid);
            pg8::EpiProj E{BIG, INW, sq, 1.0f / DM, NORM_EPS, AW, attn_body::C2, RTAB, u0.pm};
            pg8::gemm_phase<pg8::EpiProj, pg8::StaticOrder, GEMM_ALIGN, GEMM_SP2>(lds, g, S, E);
        } break;
        case 5: {
            for (int i = vcu; i < 256; i += G) {
                const int gsel = i >> 3, s = i & 7; const int b = gsel >> 4, hc = gsel & 15, h = hc >> 1;
                for (int qi = 0; qi < 4; ++qi) { const int qb = (qi == 0) ? s : (qi == 1) ? 15 - s : (qi == 2) ? 16 + s : 31 - s;
                    attn_body::attn_unit<8>(b, C_QA + hc * 64, C_KA + hc * 64, C_VA + h * 128, hc * 128, qb, (const attn_body::bf16*)BIG, (attn_body::bf16*)ATTO, (char*)lds_raw); }
            }
            {   int tid2 = tid; asm volatile("" : "+v"(tid2));
#define tid tid2
                HgRaw cur, nxt; const int u0 = vcu < 2048 ? vcu : 2047; hg_load<1>(cur, u0, BIG, tid);
                lbraw_t lbc = lb_load(args.in[12], layer, ((u0 >> 7) & 7) * 128 + (tid & 127)), lbn;
                for (int u = vcu; u < 2048; u += G) { const int un = u + G < 2048 ? u + G : u; hg_load<1>(nxt, un, BIG, tid); lbn = lb_load(args.in[12], layer, ((un >> 7) & 7) * 128 + (tid & 127));
                    hgrn_chunk_unit<1>(cur, u, BIG, LBUF, DEC, ST, REC, lb_val(layer, lbc), lds, tid); cur = nxt; lbc = lbn; } }
#undef tid
        } break;
        case 6: {
#if HGRN_NAIVE
            for (int item = bx; item < 16; item += G) hgrn_naive_item(item, BIG, REC, args.in[12], layer, lds, tid);
#else
            hgrn_scan(bx * NTHREADS + tid, G * NTHREADS, LBUF, DEC, ST);
#endif
        } break;
        case 7: {
#if !HGRN_NAIVE
            {
                PHASE_IDS
                const float sa = wave_sum(args.in[7][layer * 64 + lane] * args.in[8][layer * 64 + lane], lane), sb = wave_sum(args.in[9][layer * 64 + lane] * args.in[10][layer * 64 + lane], lane);
                const float li = lambda_init_of(layer), lam = __expf(sa) - __expf(sb) + li;
                for (int bc = vcu; bc < 256; bc += G) { const int b = bc >> 7, c = bc & 127;
                    lbraw_t lb_cur = lb_load(args.in[12], layer, (tid & 127)), lb_nxt;
                    HgRaw cur, nxt; hg_load<3>(cur, (b * 8) * 128 + c, BIG, tid);
                    for (int h = 0; h < 8; ++h) { const int u = (b * 8 + h) * 128 + c; hg_load<3>(nxt, h < 7 ? u + 128 : u, BIG, tid); lb_nxt = lb_load(args.in[12], layer, (h < 7 ? h + 1 : h) * 128 + (tid & 127));
                        hgrn_chunk_unit<3>(cur, u, BIG, LBUF, DEC, ST, REC, lb_val(layer, lb_cur), lds, tid); cur = nxt; lb_cur = lb_nxt; }
                    asm volatile("s_waitcnt vmcnt(0)" ::: "memory"); __syncthreads();
                    const int row0 = b * SEQ + c * 64 + wave * 8;
                    float sw[8]; f32x4 gw[4];
#pragma unroll
                    for (int e = 0; e < 8; ++e) sw[e] = args.in[11][layer * 128 + (lane & 15) * 8 + e] * (1.0f - li);
#pragma unroll
                    for (int j = 0; j < 4; ++j) gw[j] = *(const GAS f32x4*)(args.in[13] + (size_t)layer * HW + 4 * lane + 256 * j);
                    PmRaw pc, pn; pm_load(pc, row0, ATTO, REC, BIG, lane);
                    for (int i = 0; i < 8; ++i) { pm_load(pn, row0 + (i < 7 ? i + 1 : i), ATTO, REC, BIG, lane); pm_compute(pc, row0 + i, lam, sw, gw, MIX, lane); pc = pn; }
                }
            }
#endif
        } break;
        default: {
            PHASE_IDS
            if (gw < M) { f32x4 ww[4][2];
#pragma unroll
                for (int j = 0; j < 4; ++j)
#pragma unroll
                    for (int h = 0; h < 2; ++h) ww[j][h] = *(const GAS f32x4*)(args.in[19] + 512 * j + 8 * lane + 4 * h);
                v4u bc[4], bn[4]; fn_load(bc, XN, gw, lane);
                for (int m = gw; m < M; m += NGW) { const int mn = (m + NGW < M) ? m + NGW : m; fn_load(bn, XN, mn, lane); fn_finish(bc, xres + (size_t)m * DM, ww, lane);
#pragma unroll
                    for (int j = 0; j < 4; ++j) bc[j] = bn[j]; } }
        } break;
        }
        if (ph + 1 < args.ph_hi) {
            if (ph == args.ph_lo) { grid.sync(); xbar = xcd_barrier_post(barw, bst); }
            else xcd_barrier(xbar);
        }
#ifdef PROBE_MASK
        if (p < 32 && ((PROBE_MASK >> p) & 1) && !probe_rep && ph != args.ph_lo) { probe_rep = 1; --ph; } else probe_rep = 0;
#endif
    }
}

#ifndef HGRN_NAIVE
#define HGRN_NAIVE 0
#endif
#ifndef N_LAUNCH_MODE
#define N_LAUNCH_MODE 1
#endif
extern "C" void kernel_launch(void* const* d_in, const int* in_sizes, int n_in, void* d_out, int out_size, void* d_ws, size_t ws_size, hipStream_t stream) {
    static int grid = 0;
    if (grid == 0) {
        if (n_in != 20 || out_size != M * DM || ws_size < WS_END) { fprintf(stderr, "kernel_launch: unexpected shapes (n_in %d out %d ws %zu need %zu)\n", n_in, out_size, ws_size, (size_t)WS_END); grid = -1; return; }
        int dev = 0, cus = 0, per_cu = 0;
        (void)hipGetDevice(&dev); (void)hipDeviceGetAttribute(&cus, hipDeviceAttributeMultiprocessorCount, dev);
        if (hipFuncSetAttribute((const void*)hymba_fwd, hipFuncAttributeMaxDynamicSharedMemorySize, LDS_BYTES) != hipSuccess) { fprintf(stderr, "kernel_launch: hipFuncSetAttribute failed\n"); grid = -1; return; }
        if (hipOccupancyMaxActiveBlocksPerMultiprocessor(&per_cu, (const void*)hymba_fwd, NTHREADS, LDS_BYTES) != hipSuccess || per_cu < 1) { fprintf(stderr, "kernel_launch: occupancy query says %d\n", per_cu); per_cu = 1; }
        (void)hipGetLastError();
        grid = cus;
    }
    if (grid < 0) return;
    Args a{};
    for (int i = 0; i < 20; ++i) a.in[i] = (const float*)d_in[i];
    a.out = (float*)d_out; a.ws = (unsigned char*)d_ws;
#if N_LAUNCH_MODE == 1
    a.ph_lo = 0; a.ph_hi = N_PHASES;
    { void* kargs[] = {&a}; hipError_t e = hipLaunchCooperativeKernel((const void*)hymba_fwd, dim3(grid), dim3(NTHREADS), kargs, LDS_BYTES, stream);
      if (e != hipSuccess) fprintf(stderr, "cooperative launch failed: %s (grid %d)\n", hipGetErrorString(e), grid); }
#else
    for (int ph = 0; ph < N_PHASES; ++ph) { if (ph % PH_PER_LAYER == 7) continue; a.ph_lo = ph; a.ph_hi = ph + 1;
        void* kargs[] = {&a}; hipError_t e = hipLaunchCooperativeKernel((const void*)hymba_fwd, dim3(grid), dim3(NTHREADS), kargs, LDS_BYTES, stream);
        if (e != hipSuccess) { fprintf(stderr, "cooperative launch %d failed: %s (grid %d)\n", ph, hipGetErrorString(e), grid); break; } }
#endif
}
```
